# Optimizing an MI355X kernel written in HIP

```python
import jax, jax.numpy as jnp
from jax import lax
import numpy as np

D_MODEL = 2048
BATCH = 4
SEQ = 4096
DEPTH = 1

HEAD_DIM = 128
N_HEADS = D_MODEL // HEAD_DIM
SB_HEADS = N_HEADS // 2
DSA_HEADS = N_HEADS - SB_HEADS
DSA_KV_HEADS = 2
D_SB = SB_HEADS * HEAD_DIM
D_DSA = DSA_HEADS * HEAD_DIM
D_KV = DSA_KV_HEADS * HEAD_DIM
D_MIX = D_SB + D_DSA
IDX_HEADS = 16
IDX_DIM = 64
TOPK_MAX = 256
ROPE_THETA = 500000.0
ROPE_FRACTION_DIV = 4
Q_BLOCK = 128
EPS = 1e-6
D_IN = 4 * D_SB + 2 * D_DSA + 2 * D_KV + IDX_HEADS * IDX_DIM + IDX_DIM + IDX_HEADS

kernel_name = "hybrid_stickbreak_dsa_block"


def rmsnorm(x, g):
    xf = x.astype(jnp.float32)
    y = xf * lax.rsqrt(jnp.mean(xf * xf, axis=-1, keepdims=True) + EPS)
    return (y * g.astype(jnp.float32)).astype(x.dtype)


def partial_rope(x, pos):
    d_rot = x.shape[-1] // ROPE_FRACTION_DIV
    half = d_rot // 2
    inv_freq = jnp.power(ROPE_THETA, -jnp.arange(half, dtype=jnp.float32) / half)
    ang = pos.astype(jnp.float32)[..., None] * inv_freq
    cos = jnp.cos(ang)[:, :, None, :]
    sin = jnp.sin(ang)[:, :, None, :]
    xr = x[..., :d_rot].astype(jnp.float32)
    x1, x2 = xr[..., :half], xr[..., half:]
    rot = jnp.concatenate([x1 * cos - x2 * sin, x2 * cos + x1 * sin], axis=-1)
    return jnp.concatenate([rot.astype(x.dtype), x[..., d_rot:]], axis=-1)


def stick_breaking_attention(q, k, v):
    B, S, H, D = q.shape
    nb = S // Q_BLOCK
    scale = D ** -0.5
    key_pos = jnp.arange(S)
    qb = q.reshape(B, nb, Q_BLOCK, H, D).transpose(1, 0, 2, 3, 4)

    def block(args):
        qi, bi = args
        z = jnp.einsum('bthd,bshd->bhts', qi, k, preferred_element_type=jnp.float32) * scale
        q_pos = bi * Q_BLOCK + jnp.arange(Q_BLOCK)
        mask = (key_pos[None, :] < q_pos[:, None])[None, None]
        log_beta = jnp.where(mask, jax.nn.log_sigmoid(z), -jnp.inf)
        log_1m_beta = jnp.where(mask, jax.nn.log_sigmoid(-z), 0.0)
        tail = lax.cumsum(log_1m_beta, axis=3, reverse=True) - log_1m_beta
        w = jnp.exp(log_beta + tail)
        return jnp.einsum('bhts,bshd->bthd', w.astype(v.dtype), v)

    out = lax.map(block, (qb, jnp.arange(nb)))
    return out.transpose(1, 0, 2, 3, 4).reshape(B, S, H, D)


def dsa_sparse_attention(q, k, v, q_idx, k_idx, w_idx):
    B, S, H, D = q.shape
    G = k.shape[2]
    rep = H // G
    Hi, Di = q_idx.shape[2], q_idx.shape[3]
    topk = min(TOPK_MAX, S // 4)
    nb = S // Q_BLOCK
    scale = D ** -0.5
    idx_scale = Di ** -0.5
    key_pos = jnp.arange(S)
    qb = q.reshape(B, nb, Q_BLOCK, H, D).transpose(1, 0, 2, 3, 4)
    qib = q_idx.reshape(B, nb, Q_BLOCK, Hi, Di).transpose(1, 0, 2, 3, 4)
    wb = w_idx.reshape(B, nb, Q_BLOCK, Hi).transpose(1, 0, 2, 3)

    def block(args):
        qi, qii, wi, bi = args
        q_pos = bi * Q_BLOCK + jnp.arange(Q_BLOCK)
        causal = key_pos[None, :] <= q_pos[:, None]
        rel = jax.nn.relu(jnp.einsum('btid,bsd->btis', qii, k_idx,
                                     preferred_element_type=jnp.float32) * idx_scale)
        score = jnp.einsum('btis,bti->bts', rel, wi.astype(jnp.float32))
        score = jnp.where(causal[None], score, -jnp.inf)
        _, sel = lax.top_k(score, topk)
        valid = sel <= q_pos[None, :, None]
        k_sel = jax.vmap(lambda kb, ib: kb[ib])(k, sel)
        v_sel = jax.vmap(lambda vb, ib: vb[ib])(v, sel)
        qg = qi.reshape(B, Q_BLOCK, G, rep, D)
        s = jnp.einsum('btgrd,btkgd->btgrk', qg, k_sel,
                       preferred_element_type=jnp.float32) * scale
        s = jnp.where(valid[:, :, None, None, :], s, -jnp.inf)
        p = jax.nn.softmax(s, axis=-1)
        o = jnp.einsum('btgrk,btkgd->btgrd', p.astype(v.dtype), v_sel)
        return o.reshape(B, Q_BLOCK, H, D)

    out = lax.map(block, (qb, qib, wb, jnp.arange(nb)))
    return out.transpose(1, 0, 2, 3, 4).reshape(B, S, H, D)


def head_rmsnorm(o, g):
    B, S, H, D = o.shape
    return rmsnorm(o, g.reshape(H, D)).reshape(B, S, H * D)


def setup_inputs(seed: int = 0) -> dict:
    key = jax.random.key(seed)
    ks = jax.random.split(key, 8)
    x = jax.random.normal(ks[0], (BATCH, SEQ, D_MODEL), jnp.float32)
    positions = jnp.broadcast_to(jnp.arange(SEQ, dtype=jnp.int32)[None], (BATCH, SEQ))
    norm_g = 1.0 + 0.02 * jax.random.normal(ks[1], (DEPTH, D_MODEL), jnp.float32)
    w_in = jax.random.normal(ks[2], (DEPTH, D_MODEL, D_IN), jnp.float32) * D_MODEL ** -0.5
    sb_out_g = 1.0 + 0.02 * jax.random.normal(ks[3], (DEPTH, D_SB), jnp.float32)
    dsa_out_g = 1.0 + 0.02 * jax.random.normal(ks[4], (DEPTH, D_DSA), jnp.float32)
    w_out = jax.random.normal(ks[5], (DEPTH, D_MIX, D_MODEL), jnp.float32) * D_MIX ** -0.5
    final_g = 1.0 + 0.02 * jax.random.normal(ks[6], (D_MODEL,), jnp.float32)
    return {"x": x, "positions": positions, "norm_g": norm_g, "w_in": w_in,
            "sb_out_g": sb_out_g, "dsa_out_g": dsa_out_g, "w_out": w_out,
            "final_g": final_g}


def reference(x, positions, norm_g, w_in, sb_out_g, dsa_out_g, w_out, final_g):
    B, S, _ = x.shape
    sizes = (D_SB, D_SB, D_SB, D_SB, D_DSA, D_KV, D_KV, D_DSA,
             IDX_HEADS * IDX_DIM, IDX_DIM, IDX_HEADS)
    for layer in range(DEPTH):
        h = rmsnorm(x, norm_g[layer])
        proj = jnp.einsum('bsd,de->bse', h, w_in[layer])
        parts = []
        off = 0
        for n in sizes:
            parts.append(proj[..., off:off + n])
            off += n
        (sb_q, sb_k, sb_v, sb_gate, dq, dk, dv, dsa_gate, iq, ik, iw) = parts

        o_sb = stick_breaking_attention(sb_q.reshape(B, S, SB_HEADS, HEAD_DIM),
                                        sb_k.reshape(B, S, SB_HEADS, HEAD_DIM),
                                        sb_v.reshape(B, S, SB_HEADS, HEAD_DIM))
        o_sb = head_rmsnorm(o_sb, sb_out_g[layer]) * jax.nn.silu(sb_gate)

        q_d = partial_rope(dq.reshape(B, S, DSA_HEADS, HEAD_DIM), positions)
        k_d = partial_rope(dk.reshape(B, S, DSA_KV_HEADS, HEAD_DIM), positions)
        v_d = dv.reshape(B, S, DSA_KV_HEADS, HEAD_DIM)
        q_i = partial_rope(iq.reshape(B, S, IDX_HEADS, IDX_DIM), positions)
        k_i = partial_rope(ik.reshape(B, S, 1, IDX_DIM), positions)[:, :, 0, :]
        w_i = iw * (IDX_HEADS ** -0.5)
        o_dsa = dsa_sparse_attention(q_d, k_d, v_d, q_i, k_i, w_i)
        o_dsa = head_rmsnorm(o_dsa, dsa_out_g[layer]) * jax.nn.silu(dsa_gate)

        mixed = jnp.concatenate([o_sb, o_dsa], axis=-1)
        x = x + jnp.einsum('bse,ed->bsd', mixed, w_out[layer]).astype(x.dtype)
    return rmsnorm(x, final_g)
```

```cpp
#include <hip/hip_runtime.h>
#include <cstdio>
#include <cstdint>

constexpr int BATCH = 4, SEQ = 4096, DM = 2048, NTOK = BATCH * SEQ;
constexpr int HD = 128, SBH = 8, DSH = 8, DKV = 2, IH = 16, ID = 64, TOPK = 256;
constexpr int D_IN = 7760, NP = 7936;
constexpr int C_SBQ = 0, C_SBK = 1024, C_SBV = 2048, C_SBG = 3072, C_DQ = 4096, C_DK = 5120, C_DV = 5376, C_DG = 5632, C_IQ = 6656, C_IK = 7680, C_IW = 7744;
constexpr float EPS = 1e-6f;
constexpr float C2 = 0.08838834764831845f * 1.4426950408889634f;
constexpr float IWS = 1.0f / 32.0f;

constexpr size_t MiB = 1u << 20;
constexpr size_t WS_CTL = 0;
constexpr size_t WS_HN = 1 * MiB;
constexpr size_t WS_MIXED = WS_HN;
constexpr size_t WS_WT1 = 65 * MiB;
constexpr size_t WS_WT2 = 96 * MiB;
constexpr size_t WS_IW = 104 * MiB;
constexpr size_t WS_R128 = 105 * MiB;
constexpr size_t WS_R64 = 107 * MiB;
constexpr size_t WS_MASK = 108 * MiB;
constexpr size_t WS_PROJ = 116 * MiB;
constexpr size_t WS_END = 364 * MiB;

#define WAVE_SYNC() asm volatile("s_waitcnt lgkmcnt(0)" ::: "memory")
typedef unsigned short bf16_t;
typedef float f32x4 __attribute__((ext_vector_type(4)));
typedef unsigned u32x4 __attribute__((ext_vector_type(4)));
typedef unsigned u32x2 __attribute__((ext_vector_type(2)));

__device__ __forceinline__ unsigned f2bf(float f) { unsigned u = __builtin_bit_cast(unsigned, f); return (u + 0x7fffu + ((u >> 16) & 1u)) >> 16; }
__device__ __forceinline__ float bf2f(unsigned h) { return __builtin_bit_cast(float, h << 16); }
__device__ __forceinline__ unsigned pk2(float lo, float hi) { return f2bf(lo) | (f2bf(hi) << 16); }
__device__ __forceinline__ float wave_sum(float v) {
#pragma unroll
    for (int o = 1; o < 64; o <<= 1) v += __shfl_xor(v, o);
    return v;
}
__device__ __forceinline__ float wave_max(float v) {
#pragma unroll
    for (int o = 1; o < 64; o <<= 1) v = fmaxf(v, __shfl_xor(v, o));
    return v;
}
__device__ __forceinline__ unsigned fkey(float f) { unsigned u = __builtin_bit_cast(unsigned, f); return (u & 0x80000000u) ? ~u : (u | 0x80000000u); }

__global__ void __launch_bounds__(256) k_rmsnorm_bf16(const float* __restrict__ x, const float* __restrict__ g, bf16_t* __restrict__ out) {
    const int lane = threadIdx.x & 63, row = blockIdx.x * 4 + (threadIdx.x >> 6);
    const f32x4* xr = (const f32x4*)(x + (size_t)row * DM) + lane;
    f32x4 v[8]; float s = 0.f;
#pragma unroll
    for (int j = 0; j < 8; ++j) { v[j] = xr[64 * j]; s += (v[j].x * v[j].x + v[j].y * v[j].y) + (v[j].z * v[j].z + v[j].w * v[j].w); }
    const float r = 1.0f / sqrtf(wave_sum(s) * (1.0f / DM) + EPS);
    const f32x4* gr = (const f32x4*)g + lane;
    u32x2* o = (u32x2*)(out + (size_t)row * DM) + lane;
#pragma unroll
    for (int j = 0; j < 8; ++j) { const f32x4 gg = gr[64 * j]; u32x2 w; w.x = pk2(v[j].x * r * gg.x, v[j].y * r * gg.y); w.y = pk2(v[j].z * r * gg.z, v[j].w * r * gg.w); o[64 * j] = w; }
}
__global__ void __launch_bounds__(256) k_transpose_bf16(const float* __restrict__ W, bf16_t* __restrict__ WT, int K, int N) {
    __shared__ float t[32][33];
    const int n0 = blockIdx.x * 32, k0 = blockIdx.y * 32, tx = threadIdx.x & 31, ty = threadIdx.x >> 5;
#pragma unroll
    for (int i = 0; i < 4; ++i) { const int k = k0 + ty + 8 * i, n = n0 + tx; t[ty + 8 * i][tx] = (n < N) ? W[(size_t)k * N + n] : 0.f; }
    __syncthreads();
#pragma unroll
    for (int i = 0; i < 4; ++i) { const int n = n0 + ty + 8 * i, k = k0 + tx; WT[(size_t)n * K + k] = (bf16_t)f2bf(t[tx][ty + 8 * i]); }
}
__global__ void __launch_bounds__(256) k_rope_tables(const int* __restrict__ pos, float* __restrict__ r128, float* __restrict__ r64) {
    const int i = blockIdx.x * 256 + threadIdx.x;
    if (i >= NTOK * 24) return;
    const int tok = i / 24, j = i % 24;
    const double p = (double)pos[tok];
    const double l2t = log2(500000.0);
    if (j < 16) { const double inv = exp2(-(double)j / 16.0 * l2t); const double a = p * (double)(float)inv; r128[tok * 32 + j] = (float)cos(a); r128[tok * 32 + 16 + j] = (float)sin(a); }
    else { const int jj = j - 16; const double inv = exp2(-(double)jj / 8.0 * l2t); const double a = p * (double)(float)inv; r64[tok * 16 + jj] = (float)cos(a); r64[tok * 16 + 8 + jj] = (float)sin(a); }
}

template <int MODE>
__global__ void __launch_bounds__(256) k_naive_gemm(const bf16_t* __restrict__ A, const bf16_t* __restrict__ Bt, int M, int N, int K,
                                                    bf16_t* __restrict__ proj, float* __restrict__ iw, const float* __restrict__ xres, float* __restrict__ out) {
    __shared__ float As[32][65], Bs[32][65];
    const int tid = threadIdx.x, tx = tid & 15, ty = tid >> 4, m0 = blockIdx.y * 64, n0 = blockIdx.x * 64;
    float acc[4][4] = {};
    const int lr = tid >> 2, lc = (tid & 3) * 8;
    for (int k0 = 0; k0 < K; k0 += 32) {
        const u32x4 av = *(const u32x4*)(A + (size_t)(m0 + lr) * K + k0 + lc);
        const u32x4 bv = *(const u32x4*)(Bt + (size_t)(n0 + lr) * K + k0 + lc);
        __syncthreads();
#pragma unroll
        for (int j = 0; j < 4; ++j) { As[lc + 2 * j][lr] = bf2f(av[j] & 0xffffu); As[lc + 2 * j + 1][lr] = bf2f(av[j] >> 16);
                                      Bs[lc + 2 * j][lr] = bf2f(bv[j] & 0xffffu); Bs[lc + 2 * j + 1][lr] = bf2f(bv[j] >> 16); }
        __syncthreads();
#pragma unroll 8
        for (int k = 0; k < 32; ++k) {
            float a[4], b[4];
#pragma unroll
            for (int i = 0; i < 4; ++i) { a[i] = As[k][ty * 4 + i]; b[i] = Bs[k][tx * 4 + i]; }
#pragma unroll
            for (int i = 0; i < 4; ++i)
#pragma unroll
                for (int j = 0; j < 4; ++j) acc[i][j] = fmaf(a[i], b[j], acc[i][j]);
        }
    }
#pragma unroll
    for (int i = 0; i < 4; ++i) {
        const int m = m0 + ty * 4 + i;
#pragma unroll
        for (int j = 0; j < 4; ++j) {
            const int n = n0 + tx * 4 + j; float v = acc[i][j];
            if (MODE == 0) {
                if (n < C_SBK || (n >= C_DQ && n < C_DK)) v *= C2;
                if (n >= C_IW && n < D_IN) iw[(size_t)m * 16 + (n - C_IW)] = v * IWS;
                proj[(size_t)m * NP + n] = (bf16_t)f2bf(v);
            } else {
                out[(size_t)m * N + n] = xres[(size_t)m * N + n] + v;
            }
        }
    }
}

__global__ void __launch_bounds__(256) k_naive_rope(bf16_t* __restrict__ proj, const float* __restrict__ r128, const float* __restrict__ r64) {
    const int i = blockIdx.x * 256 + threadIdx.x;
    if (i >= NTOK * 296) return;
    const int tok = i / 296; int p = i % 296; int c1, c2; float cs, sn;
    if (p < 128) { const int h = p / 16, j = p % 16; c1 = C_DQ + h * 128 + j; c2 = c1 + 16; cs = r128[tok * 32 + j]; sn = r128[tok * 32 + 16 + j]; }
    else if (p < 160) { p -= 128; const int h = p / 16, j = p % 16; c1 = C_DK + h * 128 + j; c2 = c1 + 16; cs = r128[tok * 32 + j]; sn = r128[tok * 32 + 16 + j]; }
    else if (p < 288) { p -= 160; const int h = p / 8, j = p % 8; c1 = C_IQ + h * 64 + j; c2 = c1 + 8; cs = r64[tok * 16 + j]; sn = r64[tok * 16 + 8 + j]; }
    else { p -= 288; c1 = C_IK + p; c2 = c1 + 8; cs = r64[tok * 16 + p]; sn = r64[tok * 16 + 8 + p]; }
    bf16_t* row = proj + (size_t)tok * NP;
    const float x1 = bf2f(row[c1]), x2 = bf2f(row[c2]);
    row[c1] = (bf16_t)f2bf(x1 * cs - x2 * sn); row[c2] = (bf16_t)f2bf(x2 * cs + x1 * sn);
}

__device__ __forceinline__ float softplus2(float z2) { return fmaxf(z2, 0.f) + __builtin_amdgcn_logf(1.0f + __builtin_amdgcn_exp2f(-fabsf(z2))); }
__device__ __forceinline__ float silu(float x) { return x / (1.0f + __expf(-x)); }

__global__ void __launch_bounds__(256) k_naive_sb(const bf16_t* __restrict__ proj, const float* __restrict__ gain, bf16_t* __restrict__ mixed) {
    __shared__ float qs[4][128]; __shared__ float wsh[4][64];
    const int lane = threadIdx.x & 63, w = threadIdx.x >> 6;
    const int gid = blockIdx.x * 4 + w;
    const int t = gid % SEQ, h = (gid / SEQ) % SBH, b = gid / (SEQ * SBH);
    const size_t tok = (size_t)b * SEQ + t;
    const bf16_t* qrow = proj + tok * NP + C_SBQ + h * HD;
    qs[w][lane] = bf2f(qrow[lane]); qs[w][lane + 64] = bf2f(qrow[lane + 64]);
    WAVE_SYNC();
    float o0 = 0.f, o1 = 0.f, R = 0.f;
    for (int c = (t - 1) >> 6; c >= 0 && t > 0; --c) {
        const int s = c * 64 + lane; const bool valid = s < t;
        float z2 = 0.f;
        if (valid) {
            const u32x4* kr = (const u32x4*)(proj + ((size_t)b * SEQ + s) * NP + C_SBK + h * HD);
#pragma unroll 4
            for (int j = 0; j < 16; ++j) { const u32x4 kv = kr[j];
#pragma unroll
                for (int e = 0; e < 4; ++e) { z2 = fmaf(qs[w][8 * j + 2 * e], bf2f(kv[e] & 0xffffu), z2); z2 = fmaf(qs[w][8 * j + 2 * e + 1], bf2f(kv[e] >> 16), z2); } }
        }
        const float sp = softplus2(z2);
        const float l1m = valid ? -sp : 0.f, lb = z2 - sp;
        float v = l1m;
#pragma unroll
        for (int off = 1; off < 64; off <<= 1) { const float tt = __shfl_down(v, off); if (lane + off < 64) v += tt; }
        const float wgt = valid ? __builtin_amdgcn_exp2f(lb + (v - l1m) + R) : 0.f;
        R += __shfl(v, 0);
        wsh[w][lane] = wgt;
        WAVE_SYNC();
        const bf16_t* vb = proj + ((size_t)b * SEQ + c * 64) * NP + C_SBV + h * HD + 2 * lane;
        const int ns = min(64, t - c * 64);
        for (int ss = 0; ss < ns; ++ss) { const unsigned vv = *(const unsigned*)(vb + (size_t)ss * NP); const float ww = wsh[w][ss]; o0 = fmaf(ww, bf2f(vv & 0xffffu), o0); o1 = fmaf(ww, bf2f(vv >> 16), o1); }
        WAVE_SYNC();
    }
    const float ss = wave_sum(o0 * o0 + o1 * o1);
    const float r = 1.0f / sqrtf(ss * (1.0f / HD) + EPS);
    const int d = 2 * lane;
    const unsigned gt = *(const unsigned*)(proj + tok * NP + C_SBG + h * HD + d);
    const float y0 = o0 * r * gain[h * HD + d] * silu(bf2f(gt & 0xffffu)), y1 = o1 * r * gain[h * HD + d + 1] * silu(bf2f(gt >> 16));
    *(unsigned*)(mixed + tok * DM + h * HD + d) = pk2(y0, y1);
}

__global__ void __launch_bounds__(128) k_naive_index(const bf16_t* __restrict__ proj, const float* __restrict__ iw, unsigned long long* __restrict__ mask) {
    __shared__ float qi[2][IH * ID]; __shared__ unsigned keys[2][SEQ]; __shared__ float wv[2][16];
    const int lane = threadIdx.x & 63, w = threadIdx.x >> 6;
    const int gq = blockIdx.x * 2 + w, t = gq % SEQ, b = gq / SEQ;
    const size_t tok = (size_t)gq;
    for (int i = lane; i < IH * ID; i += 64) qi[w][i] = bf2f(proj[tok * NP + C_IQ + i]);
    if (lane < 16) wv[w][lane] = iw[tok * 16 + lane];
    WAVE_SYNC();
    const int N = t + 1, nch = (N + 63) >> 6;
    for (int c = 0; c < nch; ++c) {
        const int s = c * 64 + lane; unsigned key = 0u;
        if (s <= t) {
            float kf[ID];
            const u32x4* kr = (const u32x4*)(proj + ((size_t)b * SEQ + s) * NP + C_IK);
#pragma unroll
            for (int j = 0; j < 8; ++j) { const u32x4 kv = kr[j];
#pragma unroll
                for (int e = 0; e < 4; ++e) { kf[8 * j + 2 * e] = bf2f(kv[e] & 0xffffu); kf[8 * j + 2 * e + 1] = bf2f(kv[e] >> 16); } }
            float sc = 0.f;
            for (int hh = 0; hh < IH; ++hh) { float d = 0.f;
#pragma unroll
                for (int e = 0; e < ID; ++e) d = fmaf(qi[w][hh * ID + e], kf[e], d);
                sc = fmaf(wv[w][hh], fmaxf(d, 0.f), sc); }
            key = fkey(sc);
        }
        keys[w][s] = key;
    }
    WAVE_SYNC();
    unsigned long long* mrow = mask + tok * 64;
    if (N <= TOPK) {
        for (int e = 0; e < 64; ++e) { const int s = e * 64 + lane; const unsigned long long bm = __ballot(s <= t); if (lane == 0) mrow[e] = bm; }
        return;
    }
    for (int e = 0; e < 64; ++e) {
        unsigned long long bm = 0ull;
        if (e < nch) {
            const int i = e * 64 + lane; const unsigned my = (i < N) ? keys[w][i] : 0u; int cnt = 0;
            for (int j = 0; j < N; ++j) { const unsigned kj = keys[w][j]; cnt += (kj > my || (kj == my && j < i)) ? 1 : 0; }
            bm = __ballot(i < N && cnt < TOPK);
        }
        if (lane == 0) mrow[e] = bm;
    }
}

__global__ void __launch_bounds__(256) k_naive_dsa(const bf16_t* __restrict__ proj, const unsigned long long* __restrict__ mask, const float* __restrict__ gain, bf16_t* __restrict__ mixed) {
    __shared__ float qs[4][128]; __shared__ float wsh[4][64];
    const int lane = threadIdx.x & 63, w = threadIdx.x >> 6;
    const int gid = blockIdx.x * 4 + w;
    const int t = gid % SEQ, h = (gid / SEQ) % DSH, b = gid / (SEQ * DSH), g = h / 4;
    const size_t tok = (size_t)b * SEQ + t;
    const bf16_t* qrow = proj + tok * NP + C_DQ + h * HD;
    qs[w][lane] = bf2f(qrow[lane]); qs[w][lane + 64] = bf2f(qrow[lane + 64]);
    WAVE_SYNC();
    float o0 = 0.f, o1 = 0.f, m = -1e30f, l = 0.f;
    const int nch = (t >> 6) + 1;
    for (int c = 0; c < nch; ++c) {
        const unsigned long long word = mask[tok * 64 + c];
        if (word == 0ull) continue;
        const int s = c * 64 + lane; const bool sel = (word >> lane) & 1ull;
        float s2 = -INFINITY;
        if (sel) { float z = 0.f;
            const u32x4* kr = (const u32x4*)(proj + ((size_t)b * SEQ + s) * NP + C_DK + g * HD);
#pragma unroll 4
            for (int j = 0; j < 16; ++j) { const u32x4 kv = kr[j];
#pragma unroll
                for (int e = 0; e < 4; ++e) { z = fmaf(qs[w][8 * j + 2 * e], bf2f(kv[e] & 0xffffu), z); z = fmaf(qs[w][8 * j + 2 * e + 1], bf2f(kv[e] >> 16), z); } }
            s2 = z; }
        const float mn = fmaxf(m, wave_max(s2));
        const float alpha = __builtin_amdgcn_exp2f(m - mn);
        const float p = sel ? __builtin_amdgcn_exp2f(s2 - mn) : 0.f;
        l = l * alpha + wave_sum(p); o0 *= alpha; o1 *= alpha; m = mn;
        wsh[w][lane] = p;
        WAVE_SYNC();
        const bf16_t* vb = proj + ((size_t)b * SEQ + c * 64) * NP + C_DV + g * HD + 2 * lane;
        for (int ss = 0; ss < 64; ++ss) { const float ww = wsh[w][ss]; if (ww != 0.f) { const unsigned vv = *(const unsigned*)(vb + (size_t)ss * NP); o0 = fmaf(ww, bf2f(vv & 0xffffu), o0); o1 = fmaf(ww, bf2f(vv >> 16), o1); } }
        WAVE_SYNC();
    }
    const float il = 1.0f / l; o0 *= il; o1 *= il;
    const float ss = wave_sum(o0 * o0 + o1 * o1);
    const float r = 1.0f / sqrtf(ss * (1.0f / HD) + EPS);
    const int d = 2 * lane;
    const unsigned gt = *(const unsigned*)(proj + tok * NP + C_DG + h * HD + d);
    const float y0 = o0 * r * gain[h * HD + d] * silu(bf2f(gt & 0xffffu)), y1 = o1 * r * gain[h * HD + d + 1] * silu(bf2f(gt >> 16));
    *(unsigned*)(mixed + tok * DM + 1024 + h * HD + d) = pk2(y0, y1);
}

__global__ void __launch_bounds__(256) k_final_norm(float* __restrict__ y, const float* __restrict__ g) {
    const int lane = threadIdx.x & 63, row = blockIdx.x * 4 + (threadIdx.x >> 6);
    f32x4* yr = (f32x4*)(y + (size_t)row * DM) + lane;
    f32x4 v[8]; float s = 0.f;
#pragma unroll
    for (int j = 0; j < 8; ++j) { v[j] = yr[64 * j]; s += (v[j].x * v[j].x + v[j].y * v[j].y) + (v[j].z * v[j].z + v[j].w * v[j].w); }
    const float r = 1.0f / sqrtf(wave_sum(s) * (1.0f / DM) + EPS);
    const f32x4* gr = (const f32x4*)g + lane;
#pragma unroll
    for (int j = 0; j < 8; ++j) { const f32x4 gg = gr[64 * j]; yr[64 * j] = (f32x4){v[j].x * r * gg.x, v[j].y * r * gg.y, v[j].z * r * gg.z, v[j].w * r * gg.w}; }
}

extern "C" void kernel_launch(void* const* d_in, const int* in_sizes, int n_in, void* d_out, int out_size, void* d_ws, size_t ws_size, hipStream_t stream) {
    if (n_in != 8 || in_sizes[0] != NTOK * DM || out_size != NTOK * DM || ws_size < WS_END) {
        fprintf(stderr, "kernel_launch: shape mismatch n_in %d in0 %d out %d ws %zu (need %zu)\n", n_in, n_in > 0 ? in_sizes[0] : -1, out_size, ws_size, (size_t)WS_END); return; }
    const float* x = (const float*)d_in[0]; const int* pos = (const int*)d_in[1]; const float* norm_g = (const float*)d_in[2]; const float* w_in = (const float*)d_in[3];
    const float* sb_g = (const float*)d_in[4]; const float* dsa_g = (const float*)d_in[5]; const float* w_out = (const float*)d_in[6]; const float* final_g = (const float*)d_in[7];
    unsigned char* ws = (unsigned char*)d_ws; float* out = (float*)d_out;
    bf16_t* HN = (bf16_t*)(ws + WS_HN); bf16_t* MIXED = (bf16_t*)(ws + WS_MIXED); bf16_t* WT1 = (bf16_t*)(ws + WS_WT1); bf16_t* WT2 = (bf16_t*)(ws + WS_WT2);
    float* IW = (float*)(ws + WS_IW); float* R128 = (float*)(ws + WS_R128); float* R64 = (float*)(ws + WS_R64);
    unsigned long long* MASK = (unsigned long long*)(ws + WS_MASK); bf16_t* PROJ = (bf16_t*)(ws + WS_PROJ);

    hipLaunchKernelGGL(k_rmsnorm_bf16, dim3(NTOK / 4), dim3(256), 0, stream, x, norm_g, HN);
    hipLaunchKernelGGL(k_transpose_bf16, dim3(NP / 32, DM / 32), dim3(256), 0, stream, w_in, WT1, DM, D_IN);
    hipLaunchKernelGGL(k_transpose_bf16, dim3(DM / 32, DM / 32), dim3(256), 0, stream, w_out, WT2, DM, DM);
    hipLaunchKernelGGL(k_rope_tables, dim3((NTOK * 24 + 255) / 256), dim3(256), 0, stream, pos, R128, R64);
    hipLaunchKernelGGL(k_naive_gemm<0>, dim3(NP / 64, NTOK / 64), dim3(256), 0, stream, (const bf16_t*)HN, (const bf16_t*)WT1, NTOK, NP, DM, PROJ, IW, (const float*)nullptr, (float*)nullptr);
    hipLaunchKernelGGL(k_naive_rope, dim3((NTOK * 296 + 255) / 256), dim3(256), 0, stream, PROJ, (const float*)R128, (const float*)R64);
    hipLaunchKernelGGL(k_naive_sb, dim3(BATCH * SBH * SEQ / 4), dim3(256), 0, stream, (const bf16_t*)PROJ, sb_g, MIXED);
    hipLaunchKernelGGL(k_naive_index, dim3(NTOK / 2), dim3(128), 0, stream, (const bf16_t*)PROJ, (const float*)IW, MASK);
    hipLaunchKernelGGL(k_naive_dsa, dim3(BATCH * DSH * SEQ / 4), dim3(256), 0, stream, (const bf16_t*)PROJ, (const unsigned long long*)MASK, dsa_g, MIXED);
    hipLaunchKernelGGL(k_naive_gemm<1>, dim3(DM / 64, NTOK / 64), dim3(256), 0, stream, (const bf16_t*)MIXED, (const bf16_t*)WT2, NTOK, DM, DM, (bf16_t*)nullptr, (float*)nullptr, x, out);
    hipLaunchKernelGGL(k_final_norm, dim3(NTOK / 4), dim3(256), 0, stream, out, final_g);
}
```

```cpp
#include <hip/hip_runtime.h>
#include <cstdio>
#include <cstdint>
#include <hip/hip_cooperative_groups.h>

constexpr int BATCH = 4, SEQ = 4096, DM = 2048, NTOK = BATCH * SEQ;
constexpr int HD = 128, SBH = 8, DSH = 8, DKV = 2, IH = 16, ID = 64, TOPK = 256;
constexpr int D_IN = 7760, NP = 7936;
constexpr int C_SBQ = 0, C_SBK = 1024, C_SBV = 2048, C_SBG = 3072, C_DQ = 4096, C_DK = 5120, C_DV = 5376, C_DG = 5632, C_IQ = 6656, C_IK = 7680, C_IW = 7744;
constexpr float EPS = 1e-6f;
constexpr float C2 = 0.08838834764831845f * 1.4426950408889634f;
constexpr float IWS = 1.0f / 32.0f;

constexpr size_t MiB = 1u << 20;
constexpr size_t WS_CTL = 0;
constexpr size_t WS_HN = 1 * MiB;
constexpr size_t WS_MIXED = WS_HN;
constexpr size_t WS_WT1 = 65 * MiB;
constexpr size_t WS_WT2 = 96 * MiB;
constexpr size_t WS_IW = 104 * MiB;
constexpr size_t WS_R128 = 105 * MiB;
constexpr size_t WS_R64 = 107 * MiB;
constexpr size_t WS_MASK = 108 * MiB;
constexpr size_t WS_PROJ = 116 * MiB;
constexpr size_t WS_SSP = 364 * MiB;
constexpr size_t WS_END = 366 * MiB;

#define WAVE_SYNC() asm volatile("s_waitcnt lgkmcnt(0)" ::: "memory")
typedef unsigned short bf16_t;
typedef float f32x4 __attribute__((ext_vector_type(4)));
typedef unsigned u32x4 __attribute__((ext_vector_type(4)));
typedef unsigned u32x2 __attribute__((ext_vector_type(2)));

__device__ __forceinline__ unsigned f2bf(float f) { unsigned u = __builtin_bit_cast(unsigned, f); return (u + 0x7fffu + ((u >> 16) & 1u)) >> 16; }
__device__ __forceinline__ float bf2f(unsigned h) { return __builtin_bit_cast(float, h << 16); }
__device__ __forceinline__ unsigned pk2(float lo, float hi) { return f2bf(lo) | (f2bf(hi) << 16); }
__device__ __forceinline__ float wave_sum(float v) {
#pragma unroll
    for (int o = 1; o < 64; o <<= 1) v += __shfl_xor(v, o);
    return v;
}
__device__ __forceinline__ float wave_max(float v) {
#pragma unroll
    for (int o = 1; o < 64; o <<= 1) v = fmaxf(v, __shfl_xor(v, o));
    return v;
}
__device__ __forceinline__ unsigned fkey(float f) { unsigned u = __builtin_bit_cast(unsigned, f); return (u & 0x80000000u) ? ~u : (u | 0x80000000u); }

__global__ void __launch_bounds__(256) k_rmsnorm_bf16(const float* __restrict__ x, const float* __restrict__ g, bf16_t* __restrict__ out) {
    const int lane = threadIdx.x & 63, row = blockIdx.x * 4 + (threadIdx.x >> 6);
    const f32x4* xr = (const f32x4*)(x + (size_t)row * DM) + lane;
    f32x4 v[8]; float s = 0.f;
#pragma unroll
    for (int j = 0; j < 8; ++j) { v[j] = xr[64 * j]; s += (v[j].x * v[j].x + v[j].y * v[j].y) + (v[j].z * v[j].z + v[j].w * v[j].w); }
    const float r = 1.0f / sqrtf(wave_sum(s) * (1.0f / DM) + EPS);
    const f32x4* gr = (const f32x4*)g + lane;
    u32x2* o = (u32x2*)(out + (size_t)row * DM) + lane;
#pragma unroll
    for (int j = 0; j < 8; ++j) { const f32x4 gg = gr[64 * j]; u32x2 w; w.x = pk2(v[j].x * r * gg.x, v[j].y * r * gg.y); w.y = pk2(v[j].z * r * gg.z, v[j].w * r * gg.w); o[64 * j] = w; }
}
__global__ void __launch_bounds__(256) k_transpose_bf16(const float* __restrict__ W, bf16_t* __restrict__ WT, int K, int N) {
    __shared__ float t[32][33];
    const int n0 = blockIdx.x * 32, k0 = blockIdx.y * 32, tx = threadIdx.x & 31, ty = threadIdx.x >> 5;
#pragma unroll
    for (int i = 0; i < 4; ++i) { const int k = k0 + ty + 8 * i, n = n0 + tx; t[ty + 8 * i][tx] = (n < N) ? W[(size_t)k * N + n] : 0.f; }
    __syncthreads();
#pragma unroll
    for (int i = 0; i < 4; ++i) { const int n = n0 + ty + 8 * i, k = k0 + tx; WT[(size_t)n * K + k] = (bf16_t)f2bf(t[tx][ty + 8 * i]); }
}
__global__ void __launch_bounds__(256) k_rope_tables(const int* __restrict__ pos, float* __restrict__ r128, float* __restrict__ r64) {
    const int i = blockIdx.x * 256 + threadIdx.x;
    if (i >= NTOK * 24) return;
    const int tok = i / 24, j = i % 24;
    const double p = (double)pos[tok];
    const double l2t = log2(500000.0);
    if (j < 16) { const double inv = exp2(-(double)j / 16.0 * l2t); const double a = p * (double)(float)inv; r128[tok * 32 + j] = (float)cos(a); r128[tok * 32 + 16 + j] = (float)sin(a); }
    else { const int jj = j - 16; const double inv = exp2(-(double)jj / 8.0 * l2t); const double a = p * (double)(float)inv; r64[tok * 16 + jj] = (float)cos(a); r64[tok * 16 + 8 + jj] = (float)sin(a); }
}

template <int MODE>
__global__ void __launch_bounds__(256) k_naive_gemm(const bf16_t* __restrict__ A, const bf16_t* __restrict__ Bt, int M, int N, int K,
                                                    bf16_t* __restrict__ proj, float* __restrict__ iw, const float* __restrict__ xres, float* __restrict__ out) {
    __shared__ float As[32][65], Bs[32][65];
    const int tid = threadIdx.x, tx = tid & 15, ty = tid >> 4, m0 = blockIdx.y * 64, n0 = blockIdx.x * 64;
    float acc[4][4] = {};
    const int lr = tid >> 2, lc = (tid & 3) * 8;
    for (int k0 = 0; k0 < K; k0 += 32) {
        const u32x4 av = *(const u32x4*)(A + (size_t)(m0 + lr) * K + k0 + lc);
        const u32x4 bv = *(const u32x4*)(Bt + (size_t)(n0 + lr) * K + k0 + lc);
        __syncthreads();
#pragma unroll
        for (int j = 0; j < 4; ++j) { As[lc + 2 * j][lr] = bf2f(av[j] & 0xffffu); As[lc + 2 * j + 1][lr] = bf2f(av[j] >> 16);
                                      Bs[lc + 2 * j][lr] = bf2f(bv[j] & 0xffffu); Bs[lc + 2 * j + 1][lr] = bf2f(bv[j] >> 16); }
        __syncthreads();
#pragma unroll 8
        for (int k = 0; k < 32; ++k) {
            float a[4], b[4];
#pragma unroll
            for (int i = 0; i < 4; ++i) { a[i] = As[k][ty * 4 + i]; b[i] = Bs[k][tx * 4 + i]; }
#pragma unroll
            for (int i = 0; i < 4; ++i)
#pragma unroll
                for (int j = 0; j < 4; ++j) acc[i][j] = fmaf(a[i], b[j], acc[i][j]);
        }
    }
#pragma unroll
    for (int i = 0; i < 4; ++i) {
        const int m = m0 + ty * 4 + i;
#pragma unroll
        for (int j = 0; j < 4; ++j) {
            const int n = n0 + tx * 4 + j; float v = acc[i][j];
            if (MODE == 0) {
                if (n < C_SBK || (n >= C_DQ && n < C_DK)) v *= C2;
                if (n >= C_IW && n < D_IN) iw[(size_t)m * 16 + (n - C_IW)] = v * IWS;
                proj[(size_t)m * NP + n] = (bf16_t)f2bf(v);
            } else {
                out[(size_t)m * N + n] = xres[(size_t)m * N + n] + v;
            }
        }
    }
}

__global__ void __launch_bounds__(256) k_naive_rope(bf16_t* __restrict__ proj, const float* __restrict__ r128, const float* __restrict__ r64) {
    const int i = blockIdx.x * 256 + threadIdx.x;
    if (i >= NTOK * 296) return;
    const int tok = i / 296; int p = i % 296; int c1, c2; float cs, sn;
    if (p < 128) { const int h = p / 16, j = p % 16; c1 = C_DQ + h * 128 + j; c2 = c1 + 16; cs = r128[tok * 32 + j]; sn = r128[tok * 32 + 16 + j]; }
    else if (p < 160) { p -= 128; const int h = p / 16, j = p % 16; c1 = C_DK + h * 128 + j; c2 = c1 + 16; cs = r128[tok * 32 + j]; sn = r128[tok * 32 + 16 + j]; }
    else if (p < 288) { p -= 160; const int h = p / 8, j = p % 8; c1 = C_IQ + h * 64 + j; c2 = c1 + 8; cs = r64[tok * 16 + j]; sn = r64[tok * 16 + 8 + j]; }
    else { p -= 288; c1 = C_IK + p; c2 = c1 + 8; cs = r64[tok * 16 + p]; sn = r64[tok * 16 + 8 + p]; }
    bf16_t* row = proj + (size_t)tok * NP;
    const float x1 = bf2f(row[c1]), x2 = bf2f(row[c2]);
    row[c1] = (bf16_t)f2bf(x1 * cs - x2 * sn); row[c2] = (bf16_t)f2bf(x2 * cs + x1 * sn);
}

__device__ __forceinline__ float softplus2(float z2) { return fmaxf(z2, 0.f) + __builtin_amdgcn_logf(1.0f + __builtin_amdgcn_exp2f(-fabsf(z2))); }
__device__ __forceinline__ float silu(float x) { return x / (1.0f + __expf(-x)); }

__global__ void __launch_bounds__(256) k_naive_sb(const bf16_t* __restrict__ proj, const float* __restrict__ gain, bf16_t* __restrict__ mixed) {
    __shared__ float qs[4][128]; __shared__ float wsh[4][64];
    const int lane = threadIdx.x & 63, w = threadIdx.x >> 6;
    const int gid = blockIdx.x * 4 + w;
    const int t = gid % SEQ, h = (gid / SEQ) % SBH, b = gid / (SEQ * SBH);
    const size_t tok = (size_t)b * SEQ + t;
    const bf16_t* qrow = proj + tok * NP + C_SBQ + h * HD;
    qs[w][lane] = bf2f(qrow[lane]); qs[w][lane + 64] = bf2f(qrow[lane + 64]);
    WAVE_SYNC();
    float o0 = 0.f, o1 = 0.f, R = 0.f;
    for (int c = (t - 1) >> 6; c >= 0 && t > 0; --c) {
        const int s = c * 64 + lane; const bool valid = s < t;
        float z2 = 0.f;
        if (valid) {
            const u32x4* kr = (const u32x4*)(proj + ((size_t)b * SEQ + s) * NP + C_SBK + h * HD);
#pragma unroll 4
            for (int j = 0; j < 16; ++j) { const u32x4 kv = kr[j];
#pragma unroll
                for (int e = 0; e < 4; ++e) { z2 = fmaf(qs[w][8 * j + 2 * e], bf2f(kv[e] & 0xffffu), z2); z2 = fmaf(qs[w][8 * j + 2 * e + 1], bf2f(kv[e] >> 16), z2); } }
        }
        const float sp = softplus2(z2);
        const float l1m = valid ? -sp : 0.f, lb = z2 - sp;
        float v = l1m;
#pragma unroll
        for (int off = 1; off < 64; off <<= 1) { const float tt = __shfl_down(v, off); if (lane + off < 64) v += tt; }
        const float wgt = valid ? __builtin_amdgcn_exp2f(lb + (v - l1m) + R) : 0.f;
        R += __shfl(v, 0);
        wsh[w][lane] = wgt;
        WAVE_SYNC();
        const bf16_t* vb = proj + ((size_t)b * SEQ + c * 64) * NP + C_SBV + h * HD + 2 * lane;
        const int ns = min(64, t - c * 64);
        for (int ss = 0; ss < ns; ++ss) { const unsigned vv = *(const unsigned*)(vb + (size_t)ss * NP); const float ww = wsh[w][ss]; o0 = fmaf(ww, bf2f(vv & 0xffffu), o0); o1 = fmaf(ww, bf2f(vv >> 16), o1); }
        WAVE_SYNC();
    }
    const float ss = wave_sum(o0 * o0 + o1 * o1);
    const float r = 1.0f / sqrtf(ss * (1.0f / HD) + EPS);
    const int d = 2 * lane;
    const unsigned gt = *(const unsigned*)(proj + tok * NP + C_SBG + h * HD + d);
    const float y0 = o0 * r * gain[h * HD + d] * silu(bf2f(gt & 0xffffu)), y1 = o1 * r * gain[h * HD + d + 1] * silu(bf2f(gt >> 16));
    *(unsigned*)(mixed + tok * DM + h * HD + d) = pk2(y0, y1);
}

__global__ void __launch_bounds__(128) k_naive_index(const bf16_t* __restrict__ proj, const float* __restrict__ iw, unsigned long long* __restrict__ mask) {
    __shared__ float qi[2][IH * ID]; __shared__ unsigned keys[2][SEQ]; __shared__ float wv[2][16];
    const int lane = threadIdx.x & 63, w = threadIdx.x >> 6;
    const int gq = blockIdx.x * 2 + w, t = gq % SEQ, b = gq / SEQ;
    const size_t tok = (size_t)gq;
    for (int i = lane; i < IH * ID; i += 64) qi[w][i] = bf2f(proj[tok * NP + C_IQ + i]);
    if (lane < 16) wv[w][lane] = iw[tok * 16 + lane];
    WAVE_SYNC();
    const int N = t + 1, nch = (N + 63) >> 6;
    for (int c = 0; c < nch; ++c) {
        const int s = c * 64 + lane; unsigned key = 0u;
        if (s <= t) {
            float kf[ID];
            const u32x4* kr = (const u32x4*)(proj + ((size_t)b * SEQ + s) * NP + C_IK);
#pragma unroll
            for (int j = 0; j < 8; ++j) { const u32x4 kv = kr[j];
#pragma unroll
                for (int e = 0; e < 4; ++e) { kf[8 * j + 2 * e] = bf2f(kv[e] & 0xffffu); kf[8 * j + 2 * e + 1] = bf2f(kv[e] >> 16); } }
            float sc = 0.f;
            for (int hh = 0; hh < IH; ++hh) { float d = 0.f;
#pragma unroll
                for (int e = 0; e < ID; ++e) d = fmaf(qi[w][hh * ID + e], kf[e], d);
                sc = fmaf(wv[w][hh], fmaxf(d, 0.f), sc); }
            key = fkey(sc);
        }
        keys[w][s] = key;
    }
    WAVE_SYNC();
    unsigned long long* mrow = mask + tok * 64;
    if (N <= TOPK) {
        for (int e = 0; e < 64; ++e) { const int s = e * 64 + lane; const unsigned long long bm = __ballot(s <= t); if (lane == 0) mrow[e] = bm; }
        return;
    }
    for (int e = 0; e < 64; ++e) {
        unsigned long long bm = 0ull;
        if (e < nch) {
            const int i = e * 64 + lane; const unsigned my = (i < N) ? keys[w][i] : 0u; int cnt = 0;
            for (int j = 0; j < N; ++j) { const unsigned kj = keys[w][j]; cnt += (kj > my || (kj == my && j < i)) ? 1 : 0; }
            bm = __ballot(i < N && cnt < TOPK);
        }
        if (lane == 0) mrow[e] = bm;
    }
}

__global__ void __launch_bounds__(256) k_naive_dsa(const bf16_t* __restrict__ proj, const unsigned long long* __restrict__ mask, const float* __restrict__ gain, bf16_t* __restrict__ mixed) {
    __shared__ float qs[4][128]; __shared__ float wsh[4][64];
    const int lane = threadIdx.x & 63, w = threadIdx.x >> 6;
    const int gid = blockIdx.x * 4 + w;
    const int t = gid % SEQ, h = (gid / SEQ) % DSH, b = gid / (SEQ * DSH), g = h / 4;
    const size_t tok = (size_t)b * SEQ + t;
    const bf16_t* qrow = proj + tok * NP + C_DQ + h * HD;
    qs[w][lane] = bf2f(qrow[lane]); qs[w][lane + 64] = bf2f(qrow[lane + 64]);
    WAVE_SYNC();
    float o0 = 0.f, o1 = 0.f, m = -1e30f, l = 0.f;
    const int nch = (t >> 6) + 1;
    for (int c = 0; c < nch; ++c) {
        const unsigned long long word = mask[tok * 64 + c];
        if (word == 0ull) continue;
        const int s = c * 64 + lane; const bool sel = (word >> lane) & 1ull;
        float s2 = -INFINITY;
        if (sel) { float z = 0.f;
            const u32x4* kr = (const u32x4*)(proj + ((size_t)b * SEQ + s) * NP + C_DK + g * HD);
#pragma unroll 4
            for (int j = 0; j < 16; ++j) { const u32x4 kv = kr[j];
#pragma unroll
                for (int e = 0; e < 4; ++e) { z = fmaf(qs[w][8 * j + 2 * e], bf2f(kv[e] & 0xffffu), z); z = fmaf(qs[w][8 * j + 2 * e + 1], bf2f(kv[e] >> 16), z); } }
            s2 = z; }
        const float mn = fmaxf(m, wave_max(s2));
        const float alpha = __builtin_amdgcn_exp2f(m - mn);
        const float p = sel ? __builtin_amdgcn_exp2f(s2 - mn) : 0.f;
        l = l * alpha + wave_sum(p); o0 *= alpha; o1 *= alpha; m = mn;
        wsh[w][lane] = p;
        WAVE_SYNC();
        const bf16_t* vb = proj + ((size_t)b * SEQ + c * 64) * NP + C_DV + g * HD + 2 * lane;
        for (int ss = 0; ss < 64; ++ss) { const float ww = wsh[w][ss]; if (ww != 0.f) { const unsigned vv = *(const unsigned*)(vb + (size_t)ss * NP); o0 = fmaf(ww, bf2f(vv & 0xffffu), o0); o1 = fmaf(ww, bf2f(vv >> 16), o1); } }
        WAVE_SYNC();
    }
    const float il = 1.0f / l; o0 *= il; o1 *= il;
    const float ss = wave_sum(o0 * o0 + o1 * o1);
    const float r = 1.0f / sqrtf(ss * (1.0f / HD) + EPS);
    const int d = 2 * lane;
    const unsigned gt = *(const unsigned*)(proj + tok * NP + C_DG + h * HD + d);
    const float y0 = o0 * r * gain[h * HD + d] * silu(bf2f(gt & 0xffffu)), y1 = o1 * r * gain[h * HD + d + 1] * silu(bf2f(gt >> 16));
    *(unsigned*)(mixed + tok * DM + 1024 + h * HD + d) = pk2(y0, y1);
}

__global__ void __launch_bounds__(256) k_final_norm(float* __restrict__ y, const float* __restrict__ g) {
    const int lane = threadIdx.x & 63, row = blockIdx.x * 4 + (threadIdx.x >> 6);
    f32x4* yr = (f32x4*)(y + (size_t)row * DM) + lane;
    f32x4 v[8]; float s = 0.f;
#pragma unroll
    for (int j = 0; j < 8; ++j) { v[j] = yr[64 * j]; s += (v[j].x * v[j].x + v[j].y * v[j].y) + (v[j].z * v[j].z + v[j].w * v[j].w); }
    const float r = 1.0f / sqrtf(wave_sum(s) * (1.0f / DM) + EPS);
    const f32x4* gr = (const f32x4*)g + lane;
#pragma unroll
    for (int j = 0; j < 8; ++j) { const f32x4 gg = gr[64 * j]; yr[64 * j] = (f32x4){v[j].x * r * gg.x, v[j].y * r * gg.y, v[j].z * r * gg.z, v[j].w * r * gg.w}; }
}


namespace pg8 {
#define PG8_LAS __attribute__((address_space(3)))
typedef unsigned short bf16_t;
typedef short bf16x8 __attribute__((ext_vector_type(8)));
typedef float f32x4 __attribute__((ext_vector_type(4)));
typedef unsigned u32x4 __attribute__((ext_vector_type(4)));
constexpr int BM = 256, BK = 64, HALF = 128, HTB = HALF * BK * 2  , STAGE_BYTES = 8 * HTB, NXCD = 8, WGM = 8;

__host__ __device__ __forceinline__ int lds_byte(int r, int c) { const int st = (r >> 4) * 2 + (c >> 5), rr = r & 15, cc = c & 31, ob = rr * 64 + cc * 2; return st * 1024 + (ob ^ (((ob >> 9) & 1) << 5)); }
__host__ __device__ __forceinline__ void stage_rc(int b, int& R, int& C) { const int st = b / 1024, sb = b % 1024, swz = sb ^ (((sb >> 9) & 1) << 5); R = (st >> 1) * 16 + swz / 64; C = (st & 1) * 32 + (swz % 64) / 2; }
__host__ __device__ __forceinline__ int perm32(int rho) { const int n = rho >> 4, i = rho & 15; return 8 * (i >> 2) + 4 * n + (i & 3); }

struct Unit { int pm, pn; };
struct Gemm { const bf16_t* A; const bf16_t* Bt; int M, N, K; };

struct StaticOrder {
    int nM, nN, nwg, G, c;
    __host__ __device__ void init(int M, int N, int G_, int c_) { nM = M / BM; nN = N / BM; nwg = nM * nN; G = G_; c = c_; }
    __host__ __device__ bool next(int i, Unit& u) const {
        const long L = (long)i * G + c; if (L >= nwg) return false;
        int wgid = (int)L; { const int q = nwg / NXCD, r = nwg % NXCD, xcd = wgid % NXCD, off = wgid / NXCD; wgid = (xcd < r ? xcd * (q + 1) : r * (q + 1) + (xcd - r) * q) + off; }
        const int nig = WGM * nN, gid = wgid / nig, fm = gid * WGM, gsz = (nM - fm) < WGM ? (nM - fm) : WGM;
        u.pm = fm + ((wgid % nig) % gsz); u.pn = (wgid % nig) / gsz; return true;
    }
    __device__ __forceinline__ void a_ready(const Unit&) const {}
    __device__ __forceinline__ void done(const Unit&) const {}
};
}

namespace pg8 {
__device__ __forceinline__ unsigned cvt_pk_bf16(float lo, float hi) { unsigned r; asm volatile("v_cvt_pk_bf16_f32 %0, %1, %2" : "=v"(r) : "v"(lo), "v"(hi)); return r; }
struct EpiProj {
    static constexpr bool PERM = true, AFTER_DRAIN = false;
    bf16_t* proj; float* iw; const float* r128; const float* r64;
    __device__ __forceinline__ void operator()(const f32x4 (&acc)[2][2][4][2], const Unit& u, int wr, int wc, int fr, int fq) const {
        const int pn = u.pn;
        const int row0 = u.pm * BM + wr * 64 + fr, col0 = pn * BM + wc * 32 + 8 * fq;
        const bool rope128 = (pn >= 16 && pn <= 20) && wc == 0;
        const bool rope64 = ((pn >= 26 && pn <= 29) && (wc & 1) == 0) || (pn == 30 && wc == 0);
        const bool iwt = (pn == 30 && wc == 2);
        const float sc = (pn < 4 || (pn >= 16 && pn < 20)) ? C2 : 1.f;
#pragma unroll
        for (int ai = 0; ai < 2; ++ai)
#pragma unroll
            for (int m = 0; m < 4; ++m) {
                const int row = row0 + ai * HALF + m * 16;
                f32x4 cs0 = {1.f, 1.f, 1.f, 1.f}, cs1 = cs0, sn0 = {0.f, 0.f, 0.f, 0.f}, sn1 = sn0;
                if (rope128) { const float* t = r128 + (size_t)row * 32 + 8 * (fq & 1); cs0 = *(const f32x4*)t; cs1 = *(const f32x4*)(t + 4); sn0 = *(const f32x4*)(t + 16); sn1 = *(const f32x4*)(t + 20);
                    if (fq < 2) { sn0 = -sn0; sn1 = -sn1; } }
                if (rope64) { const float* t = r64 + (size_t)row * 16; cs0 = *(const f32x4*)t; cs1 = *(const f32x4*)(t + 4); sn0 = *(const f32x4*)(t + 8); sn1 = *(const f32x4*)(t + 12);
                    if (fq == 0) { sn0 = -sn0; sn1 = -sn1; } if (fq >= 2) { cs0 = (f32x4){1.f, 1.f, 1.f, 1.f}; cs1 = cs0; sn0 = (f32x4){0.f, 0.f, 0.f, 0.f}; sn1 = sn0; } }
                bf16_t* rowp = proj + (size_t)row * NP + col0;
#pragma unroll
                for (int bj = 0; bj < 2; ++bj) {
                    f32x4 v0 = acc[ai][bj][m][0] * sc, v1 = acc[ai][bj][m][1] * sc;
                    if (rope128 || (rope64 && (pn != 30 || bj == 0))) {
                        const int xm = rope128 ? 32 : 16;
                        f32x4 p0, p1;
#pragma unroll
                        for (int e = 0; e < 4; ++e) { p0[e] = __shfl_xor(v0[e], xm); p1[e] = __shfl_xor(v1[e], xm); }
                        v0 = v0 * cs0 + p0 * sn0; v1 = v1 * cs1 + p1 * sn1;
                    }
                    if (iwt && bj == 0 && fq < 2) { float* ip = iw + (size_t)row * 16 + 8 * fq; *(f32x4*)ip = v0 * IWS; *(f32x4*)(ip + 4) = v1 * IWS; }
                    u32x4 w; w.x = cvt_pk_bf16(v0[0], v0[1]); w.y = cvt_pk_bf16(v0[2], v0[3]); w.z = cvt_pk_bf16(v1[0], v1[1]); w.w = cvt_pk_bf16(v1[2], v1[3]);
                    *(u32x4*)(rowp + bj * HALF) = w;
                }
            }
    }
};
}

namespace pg8 {
struct EpiOut {
    static constexpr bool PERM = true, AFTER_DRAIN = false;
    const float* x; float* out; float* ssp;
    __device__ __forceinline__ void operator()(const f32x4 (&acc)[2][2][4][2], const Unit& u, int wr, int wc, int fr, int fq) const {
        const int row0 = u.pm * BM + wr * 64 + fr, col0 = u.pn * BM + wc * 32 + 8 * fq;
#pragma unroll
        for (int ai = 0; ai < 2; ++ai)
#pragma unroll
            for (int m = 0; m < 4; ++m) {
                const int row = row0 + ai * HALF + m * 16; const size_t off = (size_t)row * DM + col0; float s = 0.f;
#pragma unroll
                for (int bj = 0; bj < 2; ++bj) {
                    const f32x4 y0 = *(const f32x4*)(x + off + bj * HALF) + acc[ai][bj][m][0], y1 = *(const f32x4*)(x + off + bj * HALF + 4) + acc[ai][bj][m][1];
                    *(f32x4*)(out + off + bj * HALF) = y0; *(f32x4*)(out + off + bj * HALF + 4) = y1;
                    s += (y0[0] * y0[0] + y0[1] * y0[1]) + (y0[2] * y0[2] + y0[3] * y0[3]) + (y1[0] * y1[0] + y1[1] * y1[1]) + (y1[2] * y1[2] + y1[3] * y1[3]);
                }
                s += __shfl_xor(s, 16); s += __shfl_xor(s, 32);
                if (fq == 0) ssp[(size_t)row * 32 + u.pn * 4 + wc] = s;
            }
    }
};
}
namespace pg8 {
template <class Epi, class Sched, bool ALIGN_EPI = false, bool SP2 = false>
__device__ __forceinline__ void gemm_phase(PG8_LAS unsigned char* lds, const Gemm g, const Sched& S, const Epi& E) {
    const int tid = threadIdx.x, wid = __builtin_amdgcn_readfirstlane(tid >> 6), lane = tid & 63, wr = wid >> 2, wc = wid & 3, fr = lane & 15, fq = lane >> 4;
    const int K = g.K, nt = K / BK;
    unsigned voffA[2], voffB[2];
#pragma unroll
    for (int i = 0; i < 2; ++i) { int R, C; stage_rc(tid * 16 + i * 8192, R, C); const int Rb = Epi::PERM ? ((R & ~31) + perm32(R & 31)) : R;
        voffA[i] = (unsigned)(R * K + C) * 2u; voffB[i] = (unsigned)(Rb * K + C) * 2u; }
    const size_t kstep = (size_t)(BK * 2);
    const size_t hstep = (size_t)HALF * K * 2;
    const size_t tstep = 2 * hstep;
    const unsigned ldsw = (unsigned)wid * 1024u;
    const int aoff = lds_byte(wr * 64 + fr, fq * 8), boff = lds_byte(wc * 32 + fr, fq * 8);
#define PG8_SA(b, h) (((b) * 2 + (h)) * HTB)
#define PG8_SB(b, h) ((4 + (b) * 2 + (h)) * HTB)
#define PG8_STAGE(bufoff, gbase, voff) do { _Pragma("unroll") for (int _i = 0; _i < 2; ++_i) \
        __builtin_amdgcn_global_load_lds((const unsigned*)((const char*)(gbase) + (voff)[_i]), (PG8_LAS unsigned*)(lds + (bufoff) + ldsw + _i * 8192), 16, 0, 0); } while (0)
#define PG8_LDA(dst, b, h) do { _Pragma("unroll") for (int m = 0; m < 4; ++m) _Pragma("unroll") for (int k = 0; k < 2; ++k) dst[m][k] = *(const PG8_LAS bf16x8*)(lds + PG8_SA(b, h) + aoff + m * 2048 + k * 1024); } while (0)
#define PG8_LDB(dst, b, h) do { _Pragma("unroll") for (int n = 0; n < 2; ++n) _Pragma("unroll") for (int k = 0; k < 2; ++k) dst[n][k] = *(const PG8_LAS bf16x8*)(lds + PG8_SB(b, h) + boff + n * 2048 + k * 1024); } while (0)
#define PG8_MMA(ai, bj, At, Bt) do { __builtin_amdgcn_s_setprio(1); _Pragma("unroll") for (int m = 0; m < 4; ++m) _Pragma("unroll") for (int n = 0; n < 2; ++n) _Pragma("unroll") for (int k = 0; k < 2; ++k) \
        acc[ai][bj][m][n] = __builtin_amdgcn_mfma_f32_16x16x32_bf16(Bt[n][k], At[m][k], acc[ai][bj][m][n], 0, 0, 0); __builtin_amdgcn_s_setprio(0); } while (0)
#define PG8_WAIT_V(n) asm volatile("s_waitcnt vmcnt(" #n ")" ::: "memory")
#define PG8_WAIT_L(n) asm volatile("s_waitcnt lgkmcnt(" #n ")" ::: "memory")
#define PG8_BAR __builtin_amdgcn_s_barrier()
#define PG8_SCHED __builtin_amdgcn_sched_barrier(0)
    Unit cur, nxt; int ui = 0;
    if (!S.next(0, cur)) return;
    f32x4 acc[2][2][4][2];
#pragma unroll
    for (int a = 0; a < 2; ++a)
#pragma unroll
        for (int b = 0; b < 2; ++b)
#pragma unroll
            for (int m = 0; m < 4; ++m)
#pragma unroll
                for (int n = 0; n < 2; ++n) acc[a][b][m][n] = (f32x4){0.f, 0.f, 0.f, 0.f};
    bf16x8 At[4][2], B0[2][2], B1[2][2];
    const char* cA = (const char*)g.A + (size_t)cur.pm * tstep; const char* cB = (const char*)g.Bt + (size_t)cur.pn * tstep;
    S.a_ready(cur);
    if constexpr (SP2) {
        PG8_STAGE(PG8_SB(0, 0), cB, voffB); PG8_STAGE(PG8_SB(0, 1), cB + hstep, voffB); PG8_STAGE(PG8_SA(0, 0), cA, voffA); PG8_STAGE(PG8_SA(0, 1), cA + hstep, voffA);
        if (wr == 1) PG8_BAR;
        PG8_WAIT_V(2); PG8_BAR;
        PG8_STAGE(PG8_SB(1, 0), cB + kstep, voffB); PG8_STAGE(PG8_SA(1, 0), cA + kstep, voffA); PG8_STAGE(PG8_SB(1, 1), cB + hstep + kstep, voffB);
        PG8_WAIT_V(6); PG8_BAR;
    } else {
        PG8_STAGE(PG8_SB(0, 0), cB, voffB); PG8_STAGE(PG8_SA(0, 0), cA, voffA); PG8_STAGE(PG8_SB(0, 1), cB + hstep, voffB); PG8_STAGE(PG8_SA(0, 1), cA + hstep, voffA);
        if (wr == 1) PG8_BAR;
        PG8_WAIT_V(4); PG8_BAR;
        PG8_STAGE(PG8_SB(1, 0), cB + kstep, voffB); PG8_STAGE(PG8_SA(1, 0), cA + kstep, voffA); PG8_STAGE(PG8_SB(1, 1), cB + hstep + kstep, voffB);
        PG8_WAIT_V(6); PG8_BAR;
    }
    for (;;) {
        const bool has_next = S.next(ui + 1, nxt);
        const char* nA = has_next ? (const char*)g.A + (size_t)nxt.pm * tstep : cA; const char* nB = has_next ? (const char*)g.Bt + (size_t)nxt.pn * tstep : cB;
        for (int t = 0; t < nt; t += 2) {
            const bool last = (t == nt - 2);
            const char* a1 = cA + (size_t)(t + 1) * kstep;
            const char* a2 = last ? nA : cA + (size_t)(t + 2) * kstep; const char* b2 = last ? nB : cB + (size_t)(t + 2) * kstep;
            const char* a3 = a2 + kstep; const char* b3 = b2 + kstep;
            if (last && has_next) S.a_ready(nxt);
            if constexpr (SP2) {
            PG8_LDB(B0, 0, 0); PG8_LDB(B1, 0, 1); PG8_SCHED; PG8_LDA(At, 0, 0); PG8_STAGE(PG8_SA(1, 1), a1 + hstep, voffA);
            PG8_WAIT_V(8); PG8_WAIT_L(0); PG8_BAR; PG8_MMA(0, 0, At, B0); PG8_MMA(0, 1, At, B1); PG8_BAR; PG8_SCHED;
            PG8_LDA(At, 0, 1); PG8_STAGE(PG8_SB(0, 0), b2, voffB); PG8_STAGE(PG8_SB(0, 1), b2 + hstep, voffB); PG8_STAGE(PG8_SA(0, 0), a2, voffA);
            PG8_WAIT_V(8); PG8_WAIT_L(0); PG8_BAR; PG8_MMA(1, 0, At, B0); PG8_MMA(1, 1, At, B1); PG8_BAR; PG8_SCHED;
            PG8_LDB(B0, 1, 0); PG8_LDB(B1, 1, 1); PG8_SCHED; PG8_LDA(At, 1, 0); PG8_STAGE(PG8_SA(0, 1), a2 + hstep, voffA);
            PG8_WAIT_V(8); PG8_WAIT_L(0); PG8_BAR; PG8_MMA(0, 0, At, B0); PG8_MMA(0, 1, At, B1); PG8_BAR; PG8_SCHED;
            PG8_LDA(At, 1, 1); PG8_STAGE(PG8_SB(1, 0), b3, voffB); PG8_STAGE(PG8_SB(1, 1), b3 + hstep, voffB); PG8_STAGE(PG8_SA(1, 0), a3, voffA);
            PG8_WAIT_V(8); PG8_WAIT_L(0); PG8_BAR; PG8_MMA(1, 0, At, B0); PG8_MMA(1, 1, At, B1); PG8_BAR; PG8_SCHED;
            } else {
            PG8_LDB(B0, 0, 0); PG8_SCHED; PG8_LDA(At, 0, 0); PG8_STAGE(PG8_SA(1, 1), a1 + hstep, voffA);
            PG8_WAIT_L(8); PG8_BAR; PG8_WAIT_L(0); PG8_MMA(0, 0, At, B0); PG8_BAR; PG8_SCHED;
            PG8_LDB(B1, 0, 1); PG8_STAGE(PG8_SB(0, 0), b2, voffB);
            PG8_BAR; PG8_WAIT_L(0); PG8_MMA(0, 1, At, B1); PG8_BAR;
            PG8_LDA(At, 0, 1); PG8_STAGE(PG8_SA(0, 0), a2, voffA);
            PG8_BAR; PG8_WAIT_L(0); PG8_MMA(1, 0, At, B0); PG8_BAR; PG8_SCHED;
            PG8_STAGE(PG8_SB(0, 1), b2 + hstep, voffB);
            PG8_WAIT_V(6); PG8_BAR; PG8_MMA(1, 1, At, B1); PG8_BAR;
            PG8_LDB(B0, 1, 0); PG8_SCHED; PG8_LDA(At, 1, 0); PG8_STAGE(PG8_SA(0, 1), a2 + hstep, voffA);
            PG8_WAIT_L(8); PG8_BAR; PG8_WAIT_L(0); PG8_MMA(0, 0, At, B0); PG8_BAR; PG8_SCHED;
            PG8_LDB(B1, 1, 1); PG8_STAGE(PG8_SB(1, 0), b3, voffB);
            PG8_BAR; PG8_WAIT_L(0); PG8_MMA(0, 1, At, B1); PG8_BAR;
            PG8_LDA(At, 1, 1); PG8_STAGE(PG8_SA(1, 0), a3, voffA);
            PG8_BAR; PG8_WAIT_L(0); PG8_MMA(1, 0, At, B0); PG8_BAR; PG8_SCHED;
            PG8_STAGE(PG8_SB(1, 1), b3 + hstep, voffB);
            PG8_WAIT_V(6); PG8_BAR; PG8_MMA(1, 1, At, B1); PG8_BAR;
            }
        }
        if constexpr (ALIGN_EPI) { if (wr == 0) PG8_BAR; }
        if constexpr (!Epi::AFTER_DRAIN) { E(acc, cur, wr, wc, fr, fq); S.done(cur); }
        if (!has_next) break;
#pragma unroll
        for (int a = 0; a < 2; ++a)
#pragma unroll
            for (int b = 0; b < 2; ++b)
#pragma unroll
                for (int m = 0; m < 4; ++m)
#pragma unroll
                    for (int n = 0; n < 2; ++n) acc[a][b][m][n] = (f32x4){0.f, 0.f, 0.f, 0.f};
        cur = nxt; cA = nA; cB = nB; ++ui;
        if constexpr (ALIGN_EPI) { if (wr == 1) PG8_BAR; }
    }
    PG8_WAIT_V(0);
    if constexpr (!ALIGN_EPI) { if (wr == 0) PG8_BAR; }
    PG8_BAR;
    if constexpr (Epi::AFTER_DRAIN) { E.fused(acc, cur, wr, wc, fr, fq, lds, wid, lane); S.done(cur); }
#undef PG8_SA
#undef PG8_SB
#undef PG8_STAGE
#undef PG8_LDA
#undef PG8_LDB
#undef PG8_MMA
#undef PG8_WAIT_V
#undef PG8_WAIT_L
#undef PG8_BAR
#undef PG8_SCHED
}
}

namespace att {
#define ALAS __attribute__((address_space(3)))
using bf16x8 = __attribute__((ext_vector_type(8))) short;
using s16x4  = __attribute__((ext_vector_type(4))) short;
using f32x16 = __attribute__((ext_vector_type(16))) float;
constexpr int KVBLK = 64, SHM_V = KVBLK * 128 * 2, SHM_K = KVBLK * 128 * 2;
constexpr int L_V = 0, L_K = 2 * SHM_V, L_FLAG = 2 * SHM_V + 2 * SHM_K;
#define KSWZ(row, colB) ((row) * 256 + ((colB) ^ (((row) & 7) << 4)))
#define SBAR() __builtin_amdgcn_sched_barrier(0)
__device__ __forceinline__ int crow(int r, int hi) { return (r & 3) + 8 * (r >> 2) + 4 * hi; }
__device__ __forceinline__ unsigned cvtpk(float lo, float hi) { unsigned r; asm volatile("v_cvt_pk_bf16_f32 %0, %1, %2" : "=v"(r) : "v"(lo), "v"(hi)); return r; }
__device__ __forceinline__ void qkt(f32x16& p0, f32x16& p1, const ALAS unsigned char* Ks, const bf16x8* qr, int r32, int hi) {
    p0 = f32x16{}; p1 = f32x16{};
#pragma unroll
    for (int d0 = 0; d0 < 8; ++d0) { const int cb = (d0 * 16 + hi * 8) * 2;
        const bf16x8 b0 = *(const ALAS bf16x8*)(Ks + KSWZ(r32, cb));
        const bf16x8 b1 = *(const ALAS bf16x8*)(Ks + KSWZ(32 + r32, cb));
        p0 = __builtin_amdgcn_mfma_f32_32x32x16_bf16(b0, qr[d0], p0, 0, 0, 0);
        p1 = __builtin_amdgcn_mfma_f32_32x32x16_bf16(b1, qr[d0], p1, 0, 0, 0); }
}
__device__ __forceinline__ int v_st(int k, int c) { const int kk = (k & ~0xC) | ((k & 4) << 1) | ((k & 8) >> 1); return ((kk >> 3) * 4 + (c >> 5)) * 512 + ((kk & 7) * 32 + (c & 31)) * 2; }
__device__ __forceinline__ int v_rd_base(int lane) { return ((lane & 3) << 3) | (((lane >> 2) & 3) << 6) | (((lane >> 4) & 1) << 5) | (((lane >> 5) & 1) << 8); }
constexpr int v_rd_off(int d0, int ks, int half) { return d0 * 512 + ks * 4096 + half * 2048; }
template <int OFF> __device__ __forceinline__ s16x4 tr_read(int vb) { s16x4 r; asm volatile("ds_read_b64_tr_b16 %0, %1 offset:%2" : "=&v"(r) : "v"(vb), "i"(OFF) : "memory"); return r; }
template <int D0> __device__ __forceinline__ void pv_one(f32x16& od, int vb, bf16x8 pa0, bf16x8 pa1, bf16x8 pa2, bf16x8 pa3) {
    const s16x4 l0 = tr_read<v_rd_off(D0, 0, 0)>(vb), h0 = tr_read<v_rd_off(D0, 0, 1)>(vb), l1 = tr_read<v_rd_off(D0, 1, 0)>(vb), h1 = tr_read<v_rd_off(D0, 1, 1)>(vb);
    const s16x4 l2 = tr_read<v_rd_off(D0, 2, 0)>(vb), h2 = tr_read<v_rd_off(D0, 2, 1)>(vb), l3 = tr_read<v_rd_off(D0, 3, 0)>(vb), h3 = tr_read<v_rd_off(D0, 3, 1)>(vb);
    asm volatile("s_waitcnt lgkmcnt(0)" ::: "memory"); SBAR();
#define PK(L, H) (bf16x8){L[0], L[1], L[2], L[3], H[0], H[1], H[2], H[3]}
    od = __builtin_amdgcn_mfma_f32_32x32x16_bf16(pa0, PK(l0, h0), od, 0, 0, 0);
    od = __builtin_amdgcn_mfma_f32_32x32x16_bf16(pa1, PK(l1, h1), od, 0, 0, 0);
    od = __builtin_amdgcn_mfma_f32_32x32x16_bf16(pa2, PK(l2, h2), od, 0, 0, 0);
    od = __builtin_amdgcn_mfma_f32_32x32x16_bf16(pa3, PK(l3, h3), od, 0, 0, 0);
#undef PK
}
__device__ __forceinline__ void pv_d0(f32x16* o, int vb, bf16x8 pa0, bf16x8 pa1, bf16x8 pa2, bf16x8 pa3) {
    pv_one<0>(o[0], vb, pa0, pa1, pa2, pa3); pv_one<1>(o[1], vb, pa0, pa1, pa2, pa3); pv_one<2>(o[2], vb, pa0, pa1, pa2, pa3); pv_one<3>(o[3], vb, pa0, pa1, pa2, pa3);
}
__device__ __forceinline__ void pack_p(const f32x16& p0, const f32x16& p1, bf16x8& pa0, bf16x8& pa1, bf16x8& pa2, bf16x8& pa3) {
#define PK4(P, BASE, OUT) do { unsigned a0 = cvtpk(P[BASE + 0], P[BASE + 1]), a1 = cvtpk(P[BASE + 2], P[BASE + 3]);   \
    unsigned b0 = cvtpk(P[BASE + 4], P[BASE + 5]), b1 = cvtpk(P[BASE + 6], P[BASE + 7]);                              \
    auto r0 = __builtin_amdgcn_permlane32_swap(a0, b0, false, false); auto r1 = __builtin_amdgcn_permlane32_swap(a1, b1, false, false); \
    u32x4 w = {r0[0], r1[0], r0[1], r1[1]}; OUT = *reinterpret_cast<bf16x8*>(&w); } while (0)
    PK4(p0, 0, pa0); PK4(p0, 8, pa1); PK4(p1, 0, pa2); PK4(p1, 8, pa3);
#undef PK4
}
__device__ __forceinline__ float sp2(float z2) { return fmaxf(z2, 0.f) + __builtin_amdgcn_logf(1.0f + __builtin_amdgcn_exp2f(-fabsf(z2))); }
__device__ __forceinline__ void sb_weights(f32x16& p0, f32x16& p1, float& R, int hi) {
    float nl[32];
#pragma unroll
    for (int i = 0; i < 16; ++i) { const float z = p0[i], s = sp2(z); nl[i] = s; p0[i] = z - s; }
#pragma unroll
    for (int i = 0; i < 16; ++i) { const float z = p1[i], s = sp2(z); nl[16 + i] = s; p1[i] = z - s; }
    float S[9]; S[8] = 0.f;
#pragma unroll
    for (int g = 7; g >= 0; --g) S[g] = S[g + 1] + ((nl[4 * g] + nl[4 * g + 1]) + (nl[4 * g + 2] + nl[4 * g + 3]));
    float tot; { auto rr = __builtin_amdgcn_permlane32_swap(__float_as_uint(S[0]), __float_as_uint(S[0]), false, false); tot = __uint_as_float(rr[0]) + __uint_as_float(rr[1]); }
#pragma unroll
    for (int g = 0; g < 8; ++g) {
        const float snd = hi ? S[g] : S[g + 1];
        auto rr = __builtin_amdgcn_permlane32_swap(__float_as_uint(snd), __float_as_uint(snd), false, false);
        const float rcv = hi ? __uint_as_float(rr[0]) : __uint_as_float(rr[1]);
        const float t3 = R - S[g + 1] - rcv, t2 = t3 - nl[4 * g + 3], t1 = t2 - nl[4 * g + 2], t0 = t1 - nl[4 * g + 1];
        if (g < 4) { p0[4 * g + 3] = __builtin_amdgcn_exp2f(p0[4 * g + 3] + t3); p0[4 * g + 2] = __builtin_amdgcn_exp2f(p0[4 * g + 2] + t2); p0[4 * g + 1] = __builtin_amdgcn_exp2f(p0[4 * g + 1] + t1); p0[4 * g] = __builtin_amdgcn_exp2f(p0[4 * g] + t0); }
        else { const int q = 4 * (g - 4); p1[q + 3] = __builtin_amdgcn_exp2f(p1[q + 3] + t3); p1[q + 2] = __builtin_amdgcn_exp2f(p1[q + 2] + t2); p1[q + 1] = __builtin_amdgcn_exp2f(p1[q + 1] + t1); p1[q] = __builtin_amdgcn_exp2f(p1[q] + t0); }
    }
    R -= tot;
}
constexpr float SB_EXIT = -160.0f;
template <bool EARLY>
__device__ __forceinline__ void sb_unit(ALAS unsigned char* lds, const bf16_t* __restrict__ proj, const float* __restrict__ gain, bf16_t* __restrict__ mixed, int b, int h, int qb) {
    const int tid = threadIdx.x, wid = __builtin_amdgcn_readfirstlane(tid >> 6), lane = tid & 63, r32 = lane & 31, hi = lane >> 5;
    const size_t tok0 = (size_t)b * SEQ; const int q0 = qb * 256, tw0 = q0 + 32 * wid;
    const bf16_t* Kg = proj + tok0 * NP + C_SBK + h * HD; const bf16_t* Vg = proj + tok0 * NP + C_SBV + h * HD;
    bf16x8 qr[8];
    { const bf16_t* Qw = proj + (tok0 + tw0 + r32) * NP + C_SBQ + h * HD + hi * 8;
#pragma unroll
      for (int d0 = 0; d0 < 8; ++d0) qr[d0] = *(const bf16x8*)(Qw + d0 * 16); }
    const int sr = tid >> 4, sc = (tid & 15) * 8;
    const int vst0 = v_st(sr, sc), vst1 = v_st(32 + sr, sc), kst0 = KSWZ(sr, sc * 2), kst1 = KSWZ(32 + sr, sc * 2);
    const int vb0 = (int)(unsigned)(size_t)(lds + L_V) + v_rd_base(lane);
    ALAS unsigned* flags = (ALAS unsigned*)(lds + L_FLAG);
    bf16x8 ks0, ks1, vs0, vs1;
#define SLOAD(k0) do { const size_t o0 = (size_t)((k0) + sr) * NP + sc, o1 = (size_t)((k0) + 32 + sr) * NP + sc; \
    vs0 = *(const bf16x8*)(Vg + o0); vs1 = *(const bf16x8*)(Vg + o1); ks0 = *(const bf16x8*)(Kg + o0); ks1 = *(const bf16x8*)(Kg + o1); } while (0)
#define SWRITE(bf) do { *(ALAS bf16x8*)(lds + L_V + (bf) * SHM_V + vst0) = vs0; *(ALAS bf16x8*)(lds + L_V + (bf) * SHM_V + vst1) = vs1; \
    *(ALAS bf16x8*)(lds + L_K + (bf) * SHM_K + kst0) = ks0; *(ALAS bf16x8*)(lds + L_K + (bf) * SHM_K + kst1) = ks1; } while (0)
    const int jmax = 4 * qb + 3;
    SLOAD(jmax * KVBLK); SWRITE(0); __syncthreads();
    float R = 0.f; f32x16 o[4] = {};
    for (int it = 0, j = jmax;; ++it, --j) {
        const int cur = it & 1, key0 = j * KVBLK;
        const bool act = key0 < tw0 + 31;
        if (!act && j > 0) SLOAD((j - 1) * KVBLK);
        if (act) {
            f32x16 p0, p1;
            qkt(p0, p1, lds + L_K + cur * SHM_K, qr, r32, hi);
            if (key0 + 63 >= tw0) {
                const int lim = tw0 + r32 - key0 - 4 * hi;
#pragma unroll
                for (int i = 0; i < 16; ++i) { const int kk = 8 * (i >> 2) + (i & 3); if (kk >= lim) p0[i] = -INFINITY; if (kk + 32 >= lim) p1[i] = -INFINITY; }
            }
            sb_weights(p0, p1, R, hi);
            SBAR(); if (j > 0) SLOAD((j - 1) * KVBLK); SBAR();
            bf16x8 pa0, pa1, pa2, pa3;
            pack_p(p0, p1, pa0, pa1, pa2, pa3);
            pv_d0(o, vb0 + cur * SHM_V, pa0, pa1, pa2, pa3);
        }
        if (EARLY) { const bool dn = __all(R < SB_EXIT); if (lane == 0) flags[cur * 8 + wid] = dn ? 1u : 0u; }
        if (j > 0) SWRITE(cur ^ 1);
        __syncthreads();
        if (j == 0) break;
        if (EARLY) { const u32x4 f0 = *(const ALAS u32x4*)(flags + cur * 8), f1 = *(const ALAS u32x4*)(flags + cur * 8 + 4);
            if ((f0.x & f0.y & f0.z & f0.w & f1.x & f1.y & f1.z & f1.w) != 0u) break; }
    }
#undef SLOAD
#undef SWRITE
    float rn[16];
#pragma unroll
    for (int r = 0; r < 16; ++r) { float ss = (o[0][r] * o[0][r] + o[1][r] * o[1][r]) + (o[2][r] * o[2][r] + o[3][r] * o[3][r]);
#pragma unroll
        for (int x = 1; x < 32; x <<= 1) ss += __shfl_xor(ss, x);
        rn[r] = 1.0f / sqrtf(ss * (1.0f / HD) + EPS); }
    float gn[4];
#pragma unroll
    for (int d0 = 0; d0 < 4; ++d0) gn[d0] = gain[h * HD + d0 * 32 + r32];
#pragma unroll
    for (int r = 0; r < 16; ++r) { const size_t tok = tok0 + tw0 + crow(r, hi);
        const bf16_t* gp = proj + tok * NP + C_SBG + h * HD + r32; bf16_t* op = mixed + tok * DM + h * HD + r32;
#pragma unroll
        for (int d0 = 0; d0 < 4; ++d0) { const float gt = bf2f(gp[d0 * 32]); op[d0 * 32] = (bf16_t)f2bf(o[d0][r] * rn[r] * gn[d0] * (gt / (1.0f + __expf(-gt)))); } }
}
constexpr int L_WS = L_FLAG + 64;
constexpr float DSA_THR = 11.5f;
__device__ __forceinline__ void dsa_unit(ALAS unsigned char* lds, const bf16_t* __restrict__ proj, const unsigned long long* __restrict__ mask, const float* __restrict__ gain,
                                         bf16_t* __restrict__ mixed, int b, int h, int qb) {
    const int tid = threadIdx.x, wid = __builtin_amdgcn_readfirstlane(tid >> 6), lane = tid & 63, r32 = lane & 31, hi = lane >> 5, g = h >> 2;
    const size_t tok0 = (size_t)b * SEQ; const int q0 = qb * 256, tw0 = q0 + 32 * wid;
    const bf16_t* Kg = proj + tok0 * NP + C_DK + g * HD; const bf16_t* Vg = proj + tok0 * NP + C_DV + g * HD;
    bf16x8 qr[8];
    { const bf16_t* Qw = proj + (tok0 + tw0 + r32) * NP + C_DQ + h * HD + hi * 8;
#pragma unroll
      for (int d0 = 0; d0 < 8; ++d0) qr[d0] = *(const bf16x8*)(Qw + d0 * 16); }
    const unsigned long long* mrow = mask + (tok0 + tw0 + r32) * 64;
    const int sr = tid >> 4, sc = (tid & 15) * 8;
    const int vst0 = v_st(sr, sc), vst1 = v_st(32 + sr, sc), kst0 = KSWZ(sr, sc * 2), kst1 = KSWZ(32 + sr, sc * 2);
    const int vb0 = (int)(unsigned)(size_t)(lds + L_V) + v_rd_base(lane);
    ALAS float* wsl = (ALAS float*)(lds + L_WS) + wid * 64;
    bf16x8 ks0, ks1, vs0, vs1;
#define SLOAD(k0) do { const size_t o0 = (size_t)((k0) + sr) * NP + sc, o1 = (size_t)((k0) + 32 + sr) * NP + sc; \
    vs0 = *(const bf16x8*)(Vg + o0); vs1 = *(const bf16x8*)(Vg + o1); ks0 = *(const bf16x8*)(Kg + o0); ks1 = *(const bf16x8*)(Kg + o1); } while (0)
#define SWRITE(bf) do { *(ALAS bf16x8*)(lds + L_V + (bf) * SHM_V + vst0) = vs0; *(ALAS bf16x8*)(lds + L_V + (bf) * SHM_V + vst1) = vs1; \
    *(ALAS bf16x8*)(lds + L_K + (bf) * SHM_K + kst0) = ks0; *(ALAS bf16x8*)(lds + L_K + (bf) * SHM_K + kst1) = ks1; } while (0)
    const int jmax = 4 * qb + 3;
    SLOAD(0); SWRITE(0); __syncthreads();
    float m_reg = -1e30f, l_reg = 0.f; f32x16 o[4] = {};
    for (int j = 0;; ++j) {
        const int cur = j & 1, key0 = j * KVBLK;
        const bool act = key0 <= tw0 + 31;
        unsigned long long mw = 0ull; if (act) mw = mrow[j];
        if (!act && j < jmax) SLOAD((j + 1) * KVBLK);
        if (act) {
            f32x16 p0, p1;
            qkt(p0, p1, lds + L_K + cur * SHM_K, qr, r32, hi);
            const int mlo = (int)((unsigned)mw >> (4 * hi)), mhi = (int)((unsigned)(mw >> 32) >> (4 * hi));
            const unsigned NINF = 0xff800000u;
#pragma unroll
            for (int i = 0; i < 16; ++i) { const int kk = 8 * (i >> 2) + (i & 3);
                const unsigned t0 = (unsigned)__builtin_amdgcn_sbfe(mlo, kk, 1), t1 = (unsigned)__builtin_amdgcn_sbfe(mhi, kk, 1);
                p0[i] = __uint_as_float((__float_as_uint(p0[i]) & t0) | (NINF & ~t0)); p1[i] = __uint_as_float((__float_as_uint(p1[i]) & t1) | (NINF & ~t1)); }
            float pmax = p0[0];
#pragma unroll
            for (int r = 1; r < 16; ++r) pmax = fmaxf(pmax, p0[r]);
#pragma unroll
            for (int r = 0; r < 16; ++r) pmax = fmaxf(pmax, p1[r]);
            { auto rr = __builtin_amdgcn_permlane32_swap(__float_as_uint(pmax), __float_as_uint(pmax), false, false); pmax = fmaxf(__uint_as_float(rr[0]), __uint_as_float(rr[1])); }
            float mn, alpha;
            if (__all(pmax - m_reg <= DSA_THR)) { mn = m_reg; alpha = 1.f; }
            else { mn = fmaxf(m_reg, pmax); alpha = __builtin_amdgcn_exp2f(m_reg - mn); m_reg = mn; }
            if (__any(alpha < 1.f)) { if (hi == 0) wsl[r32] = alpha; asm volatile("s_waitcnt lgkmcnt(0)" ::: "memory");
#pragma unroll
                for (int r = 0; r < 16; ++r) { const float al = wsl[crow(r, hi)];
#pragma unroll
                    for (int d = 0; d < 4; ++d) o[d][r] *= al; } }
            float ps = 0.f;
#pragma unroll
            for (int r = 0; r < 16; ++r) { p0[r] = __builtin_amdgcn_exp2f(p0[r] - mn); p1[r] = __builtin_amdgcn_exp2f(p1[r] - mn); ps += p0[r] + p1[r]; }
            { auto rr = __builtin_amdgcn_permlane32_swap(__float_as_uint(ps), __float_as_uint(ps), false, false); ps = __uint_as_float(rr[0]) + __uint_as_float(rr[1]); }
            l_reg = l_reg * alpha + ps;
            SBAR(); if (j < jmax) SLOAD((j + 1) * KVBLK); SBAR();
            bf16x8 pa0, pa1, pa2, pa3;
            pack_p(p0, p1, pa0, pa1, pa2, pa3);
            pv_d0(o, vb0 + cur * SHM_V, pa0, pa1, pa2, pa3);
        }
        if (j < jmax) SWRITE(cur ^ 1);
        __syncthreads();
        if (j == jmax) break;
    }
#undef SLOAD
#undef SWRITE
    if (hi == 0) wsl[32 + r32] = l_reg; asm volatile("s_waitcnt lgkmcnt(0)" ::: "memory");
    float rn[16];
#pragma unroll
    for (int r = 0; r < 16; ++r) { const float il = 1.0f / wsl[32 + crow(r, hi)];
#pragma unroll
        for (int d = 0; d < 4; ++d) o[d][r] *= il;
        float ss = (o[0][r] * o[0][r] + o[1][r] * o[1][r]) + (o[2][r] * o[2][r] + o[3][r] * o[3][r]);
#pragma unroll
        for (int x = 1; x < 32; x <<= 1) ss += __shfl_xor(ss, x);
        rn[r] = 1.0f / sqrtf(ss * (1.0f / HD) + EPS); }
    float gn[4];
#pragma unroll
    for (int d0 = 0; d0 < 4; ++d0) gn[d0] = gain[h * HD + d0 * 32 + r32];
#pragma unroll
    for (int r = 0; r < 16; ++r) { const size_t tok = tok0 + tw0 + crow(r, hi);
        const bf16_t* gp = proj + tok * NP + C_DG + h * HD + r32; bf16_t* op = mixed + tok * DM + 1024 + h * HD + r32;
#pragma unroll
        for (int d0 = 0; d0 < 4; ++d0) { const float gt = bf2f(gp[d0 * 32]); op[d0 * 32] = (bf16_t)f2bf(o[d0][r] * rn[r] * gn[d0] * (gt / (1.0f + __expf(-gt)))); } }
    asm volatile("s_waitcnt lgkmcnt(0)" ::: "memory");
}
}

namespace idx {
#define ILAS __attribute__((address_space(3)))
using bf16x8 = __attribute__((ext_vector_type(8))) short;
using f32x16 = __attribute__((ext_vector_type(16))) float;
constexpr int L_SC = 0, L_HIST = 131072;
__device__ __forceinline__ void index_unit(ILAS unsigned char* lds, const bf16_t* __restrict__ proj, const float* __restrict__ iw, unsigned long long* __restrict__ mask, int b, int t0) {
    const int tid = threadIdx.x, wid = __builtin_amdgcn_readfirstlane(tid >> 6), lane = tid & 63, r = lane & 31, hi = lane >> 5;
    const size_t tok0 = (size_t)b * SEQ;
    ILAS unsigned* sc = (ILAS unsigned*)(lds + L_SC);
    {
        bf16x8 af[4][4]; float wv[4][16];
#pragma unroll
        for (int T = 0; T < 4; ++T) {
            const bf16_t* qb = proj + (tok0 + t0 + 2 * T + ((r >> 2) & 1)) * NP + C_IQ + ((r & 3) + 4 * (r >> 3)) * ID + 8 * hi;
#pragma unroll
            for (int ks = 0; ks < 4; ++ks) af[T][ks] = *(const bf16x8*)(qb + 16 * ks);
            const float* wp = iw + (tok0 + t0 + 2 * T + hi) * 16;
#pragma unroll
            for (int i = 0; i < 4; ++i) { const f32x4 w4 = *(const f32x4*)(wp + 4 * i); wv[T][4 * i] = w4.x; wv[T][4 * i + 1] = w4.y; wv[T][4 * i + 2] = w4.z; wv[T][4 * i + 3] = w4.w; }
        }
        const int nt32 = 2 * ((t0 + 8 + 63) >> 6);
        const bf16_t* kb = proj + tok0 * NP + C_IK + 8 * hi + (size_t)r * NP;
        bf16x8 bf[4], bn[4];
        int jt = wid;
        if (jt < nt32) {
#pragma unroll
            for (int ks = 0; ks < 4; ++ks) bf[ks] = *(const bf16x8*)(kb + (size_t)(32 * jt) * NP + 16 * ks);
        }
        for (; jt < nt32; jt += 8) {
            const int key0 = 32 * jt;
            if (jt + 8 < nt32) {
#pragma unroll
                for (int ks = 0; ks < 4; ++ks) bn[ks] = *(const bf16x8*)(kb + (size_t)(32 * (jt + 8)) * NP + 16 * ks);
            }
#pragma unroll
            for (int T = 0; T < 4; ++T) {
                f32x16 acc = {};
#pragma unroll
                for (int ks = 0; ks < 4; ++ks) acc = __builtin_amdgcn_mfma_f32_32x32x16_bf16(af[T][ks], bf[ks], acc, 0, 0, 0);
                float sv = 0.f;
#pragma unroll
                for (int rr = 0; rr < 16; ++rr) sv = fmaf(wv[T][rr], fmaxf(acc[rr], 0.f), sv);
                const int q = 2 * T + hi, key = key0 + r;
                sc[q * SEQ + key] = (key <= t0 + q) ? fkey(sv) : 0u;
            }
#pragma unroll
            for (int ks = 0; ks < 4; ++ks) bf[ks] = bn[ks];
        }
    }
    __syncthreads();
    const int t = t0 + wid, N = t + 1, NE = (N + 63) >> 6;
    const ILAS unsigned* myrow = sc + wid * SEQ + lane;
    unsigned long long myw = 0ull;
    if (N <= TOPK) {
        for (int e = 0; e < NE; ++e) { const unsigned long long bm = __ballot(64 * e + lane <= t); if (lane == e) myw = bm; }
    } else {
        ILAS unsigned* hist = (ILAS unsigned*)(lds + L_HIST) + wid * 256;
        unsigned pref = 0u; int krem = TOPK;
        for (int pass = 0; pass < 4; ++pass) {
            const int shift = 24 - 8 * pass;
            *(ILAS u32x4*)(hist + 4 * lane) = (u32x4){0u, 0u, 0u, 0u};
            asm volatile("s_waitcnt lgkmcnt(0)" ::: "memory");
#pragma unroll 4
            for (int e = 0; e < NE; ++e) { const unsigned k = myrow[64 * e];
                const bool mt = (pass == 0) ? true : ((k >> ((shift + 8) & 31)) == pref);
                if (mt) __hip_atomic_fetch_add(hist + ((k >> shift) & 255u), 1u, __ATOMIC_RELAXED, __HIP_MEMORY_SCOPE_WORKGROUP); }
            asm volatile("s_waitcnt lgkmcnt(0)" ::: "memory");
            const u32x4 c4 = *(const ILAS u32x4*)(hist + 4 * lane);
            const unsigned s4 = (c4.x + c4.y) + (c4.z + c4.w);
            unsigned sl = s4;
#pragma unroll
            for (int off = 1; off < 64; off <<= 1) { const unsigned tt = __shfl_down(sl, off); if (lane + off < 64) sl += tt; }
            const unsigned long long bal = __ballot(sl >= (unsigned)krem);
            const int ls = 63 - __clzll((long long)bal);
            const unsigned above = (unsigned)__builtin_amdgcn_readlane((int)sl, ls) - (unsigned)__builtin_amdgcn_readlane((int)s4, ls);
            const unsigned cx = (unsigned)__builtin_amdgcn_readlane((int)c4.x, ls), cy = (unsigned)__builtin_amdgcn_readlane((int)c4.y, ls);
            const unsigned cz = (unsigned)__builtin_amdgcn_readlane((int)c4.z, ls), cw = (unsigned)__builtin_amdgcn_readlane((int)c4.w, ls);
            unsigned ab = above; int d;
            if (ab + cw >= (unsigned)krem) d = 3; else { ab += cw;
                if (ab + cz >= (unsigned)krem) d = 2; else { ab += cz;
                    if (ab + cy >= (unsigned)krem) d = 1; else { ab += cy; d = 0; } } }
            pref = (pref << 8) | (unsigned)(4 * ls + d); krem -= (int)ab;
        }
        int rleft = krem;
        for (int e = 0; e < NE; ++e) { const unsigned k = myrow[64 * e];
            const unsigned long long gt = __ballot(k > pref); unsigned long long em = __ballot(k == pref), take = 0ull;
            if (em != 0ull) { const int cnt = __popcll(em);
                if (cnt <= rleft) { take = em; rleft -= cnt; }
                else { while (rleft > 0) { const unsigned long long bb = em & (~em + 1ull); take |= bb; em ^= bb; --rleft; } } }
            const unsigned long long bm = gt | take;
            if (lane == e) myw = bm;
        }
    }
    mask[(tok0 + t) * 64 + lane] = myw;
    asm volatile("s_waitcnt lgkmcnt(0)" ::: "memory");
    __syncthreads();
}
}

#define GAS __attribute__((address_space(1)))
#define LAS __attribute__((address_space(3)))
#define LDS_WAIT() asm volatile("s_waitcnt lgkmcnt(0)" ::: "memory")
constexpr int NWAVES = 8, LDS_BYTES = 147456;
struct Args { const float* x; const int* pos; const float* norm_g; const float* w_in; const float* sb_g; const float* dsa_g; const float* w_out; const float* final_g; float* out; unsigned char* ws; int ph_lo, ph_hi; };

__device__ __forceinline__ void transpose_item(const float* __restrict__ W, int K, int N, int NPAD, bf16_t* __restrict__ WT, LAS float* scr, int item, int lane) {
    const int nblk = NPAD / 32, kb = item / nblk, nb = item % nblk, k0 = 64 * kb, n0 = 32 * nb;
    const int n = n0 + (lane & 31); const bool ok = n < N;
#pragma unroll 8
    for (int i = 0; i < 32; ++i) { const int kk = 2 * i + (lane >> 5); scr[kk * 33 + (lane & 31)] = ok ? W[(size_t)(k0 + kk) * N + n] : 0.f; }
    LDS_WAIT();
    const int c = lane & 7;
#pragma unroll
    for (int j = 0; j < 4; ++j) { const int nn = (lane >> 3) + 8 * j; const LAS float* s = scr + (8 * c) * 33 + nn;
        u32x4 o; o.x = pk2(s[0 * 33], s[1 * 33]); o.y = pk2(s[2 * 33], s[3 * 33]); o.z = pk2(s[4 * 33], s[5 * 33]); o.w = pk2(s[6 * 33], s[7 * 33]);
        *(u32x4*)(WT + (size_t)(n0 + nn) * K + k0 + 8 * c) = o; }
    LDS_WAIT();
}
__device__ __forceinline__ void rmsnorm_row_bf16(const float* __restrict__ xrow, const float* __restrict__ g, bf16_t* __restrict__ orow, int lane) {
    const f32x4* xr = (const f32x4*)xrow + lane;
    f32x4 v[8]; float s = 0.f;
#pragma unroll
    for (int j = 0; j < 8; ++j) { v[j] = xr[64 * j]; s += (v[j].x * v[j].x + v[j].y * v[j].y) + (v[j].z * v[j].z + v[j].w * v[j].w); }
    const float r = 1.0f / sqrtf(wave_sum(s) * (1.0f / DM) + EPS);
    const f32x4* gr = (const f32x4*)g + lane;
    u32x2* o = (u32x2*)orow + lane;
#pragma unroll
    for (int j = 0; j < 8; ++j) { const f32x4 gg = gr[64 * j]; u32x2 w; w.x = pk2(v[j].x * r * gg.x, v[j].y * r * gg.y); w.y = pk2(v[j].z * r * gg.z, v[j].w * r * gg.w); o[64 * j] = w; }
}

__global__ void __launch_bounds__(NWAVES * 64, 2) mega(Args a) {
    extern __shared__ __attribute__((aligned(16))) unsigned char lds_raw[];
    LAS unsigned char* lds = (LAS unsigned char*)lds_raw;
    const int tid = threadIdx.x, lane = tid & 63, wave = __builtin_amdgcn_readfirstlane(tid >> 6);
    const int G = gridDim.x, bx = blockIdx.x;
    unsigned char* ws = a.ws;
    bf16_t* HN = (bf16_t*)(ws + WS_HN); bf16_t* WT1 = (bf16_t*)(ws + WS_WT1); bf16_t* WT2 = (bf16_t*)(ws + WS_WT2);
    float* IW = (float*)(ws + WS_IW); float* R128 = (float*)(ws + WS_R128); float* R64 = (float*)(ws + WS_R64); bf16_t* PROJ = (bf16_t*)(ws + WS_PROJ);
    bf16_t* MIXED = (bf16_t*)(ws + WS_MIXED); float* SSP = (float*)(ws + WS_SSP); unsigned long long* MASKW = (unsigned long long*)(ws + WS_MASK); const unsigned long long* MASK = MASKW;
    const int lo = a.ph_lo, hi = a.ph_hi;
#define IN(k) (lo <= (k) && (k) < hi)
#define SEAM(k) do { if (IN(k) && IN((k) + 1)) cooperative_groups::this_grid().sync(); } while (0)
    if (IN(0)) {
        const int gw = bx * NWAVES + wave, NGW = G * NWAVES;
        LAS float* scr = (LAS float*)(lds + wave * 16384);
        constexpr int I1 = (DM / 64) * (NP / 32), I2 = (DM / 64) * (DM / 32);
        for (int it = gw; it < I1 + I2; it += NGW) {
            if (it < I1) transpose_item(a.w_in, DM, D_IN, NP, WT1, scr, it, lane);
            else transpose_item(a.w_out, DM, DM, DM, WT2, scr, it - I1, lane);
        }
        for (int m = gw; m < NTOK; m += NGW) rmsnorm_row_bf16(a.x + (size_t)m * DM, a.norm_g, HN + (size_t)m * DM, lane);
        for (int i = bx * (NWAVES * 64) + tid; i < NTOK * 24; i += G * NWAVES * 64) {
            const int tok = i / 24, j = i % 24;
            const double p = (double)a.pos[tok];
            const double l2t = 18.931568569324174;
            if (j < 16) { const double inv = exp2(-(double)j / 16.0 * l2t); const double ang = p * (double)(float)inv; R128[tok * 32 + j] = (float)cos(ang); R128[tok * 32 + 16 + j] = (float)sin(ang); }
            else { const int jj = j - 16; const double inv = exp2(-(double)jj / 8.0 * l2t); const double ang = p * (double)(float)inv; R64[tok * 16 + jj] = (float)cos(ang); R64[tok * 16 + 8 + jj] = (float)sin(ang); }
        }
    }
    SEAM(0);
    if (IN(1)) {
        pg8::Gemm g{HN, WT1, NTOK, NP, DM}; pg8::StaticOrder S; S.init(NTOK, NP, G, bx);
        pg8::EpiProj E{PROJ, IW, R128, R64};
        pg8::gemm_phase<pg8::EpiProj, pg8::StaticOrder, true, true>(lds, g, S, E);
    }
    SEAM(1);
    if (IN(2)) {
        const int vcu = (G % 8 == 0) ? (bx % 8) * (G / 8) + bx / 8 : bx;
        for (int k = 0;; ++k) {
            const int sI = k * G + ((k & 1) ? (G - 1 - vcu) : vcu);
            if (sI >= NTOK / 8) break;
            idx::index_unit(lds, PROJ, IW, MASKW, sI & 3, 8 * (511 - (sI >> 2)));
        }
    }
    SEAM(2);
    if (IN(3)) {
        const int vcu = (G % 8 == 0) ? (bx % 8) * (G / 8) + bx / 8 : bx;
        for (int p = vcu; p < BATCH * SBH * 8; p += G) {
            const int bh = p >> 3, sI = p & 7, b = bh / SBH, h = bh % SBH;
            for (int k = 0; k < 2; ++k) att::sb_unit<true>(lds, PROJ, a.sb_g, MIXED, b, h, k == 0 ? 15 - sI : sI);
        }
    }
    if (IN(3)) {
        const int vcu = (G % 8 == 0) ? (bx % 8) * (G / 8) + bx / 8 : bx;
        for (int p = vcu; p < BATCH * DSH * 8; p += G) {
            const int bh = p >> 3, sI = p & 7, b = bh / DSH, h = bh % DSH;
            for (int k = 0; k < 2; ++k) att::dsa_unit(lds, PROJ, MASK, a.dsa_g, MIXED, b, h, k == 0 ? 15 - sI : sI);
        }
    }
    SEAM(3);
    if (IN(4)) {
        pg8::Gemm g{MIXED, WT2, NTOK, DM, DM}; pg8::StaticOrder S; S.init(NTOK, DM, G, bx);
        pg8::EpiOut E{a.x, a.out, SSP};
        pg8::gemm_phase<pg8::EpiOut, pg8::StaticOrder, true, true>(lds, g, S, E);
    }
    SEAM(4);
    if (IN(5)) {
        const int gw = bx * NWAVES + wave, NGW = G * NWAVES;
        for (int m = gw; m < NTOK; m += NGW) {
            const float sp = (lane < 32) ? SSP[(size_t)m * 32 + lane] : 0.f;
            const float r = 1.0f / sqrtf(wave_sum(sp) * (1.0f / DM) + EPS);
            f32x4* yr = (f32x4*)(a.out + (size_t)m * DM) + lane; const f32x4* gr = (const f32x4*)a.final_g + lane;
#pragma unroll
            for (int j = 0; j < 8; ++j) { const f32x4 v = yr[64 * j], gg = gr[64 * j]; yr[64 * j] = (f32x4){v.x * r * gg.x, v.y * r * gg.y, v.z * r * gg.z, v.w * r * gg.w}; }
        }
    }
#undef IN
#undef SEAM
}

extern "C" void kernel_launch(void* const* d_in, const int* in_sizes, int n_in, void* d_out, int out_size, void* d_ws, size_t ws_size, hipStream_t stream) {
    static int grid = 0;
    if (grid == 0) {
        if (n_in != 8 || in_sizes[0] != NTOK * DM || out_size != NTOK * DM || ws_size < WS_END) {
            fprintf(stderr, "kernel_launch: shape mismatch n_in %d in0 %d out %d ws %zu (need %zu)\n", n_in, n_in > 0 ? in_sizes[0] : -1, out_size, ws_size, (size_t)WS_END); grid = -1; return; }
        int dev = 0, cus = 0;
        if (hipGetDevice(&dev) != hipSuccess || hipDeviceGetAttribute(&cus, hipDeviceAttributeMultiprocessorCount, dev) != hipSuccess) { grid = -1; return; }
        if (hipFuncSetAttribute((const void*)mega, hipFuncAttributeMaxDynamicSharedMemorySize, LDS_BYTES) != hipSuccess) { fprintf(stderr, "kernel_launch: hipFuncSetAttribute failed\n"); grid = -1; return; }
        int per_cu = 0;
        if (hipOccupancyMaxActiveBlocksPerMultiprocessor(&per_cu, (const void*)mega, NWAVES * 64, LDS_BYTES) != hipSuccess || per_cu < 1) { fprintf(stderr, "kernel_launch: occupancy query says %d blocks per CU\n", per_cu); grid = -1; return; }
        grid = cus;
    }
    if (grid < 0) return;
    const float* x = (const float*)d_in[0]; const float* sb_g = (const float*)d_in[4]; const float* dsa_g = (const float*)d_in[5]; const float* final_g = (const float*)d_in[7];
    unsigned char* ws = (unsigned char*)d_ws; float* out = (float*)d_out;
    bf16_t* MIXED = (bf16_t*)(ws + WS_MIXED); bf16_t* WT2 = (bf16_t*)(ws + WS_WT2);
    float* IW = (float*)(ws + WS_IW);
    unsigned long long* MASK = (unsigned long long*)(ws + WS_MASK); bf16_t* PROJ = (bf16_t*)(ws + WS_PROJ);
    hipMemsetAsync(ws + WS_CTL, 0, 1 * MiB, stream);
    Args a{};
    a.x = x; a.pos = (const int*)d_in[1]; a.norm_g = (const float*)d_in[2]; a.w_in = (const float*)d_in[3]; a.sb_g = sb_g; a.dsa_g = dsa_g; a.w_out = (const float*)d_in[6]; a.final_g = final_g;
    a.out = out; a.ws = ws;
    a.ph_lo = 0; a.ph_hi = 6;
    void* kargs[] = {(void*)&a};
    const hipError_t le = hipLaunchCooperativeKernel((const void*)mega, dim3(grid), dim3(NWAVES * 64), kargs, LDS_BYTES, stream);
    if (le != hipSuccess) fprintf(stderr, "kernel_launch: cooperative launch failed: %s (grid %d)\n", hipGetErrorString(le), grid);
}
```

```cpp
#include <hip/hip_runtime.h>
#include <cstdio>
#include <cstdint>
#include <hip/hip_cooperative_groups.h>

constexpr int BATCH = 4, SEQ = 4096, DM = 2048, NTOK = BATCH * SEQ;
constexpr int HD = 128, SBH = 8, DSH = 8, DKV = 2, IH = 16, ID = 64, TOPK = 256;
constexpr int D_IN = 7760, NP = 7936;
constexpr int C_SBQ = 0, C_SBK = 1024, C_SBV = 2048, C_SBG = 3072, C_DQ = 4096, C_DK = 5120, C_DV = 5376, C_DG = 5632, C_IQ = 6656, C_IK = 7680, C_IW = 7744;
constexpr float EPS = 1e-6f;
constexpr float C2 = 0.08838834764831845f * 1.4426950408889634f;
constexpr float IWS = 1.0f / 32.0f;

constexpr size_t MiB = 1u << 20;
constexpr size_t WS_CTL = 0;
constexpr size_t WS_HN = 1 * MiB;
constexpr size_t WS_MIXED = WS_HN;
constexpr size_t WS_WT1 = 65 * MiB;
constexpr size_t WS_WT2 = 96 * MiB;
constexpr size_t WS_IW = 104 * MiB;
constexpr size_t WS_R128 = 105 * MiB;
constexpr size_t WS_R64 = 107 * MiB;
constexpr size_t WS_MASK = 108 * MiB;
constexpr size_t WS_PROJ = 116 * MiB;
constexpr size_t WS_SSP = 364 * MiB;
constexpr size_t WS_END = 366 * MiB;

#define WAVE_SYNC() asm volatile("s_waitcnt lgkmcnt(0)" ::: "memory")
typedef unsigned short bf16_t;
typedef float f32x4 __attribute__((ext_vector_type(4)));
typedef unsigned u32x4 __attribute__((ext_vector_type(4)));
typedef unsigned u32x2 __attribute__((ext_vector_type(2)));

__device__ __forceinline__ unsigned f2bf(float f) { unsigned u = __builtin_bit_cast(unsigned, f); return (u + 0x7fffu + ((u >> 16) & 1u)) >> 16; }
__device__ __forceinline__ float bf2f(unsigned h) { return __builtin_bit_cast(float, h << 16); }
__device__ __forceinline__ unsigned pk2(float lo, float hi) { return f2bf(lo) | (f2bf(hi) << 16); }
__device__ __forceinline__ float wave_sum(float v) {
#pragma unroll
    for (int o = 1; o < 64; o <<= 1) v += __shfl_xor(v, o);
    return v;
}
__device__ __forceinline__ float wave_max(float v) {
#pragma unroll
    for (int o = 1; o < 64; o <<= 1) v = fmaxf(v, __shfl_xor(v, o));
    return v;
}
__device__ __forceinline__ unsigned fkey(float f) { unsigned u = __builtin_bit_cast(unsigned, f); return (u & 0x80000000u) ? ~u : (u | 0x80000000u); }

__global__ void __launch_bounds__(256) k_rmsnorm_bf16(const float* __restrict__ x, const float* __restrict__ g, bf16_t* __restrict__ out) {
    const int lane = threadIdx.x & 63, row = blockIdx.x * 4 + (threadIdx.x >> 6);
    const f32x4* xr = (const f32x4*)(x + (size_t)row * DM) + lane;
    f32x4 v[8]; float s = 0.f;
#pragma unroll
    for (int j = 0; j < 8; ++j) { v[j] = xr[64 * j]; s += (v[j].x * v[j].x + v[j].y * v[j].y) + (v[j].z * v[j].z + v[j].w * v[j].w); }
    const float r = 1.0f / sqrtf(wave_sum(s) * (1.0f / DM) + EPS);
    const f32x4* gr = (const f32x4*)g + lane;
    u32x2* o = (u32x2*)(out + (size_t)row * DM) + lane;
#pragma unroll
    for (int j = 0; j < 8; ++j) { const f32x4 gg = gr[64 * j]; u32x2 w; w.x = pk2(v[j].x * r * gg.x, v[j].y * r * gg.y); w.y = pk2(v[j].z * r * gg.z, v[j].w * r * gg.w); o[64 * j] = w; }
}
__global__ void __launch_bounds__(256) k_transpose_bf16(const float* __restrict__ W, bf16_t* __restrict__ WT, int K, int N) {
    __shared__ float t[32][33];
    const int n0 = blockIdx.x * 32, k0 = blockIdx.y * 32, tx = threadIdx.x & 31, ty = threadIdx.x >> 5;
#pragma unroll
    for (int i = 0; i < 4; ++i) { const int k = k0 + ty + 8 * i, n = n0 + tx; t[ty + 8 * i][tx] = (n < N) ? W[(size_t)k * N + n] : 0.f; }
    __syncthreads();
#pragma unroll
    for (int i = 0; i < 4; ++i) { const int n = n0 + ty + 8 * i, k = k0 + tx; WT[(size_t)n * K + k] = (bf16_t)f2bf(t[tx][ty + 8 * i]); }
}
__global__ void __launch_bounds__(256) k_rope_tables(const int* __restrict__ pos, float* __restrict__ r128, float* __restrict__ r64) {
    const int i = blockIdx.x * 256 + threadIdx.x;
    if (i >= NTOK * 24) return;
    const int tok = i / 24, j = i % 24;
    const double p = (double)pos[tok];
    const double l2t = log2(500000.0);
    if (j < 16) { const double inv = exp2(-(double)j / 16.0 * l2t); const double a = p * (double)(float)inv; r128[tok * 32 + j] = (float)cos(a); r128[tok * 32 + 16 + j] = (float)sin(a); }
    else { const int jj = j - 16; const double inv = exp2(-(double)jj / 8.0 * l2t); const double a = p * (double)(float)inv; r64[tok * 16 + jj] = (float)cos(a); r64[tok * 16 + 8 + jj] = (float)sin(a); }
}

template <int MODE>
__global__ void __launch_bounds__(256) k_naive_gemm(const bf16_t* __restrict__ A, const bf16_t* __restrict__ Bt, int M, int N, int K,
                                                    bf16_t* __restrict__ proj, float* __restrict__ iw, const float* __restrict__ xres, float* __restrict__ out) {
    __shared__ float As[32][65], Bs[32][65];
    const int tid = threadIdx.x, tx = tid & 15, ty = tid >> 4, m0 = blockIdx.y * 64, n0 = blockIdx.x * 64;
    float acc[4][4] = {};
    const int lr = tid >> 2, lc = (tid & 3) * 8;
    for (int k0 = 0; k0 < K; k0 += 32) {
        const u32x4 av = *(const u32x4*)(A + (size_t)(m0 + lr) * K + k0 + lc);
        const u32x4 bv = *(const u32x4*)(Bt + (size_t)(n0 + lr) * K + k0 + lc);
        __syncthreads();
#pragma unroll
        for (int j = 0; j < 4; ++j) { As[lc + 2 * j][lr] = bf2f(av[j] & 0xffffu); As[lc + 2 * j + 1][lr] = bf2f(av[j] >> 16);
                                      Bs[lc + 2 * j][lr] = bf2f(bv[j] & 0xffffu); Bs[lc + 2 * j + 1][lr] = bf2f(bv[j] >> 16); }
        __syncthreads();
#pragma unroll 8
        for (int k = 0; k < 32; ++k) {
            float a[4], b[4];
#pragma unroll
            for (int i = 0; i < 4; ++i) { a[i] = As[k][ty * 4 + i]; b[i] = Bs[k][tx * 4 + i]; }
#pragma unroll
            for (int i = 0; i < 4; ++i)
#pragma unroll
                for (int j = 0; j < 4; ++j) acc[i][j] = fmaf(a[i], b[j], acc[i][j]);
        }
    }
#pragma unroll
    for (int i = 0; i < 4; ++i) {
        const int m = m0 + ty * 4 + i;
#pragma unroll
        for (int j = 0; j < 4; ++j) {
            const int n = n0 + tx * 4 + j; float v = acc[i][j];
            if (MODE == 0) {
                if (n < C_SBK || (n >= C_DQ && n < C_DK)) v *= C2;
                if (n >= C_IW && n < D_IN) iw[(size_t)m * 16 + (n - C_IW)] = v * IWS;
                proj[(size_t)m * NP + n] = (bf16_t)f2bf(v);
            } else {
                out[(size_t)m * N + n] = xres[(size_t)m * N + n] + v;
            }
        }
    }
}

__global__ void __launch_bounds__(256) k_naive_rope(bf16_t* __restrict__ proj, const float* __restrict__ r128, const float* __restrict__ r64) {
    const int i = blockIdx.x * 256 + threadIdx.x;
    if (i >= NTOK * 296) return;
    const int tok = i / 296; int p = i % 296; int c1, c2; float cs, sn;
    if (p < 128) { const int h = p / 16, j = p % 16; c1 = C_DQ + h * 128 + j; c2 = c1 + 16; cs = r128[tok * 32 + j]; sn = r128[tok * 32 + 16 + j]; }
    else if (p < 160) { p -= 128; const int h = p / 16, j = p % 16; c1 = C_DK + h * 128 + j; c2 = c1 + 16; cs = r128[tok * 32 + j]; sn = r128[tok * 32 + 16 + j]; }
    else if (p < 288) { p -= 160; const int h = p / 8, j = p % 8; c1 = C_IQ + h * 64 + j; c2 = c1 + 8; cs = r64[tok * 16 + j]; sn = r64[tok * 16 + 8 + j]; }
    else { p -= 288; c1 = C_IK + p; c2 = c1 + 8; cs = r64[tok * 16 + p]; sn = r64[tok * 16 + 8 + p]; }
    bf16_t* row = proj + (size_t)tok * NP;
    const float x1 = bf2f(row[c1]), x2 = bf2f(row[c2]);
    row[c1] = (bf16_t)f2bf(x1 * cs - x2 * sn); row[c2] = (bf16_t)f2bf(x2 * cs + x1 * sn);
}

__device__ __forceinline__ float softplus2(float z2) { return fmaxf(z2, 0.f) + __builtin_amdgcn_logf(1.0f + __builtin_amdgcn_exp2f(-fabsf(z2))); }
__device__ __forceinline__ float silu(float x) { return x / (1.0f + __expf(-x)); }

__global__ void __launch_bounds__(256) k_naive_sb(const bf16_t* __restrict__ proj, const float* __restrict__ gain, bf16_t* __restrict__ mixed) {
    __shared__ float qs[4][128]; __shared__ float wsh[4][64];
    const int lane = threadIdx.x & 63, w = threadIdx.x >> 6;
    const int gid = blockIdx.x * 4 + w;
    const int t = gid % SEQ, h = (gid / SEQ) % SBH, b = gid / (SEQ * SBH);
    const size_t tok = (size_t)b * SEQ + t;
    const bf16_t* qrow = proj + tok * NP + C_SBQ + h * HD;
    qs[w][lane] = bf2f(qrow[lane]); qs[w][lane + 64] = bf2f(qrow[lane + 64]);
    WAVE_SYNC();
    float o0 = 0.f, o1 = 0.f, R = 0.f;
    for (int c = (t - 1) >> 6; c >= 0 && t > 0; --c) {
        const int s = c * 64 + lane; const bool valid = s < t;
        float z2 = 0.f;
        if (valid) {
            const u32x4* kr = (const u32x4*)(proj + ((size_t)b * SEQ + s) * NP + C_SBK + h * HD);
#pragma unroll 4
            for (int j = 0; j < 16; ++j) { const u32x4 kv = kr[j];
#pragma unroll
                for (int e = 0; e < 4; ++e) { z2 = fmaf(qs[w][8 * j + 2 * e], bf2f(kv[e] & 0xffffu), z2); z2 = fmaf(qs[w][8 * j + 2 * e + 1], bf2f(kv[e] >> 16), z2); } }
        }
        const float sp = softplus2(z2);
        const float l1m = valid ? -sp : 0.f, lb = z2 - sp;
        float v = l1m;
#pragma unroll
        for (int off = 1; off < 64; off <<= 1) { const float tt = __shfl_down(v, off); if (lane + off < 64) v += tt; }
        const float wgt = valid ? __builtin_amdgcn_exp2f(lb + (v - l1m) + R) : 0.f;
        R += __shfl(v, 0);
        wsh[w][lane] = wgt;
        WAVE_SYNC();
        const bf16_t* vb = proj + ((size_t)b * SEQ + c * 64) * NP + C_SBV + h * HD + 2 * lane;
        const int ns = min(64, t - c * 64);
        for (int ss = 0; ss < ns; ++ss) { const unsigned vv = *(const unsigned*)(vb + (size_t)ss * NP); const float ww = wsh[w][ss]; o0 = fmaf(ww, bf2f(vv & 0xffffu), o0); o1 = fmaf(ww, bf2f(vv >> 16), o1); }
        WAVE_SYNC();
    }
    const float ss = wave_sum(o0 * o0 + o1 * o1);
    const float r = 1.0f / sqrtf(ss * (1.0f / HD) + EPS);
    const int d = 2 * lane;
    const unsigned gt = *(const unsigned*)(proj + tok * NP + C_SBG + h * HD + d);
    const float y0 = o0 * r * gain[h * HD + d] * silu(bf2f(gt & 0xffffu)), y1 = o1 * r * gain[h * HD + d + 1] * silu(bf2f(gt >> 16));
    *(unsigned*)(mixed + tok * DM + h * HD + d) = pk2(y0, y1);
}

__global__ void __launch_bounds__(128) k_naive_index(const bf16_t* __restrict__ proj, const float* __restrict__ iw, unsigned long long* __restrict__ mask) {
    __shared__ float qi[2][IH * ID]; __shared__ unsigned keys[2][SEQ]; __shared__ float wv[2][16];
    const int lane = threadIdx.x & 63, w = threadIdx.x >> 6;
    const int gq = blockIdx.x * 2 + w, t = gq % SEQ, b = gq / SEQ;
    const size_t tok = (size_t)gq;
    for (int i = lane; i < IH * ID; i += 64) qi[w][i] = bf2f(proj[tok * NP + C_IQ + i]);
    if (lane < 16) wv[w][lane] = iw[tok * 16 + lane];
    WAVE_SYNC();
    const int N = t + 1, nch = (N + 63) >> 6;
    for (int c = 0; c < nch; ++c) {
        const int s = c * 64 + lane; unsigned key = 0u;
        if (s <= t) {
            float kf[ID];
            const u32x4* kr = (const u32x4*)(proj + ((size_t)b * SEQ + s) * NP + C_IK);
#pragma unroll
            for (int j = 0; j < 8; ++j) { const u32x4 kv = kr[j];
#pragma unroll
                for (int e = 0; e < 4; ++e) { kf[8 * j + 2 * e] = bf2f(kv[e] & 0xffffu); kf[8 * j + 2 * e + 1] = bf2f(kv[e] >> 16); } }
            float sc = 0.f;
            for (int hh = 0; hh < IH; ++hh) { float d = 0.f;
#pragma unroll
                for (int e = 0; e < ID; ++e) d = fmaf(qi[w][hh * ID + e], kf[e], d);
                sc = fmaf(wv[w][hh], fmaxf(d, 0.f), sc); }
            key = fkey(sc);
        }
        keys[w][s] = key;
    }
    WAVE_SYNC();
    unsigned long long* mrow = mask + tok * 64;
    if (N <= TOPK) {
        for (int e = 0; e < 64; ++e) { const int s = e * 64 + lane; const unsigned long long bm = __ballot(s <= t); if (lane == 0) mrow[e] = bm; }
        return;
    }
    for (int e = 0; e < 64; ++e) {
        unsigned long long bm = 0ull;
        if (e < nch) {
            const int i = e * 64 + lane; const unsigned my = (i < N) ? keys[w][i] : 0u; int cnt = 0;
            for (int j = 0; j < N; ++j) { const unsigned kj = keys[w][j]; cnt += (kj > my || (kj == my && j < i)) ? 1 : 0; }
            bm = __ballot(i < N && cnt < TOPK);
        }
        if (lane == 0) mrow[e] = bm;
    }
}

__global__ void __launch_bounds__(256) k_naive_dsa(const bf16_t* __restrict__ proj, const unsigned long long* __restrict__ mask, const float* __restrict__ gain, bf16_t* __restrict__ mixed) {
    __shared__ float qs[4][128]; __shared__ float wsh[4][64];
    const int lane = threadIdx.x & 63, w = threadIdx.x >> 6;
    const int gid = blockIdx.x * 4 + w;
    const int t = gid % SEQ, h = (gid / SEQ) % DSH, b = gid / (SEQ * DSH), g = h / 4;
    const size_t tok = (size_t)b * SEQ + t;
    const bf16_t* qrow = proj + tok * NP + C_DQ + h * HD;
    qs[w][lane] = bf2f(qrow[lane]); qs[w][lane + 64] = bf2f(qrow[lane + 64]);
    WAVE_SYNC();
    float o0 = 0.f, o1 = 0.f, m = -1e30f, l = 0.f;
    const int nch = (t >> 6) + 1;
    for (int c = 0; c < nch; ++c) {
        const unsigned long long word = mask[tok * 64 + c];
        if (word == 0ull) continue;
        const int s = c * 64 + lane; const bool sel = (word >> lane) & 1ull;
        float s2 = -INFINITY;
        if (sel) { float z = 0.f;
            const u32x4* kr = (const u32x4*)(proj + ((size_t)b * SEQ + s) * NP + C_DK + g * HD);
#pragma unroll 4
            for (int j = 0; j < 16; ++j) { const u32x4 kv = kr[j];
#pragma unroll
                for (int e = 0; e < 4; ++e) { z = fmaf(qs[w][8 * j + 2 * e], bf2f(kv[e] & 0xffffu), z); z = fmaf(qs[w][8 * j + 2 * e + 1], bf2f(kv[e] >> 16), z); } }
            s2 = z; }
        const float mn = fmaxf(m, wave_max(s2));
        const float alpha = __builtin_amdgcn_exp2f(m - mn);
        const float p = sel ? __builtin_amdgcn_exp2f(s2 - mn) : 0.f;
        l = l * alpha + wave_sum(p); o0 *= alpha; o1 *= alpha; m = mn;
        wsh[w][lane] = p;
        WAVE_SYNC();
        const bf16_t* vb = proj + ((size_t)b * SEQ + c * 64) * NP + C_DV + g * HD + 2 * lane;
        for (int ss = 0; ss < 64; ++ss) { const float ww = wsh[w][ss]; if (ww != 0.f) { const unsigned vv = *(const unsigned*)(vb + (size_t)ss * NP); o0 = fmaf(ww, bf2f(vv & 0xffffu), o0); o1 = fmaf(ww, bf2f(vv >> 16), o1); } }
        WAVE_SYNC();
    }
    const float il = 1.0f / l; o0 *= il; o1 *= il;
    const float ss = wave_sum(o0 * o0 + o1 * o1);
    const float r = 1.0f / sqrtf(ss * (1.0f / HD) + EPS);
    const int d = 2 * lane;
    const unsigned gt = *(const unsigned*)(proj + tok * NP + C_DG + h * HD + d);
    const float y0 = o0 * r * gain[h * HD + d] * silu(bf2f(gt & 0xffffu)), y1 = o1 * r * gain[h * HD + d + 1] * silu(bf2f(gt >> 16));
    *(unsigned*)(mixed + tok * DM + 1024 + h * HD + d) = pk2(y0, y1);
}

__global__ void __launch_bounds__(256) k_final_norm(float* __restrict__ y, const float* __restrict__ g) {
    const int lane = threadIdx.x & 63, row = blockIdx.x * 4 + (threadIdx.x >> 6);
    f32x4* yr = (f32x4*)(y + (size_t)row * DM) + lane;
    f32x4 v[8]; float s = 0.f;
#pragma unroll
    for (int j = 0; j < 8; ++j) { v[j] = yr[64 * j]; s += (v[j].x * v[j].x + v[j].y * v[j].y) + (v[j].z * v[j].z + v[j].w * v[j].w); }
    const float r = 1.0f / sqrtf(wave_sum(s) * (1.0f / DM) + EPS);
    const f32x4* gr = (const f32x4*)g + lane;
#pragma unroll
    for (int j = 0; j < 8; ++j) { const f32x4 gg = gr[64 * j]; yr[64 * j] = (f32x4){v[j].x * r * gg.x, v[j].y * r * gg.y, v[j].z * r * gg.z, v[j].w * r * gg.w}; }
}


namespace pg8 {
#define PG8_LAS __attribute__((address_space(3)))
typedef unsigned short bf16_t;
typedef short bf16x8 __attribute__((ext_vector_type(8)));
typedef float f32x4 __attribute__((ext_vector_type(4)));
typedef unsigned u32x4 __attribute__((ext_vector_type(4)));
constexpr int BM = 256, BK = 64, HALF = 128, HTB = HALF * BK * 2  , STAGE_BYTES = 8 * HTB, NXCD = 8, WGM = 8;

__host__ __device__ __forceinline__ int lds_byte(int r, int c) { const int st = (r >> 4) * 2 + (c >> 5), rr = r & 15, cc = c & 31, ob = rr * 64 + cc * 2; return st * 1024 + (ob ^ (((ob >> 9) & 1) << 5)); }
__host__ __device__ __forceinline__ void stage_rc(int b, int& R, int& C) { const int st = b / 1024, sb = b % 1024, swz = sb ^ (((sb >> 9) & 1) << 5); R = (st >> 1) * 16 + swz / 64; C = (st & 1) * 32 + (swz % 64) / 2; }
__host__ __device__ __forceinline__ int perm32(int rho) { const int n = rho >> 4, i = rho & 15; return 8 * (i >> 2) + 4 * n + (i & 3); }

struct Unit { int pm, pn; };
struct Gemm { const bf16_t* A; const bf16_t* Bt; int M, N, K; };

struct StaticOrder {
    int nM, nN, nwg, G, c;
    __host__ __device__ void init(int M, int N, int G_, int c_) { nM = M / BM; nN = N / BM; nwg = nM * nN; G = G_; c = c_; }
    __host__ __device__ bool next(int i, Unit& u) const {
        const long L = (long)i * G + c; if (L >= nwg) return false;
        int wgid = (int)L; { const int q = nwg / NXCD, r = nwg % NXCD, xcd = wgid % NXCD, off = wgid / NXCD; wgid = (xcd < r ? xcd * (q + 1) : r * (q + 1) + (xcd - r) * q) + off; }
        const int nig = WGM * nN, gid = wgid / nig, fm = gid * WGM, gsz = (nM - fm) < WGM ? (nM - fm) : WGM;
        u.pm = fm + ((wgid % nig) % gsz); u.pn = (wgid % nig) / gsz; return true;
    }
    __device__ __forceinline__ void a_ready(const Unit&) const {}
    __device__ __forceinline__ void done(const Unit&) const {}
};
}

namespace pg8 {
__device__ __forceinline__ unsigned cvt_pk_bf16(float lo, float hi) { unsigned r; asm volatile("v_cvt_pk_bf16_f32 %0, %1, %2" : "=v"(r) : "v"(lo), "v"(hi)); return r; }
struct EpiProj {
    static constexpr bool PERM = true, AFTER_DRAIN = false;
    bf16_t* proj; float* iw; const float* r128; const float* r64;
    __device__ __forceinline__ void operator()(const f32x4 (&acc)[2][2][4][2], const Unit& u, int wr, int wc, int fr, int fq) const {
        const int pn = u.pn;
        const int row0 = u.pm * BM + wr * 64 + fr, col0 = pn * BM + wc * 32 + 8 * fq;
        const bool rope128 = (pn >= 16 && pn <= 20) && wc == 0;
        const bool rope64 = ((pn >= 26 && pn <= 29) && (wc & 1) == 0) || (pn == 30 && wc == 0);
        const bool iwt = (pn == 30 && wc == 2);
        const float sc = (pn < 4 || (pn >= 16 && pn < 20)) ? C2 : 1.f;
#pragma unroll
        for (int ai = 0; ai < 2; ++ai)
#pragma unroll
            for (int m = 0; m < 4; ++m) {
                const int row = row0 + ai * HALF + m * 16;
                f32x4 cs0 = {1.f, 1.f, 1.f, 1.f}, cs1 = cs0, sn0 = {0.f, 0.f, 0.f, 0.f}, sn1 = sn0;
                if (rope128) { const float* t = r128 + (size_t)row * 32 + 8 * (fq & 1); cs0 = *(const f32x4*)t; cs1 = *(const f32x4*)(t + 4); sn0 = *(const f32x4*)(t + 16); sn1 = *(const f32x4*)(t + 20);
                    if (fq < 2) { sn0 = -sn0; sn1 = -sn1; } }
                if (rope64) { const float* t = r64 + (size_t)row * 16; cs0 = *(const f32x4*)t; cs1 = *(const f32x4*)(t + 4); sn0 = *(const f32x4*)(t + 8); sn1 = *(const f32x4*)(t + 12);
                    if (fq == 0) { sn0 = -sn0; sn1 = -sn1; } if (fq >= 2) { cs0 = (f32x4){1.f, 1.f, 1.f, 1.f}; cs1 = cs0; sn0 = (f32x4){0.f, 0.f, 0.f, 0.f}; sn1 = sn0; } }
                bf16_t* rowp = proj + (size_t)row * NP + col0;
#pragma unroll
                for (int bj = 0; bj < 2; ++bj) {
                    f32x4 v0 = acc[ai][bj][m][0] * sc, v1 = acc[ai][bj][m][1] * sc;
                    if (rope128 || (rope64 && (pn != 30 || bj == 0))) {
                        const int xm = rope128 ? 32 : 16;
                        f32x4 p0, p1;
#pragma unroll
                        for (int e = 0; e < 4; ++e) { p0[e] = __shfl_xor(v0[e], xm); p1[e] = __shfl_xor(v1[e], xm); }
                        v0 = v0 * cs0 + p0 * sn0; v1 = v1 * cs1 + p1 * sn1;
                    }
                    if (iwt && bj == 0 && fq < 2) { float* ip = iw + (size_t)row * 16 + 8 * fq; *(f32x4*)ip = v0 * IWS; *(f32x4*)(ip + 4) = v1 * IWS; }
                    u32x4 w; w.x = cvt_pk_bf16(v0[0], v0[1]); w.y = cvt_pk_bf16(v0[2], v0[3]); w.z = cvt_pk_bf16(v1[0], v1[1]); w.w = cvt_pk_bf16(v1[2], v1[3]);
                    *(u32x4*)(rowp + bj * HALF) = w;
                }
            }
    }
};
}

namespace pg8 {
struct EpiOut {
    static constexpr bool PERM = true, AFTER_DRAIN = false;
    const float* x; float* out; float* ssp;
    __device__ __forceinline__ void operator()(const f32x4 (&acc)[2][2][4][2], const Unit& u, int wr, int wc, int fr, int fq) const {
        const int row0 = u.pm * BM + wr * 64 + fr, col0 = u.pn * BM + wc * 32 + 8 * fq;
#pragma unroll
        for (int ai = 0; ai < 2; ++ai)
#pragma unroll
            for (int m = 0; m < 4; ++m) {
                const int row = row0 + ai * HALF + m * 16; const size_t off = (size_t)row * DM + col0; float s = 0.f;
#pragma unroll
                for (int bj = 0; bj < 2; ++bj) {
                    const f32x4 y0 = *(const f32x4*)(x + off + bj * HALF) + acc[ai][bj][m][0], y1 = *(const f32x4*)(x + off + bj * HALF + 4) + acc[ai][bj][m][1];
                    *(f32x4*)(out + off + bj * HALF) = y0; *(f32x4*)(out + off + bj * HALF + 4) = y1;
                    s += (y0[0] * y0[0] + y0[1] * y0[1]) + (y0[2] * y0[2] + y0[3] * y0[3]) + (y1[0] * y1[0] + y1[1] * y1[1]) + (y1[2] * y1[2] + y1[3] * y1[3]);
                }
                s += __shfl_xor(s, 16); s += __shfl_xor(s, 32);
                if (fq == 0) ssp[(size_t)row * 32 + u.pn * 4 + wc] = s;
            }
    }
};
}
namespace pg8 {
template <class Epi, class Sched, bool ALIGN_EPI = false, bool SP2 = false>
__device__ __forceinline__ void gemm_phase(PG8_LAS unsigned char* lds, const Gemm g, const Sched& S, const Epi& E) {
    const int tid = threadIdx.x, wid = __builtin_amdgcn_readfirstlane(tid >> 6), lane = tid & 63, wr = wid >> 2, wc = wid & 3, fr = lane & 15, fq = lane >> 4;
    const int K = g.K, nt = K / BK;
    unsigned voffA[2], voffB[2];
#pragma unroll
    for (int i = 0; i < 2; ++i) { int R, C; stage_rc(tid * 16 + i * 8192, R, C); const int Rb = Epi::PERM ? ((R & ~31) + perm32(R & 31)) : R;
        voffA[i] = (unsigned)(R * K + C) * 2u; voffB[i] = (unsigned)(Rb * K + C) * 2u; }
    const size_t kstep = (size_t)(BK * 2);
    const size_t hstep = (size_t)HALF * K * 2;
    const size_t tstep = 2 * hstep;
    const unsigned ldsw = (unsigned)wid * 1024u;
    const int aoff = lds_byte(wr * 64 + fr, fq * 8), boff = lds_byte(wc * 32 + fr, fq * 8);
#define PG8_SA(b, h) (((b) * 2 + (h)) * HTB)
#define PG8_SB(b, h) ((4 + (b) * 2 + (h)) * HTB)
#define PG8_STAGE(bufoff, gbase, voff) do { _Pragma("unroll") for (int _i = 0; _i < 2; ++_i) \
        __builtin_amdgcn_global_load_lds((const unsigned*)((const char*)(gbase) + (voff)[_i]), (PG8_LAS unsigned*)(lds + (bufoff) + ldsw + _i * 8192), 16, 0, 0); } while (0)
#define PG8_LDA(dst, b, h) do { _Pragma("unroll") for (int m = 0; m < 4; ++m) _Pragma("unroll") for (int k = 0; k < 2; ++k) dst[m][k] = *(const PG8_LAS bf16x8*)(lds + PG8_SA(b, h) + aoff + m * 2048 + k * 1024); } while (0)
#define PG8_LDB(dst, b, h) do { _Pragma("unroll") for (int n = 0; n < 2; ++n) _Pragma("unroll") for (int k = 0; k < 2; ++k) dst[n][k] = *(const PG8_LAS bf16x8*)(lds + PG8_SB(b, h) + boff + n * 2048 + k * 1024); } while (0)
#define PG8_MMA(ai, bj, At, Bt) do { __builtin_amdgcn_s_setprio(1); _Pragma("unroll") for (int m = 0; m < 4; ++m) _Pragma("unroll") for (int n = 0; n < 2; ++n) _Pragma("unroll") for (int k = 0; k < 2; ++k) \
        acc[ai][bj][m][n] = __builtin_amdgcn_mfma_f32_16x16x32_bf16(Bt[n][k], At[m][k], acc[ai][bj][m][n], 0, 0, 0); __builtin_amdgcn_s_setprio(0); } while (0)
#define PG8_WAIT_V(n) asm volatile("s_waitcnt vmcnt(" #n ")" ::: "memory")
#define PG8_WAIT_L(n) asm volatile("s_waitcnt lgkmcnt(" #n ")" ::: "memory")
#define PG8_BAR __builtin_amdgcn_s_barrier()
#define PG8_SCHED __builtin_amdgcn_sched_barrier(0)
    Unit cur, nxt; int ui = 0;
    if (!S.next(0, cur)) return;
    f32x4 acc[2][2][4][2];
#pragma unroll
    for (int a = 0; a < 2; ++a)
#pragma unroll
        for (int b = 0; b < 2; ++b)
#pragma unroll
            for (int m = 0; m < 4; ++m)
#pragma unroll
                for (int n = 0; n < 2; ++n) acc[a][b][m][n] = (f32x4){0.f, 0.f, 0.f, 0.f};
    bf16x8 At[4][2], B0[2][2], B1[2][2];
    const char* cA = (const char*)g.A + (size_t)cur.pm * tstep; const char* cB = (const char*)g.Bt + (size_t)cur.pn * tstep;
    S.a_ready(cur);
    if constexpr (SP2) {
        PG8_STAGE(PG8_SB(0, 0), cB, voffB); PG8_STAGE(PG8_SB(0, 1), cB + hstep, voffB); PG8_STAGE(PG8_SA(0, 0), cA, voffA); PG8_STAGE(PG8_SA(0, 1), cA + hstep, voffA);
        if (wr == 1) PG8_BAR;
        PG8_WAIT_V(2); PG8_BAR;
        PG8_STAGE(PG8_SB(1, 0), cB + kstep, voffB); PG8_STAGE(PG8_SA(1, 0), cA + kstep, voffA); PG8_STAGE(PG8_SB(1, 1), cB + hstep + kstep, voffB);
        PG8_WAIT_V(6); PG8_BAR;
    } else {
        PG8_STAGE(PG8_SB(0, 0), cB, voffB); PG8_STAGE(PG8_SA(0, 0), cA, voffA); PG8_STAGE(PG8_SB(0, 1), cB + hstep, voffB); PG8_STAGE(PG8_SA(0, 1), cA + hstep, voffA);
        if (wr == 1) PG8_BAR;
        PG8_WAIT_V(4); PG8_BAR;
        PG8_STAGE(PG8_SB(1, 0), cB + kstep, voffB); PG8_STAGE(PG8_SA(1, 0), cA + kstep, voffA); PG8_STAGE(PG8_SB(1, 1), cB + hstep + kstep, voffB);
        PG8_WAIT_V(6); PG8_BAR;
    }
    for (;;) {
        const bool has_next = S.next(ui + 1, nxt);
        const char* nA = has_next ? (const char*)g.A + (size_t)nxt.pm * tstep : cA; const char* nB = has_next ? (const char*)g.Bt + (size_t)nxt.pn * tstep : cB;
        for (int t = 0; t < nt; t += 2) {
            const bool last = (t == nt - 2);
            const char* a1 = cA + (size_t)(t + 1) * kstep;
            const char* a2 = last ? nA : cA + (size_t)(t + 2) * kstep; const char* b2 = last ? nB : cB + (size_t)(t + 2) * kstep;
            const char* a3 = a2 + kstep; const char* b3 = b2 + kstep;
            if (last && has_next) S.a_ready(nxt);
            if constexpr (SP2) {
            PG8_LDB(B0, 0, 0); PG8_LDB(B1, 0, 1); PG8_SCHED; PG8_LDA(At, 0, 0); PG8_STAGE(PG8_SA(1, 1), a1 + hstep, voffA);
            PG8_WAIT_V(8); PG8_WAIT_L(0); PG8_BAR; PG8_MMA(0, 0, At, B0); PG8_MMA(0, 1, At, B1); PG8_BAR; PG8_SCHED;
            PG8_LDA(At, 0, 1); PG8_STAGE(PG8_SB(0, 0), b2, voffB); PG8_STAGE(PG8_SB(0, 1), b2 + hstep, voffB); PG8_STAGE(PG8_SA(0, 0), a2, voffA);
            PG8_WAIT_V(8); PG8_WAIT_L(0); PG8_BAR; PG8_MMA(1, 0, At, B0); PG8_MMA(1, 1, At, B1); PG8_BAR; PG8_SCHED;
            PG8_LDB(B0, 1, 0); PG8_LDB(B1, 1, 1); PG8_SCHED; PG8_LDA(At, 1, 0); PG8_STAGE(PG8_SA(0, 1), a2 + hstep, voffA);
            PG8_WAIT_V(8); PG8_WAIT_L(0); PG8_BAR; PG8_MMA(0, 0, At, B0); PG8_MMA(0, 1, At, B1); PG8_BAR; PG8_SCHED;
            PG8_LDA(At, 1, 1); PG8_STAGE(PG8_SB(1, 0), b3, voffB); PG8_STAGE(PG8_SB(1, 1), b3 + hstep, voffB); PG8_STAGE(PG8_SA(1, 0), a3, voffA);
            PG8_WAIT_V(8); PG8_WAIT_L(0); PG8_BAR; PG8_MMA(1, 0, At, B0); PG8_MMA(1, 1, At, B1); PG8_BAR; PG8_SCHED;
            } else {
            PG8_LDB(B0, 0, 0); PG8_SCHED; PG8_LDA(At, 0, 0); PG8_STAGE(PG8_SA(1, 1), a1 + hstep, voffA);
            PG8_WAIT_L(8); PG8_BAR; PG8_WAIT_L(0); PG8_MMA(0, 0, At, B0); PG8_BAR; PG8_SCHED;
            PG8_LDB(B1, 0, 1); PG8_STAGE(PG8_SB(0, 0), b2, voffB);
            PG8_BAR; PG8_WAIT_L(0); PG8_MMA(0, 1, At, B1); PG8_BAR;
            PG8_LDA(At, 0, 1); PG8_STAGE(PG8_SA(0, 0), a2, voffA);
            PG8_BAR; PG8_WAIT_L(0); PG8_MMA(1, 0, At, B0); PG8_BAR; PG8_SCHED;
            PG8_STAGE(PG8_SB(0, 1), b2 + hstep, voffB);
            PG8_WAIT_V(6); PG8_BAR; PG8_MMA(1, 1, At, B1); PG8_BAR;
            PG8_LDB(B0, 1, 0); PG8_SCHED; PG8_LDA(At, 1, 0); PG8_STAGE(PG8_SA(0, 1), a2 + hstep, voffA);
            PG8_WAIT_L(8); PG8_BAR; PG8_WAIT_L(0); PG8_MMA(0, 0, At, B0); PG8_BAR; PG8_SCHED;
            PG8_LDB(B1, 1, 1); PG8_STAGE(PG8_SB(1, 0), b3, voffB);
            PG8_BAR; PG8_WAIT_L(0); PG8_MMA(0, 1, At, B1); PG8_BAR;
            PG8_LDA(At, 1, 1); PG8_STAGE(PG8_SA(1, 0), a3, voffA);
            PG8_BAR; PG8_WAIT_L(0); PG8_MMA(1, 0, At, B0); PG8_BAR; PG8_SCHED;
            PG8_STAGE(PG8_SB(1, 1), b3 + hstep, voffB);
            PG8_WAIT_V(6); PG8_BAR; PG8_MMA(1, 1, At, B1); PG8_BAR;
            }
        }
        if constexpr (ALIGN_EPI) { if (wr == 0) PG8_BAR; }
        if constexpr (!Epi::AFTER_DRAIN) { E(acc, cur, wr, wc, fr, fq); S.done(cur); }
        if (!has_next) break;
#pragma unroll
        for (int a = 0; a < 2; ++a)
#pragma unroll
            for (int b = 0; b < 2; ++b)
#pragma unroll
                for (int m = 0; m < 4; ++m)
#pragma unroll
                    for (int n = 0; n < 2; ++n) acc[a][b][m][n] = (f32x4){0.f, 0.f, 0.f, 0.f};
        cur = nxt; cA = nA; cB = nB; ++ui;
        if constexpr (ALIGN_EPI) { if (wr == 1) PG8_BAR; }
    }
    PG8_WAIT_V(0);
    if constexpr (!ALIGN_EPI) { if (wr == 0) PG8_BAR; }
    PG8_BAR;
    if constexpr (Epi::AFTER_DRAIN) { E.fused(acc, cur, wr, wc, fr, fq, lds, wid, lane); S.done(cur); }
#undef PG8_SA
#undef PG8_SB
#undef PG8_STAGE
#undef PG8_LDA
#undef PG8_LDB
#undef PG8_MMA
#undef PG8_WAIT_V
#undef PG8_WAIT_L
#undef PG8_BAR
#undef PG8_SCHED
}
}

namespace att {
#define ALAS __attribute__((address_space(3)))
using bf16x8 = __attribute__((ext_vector_type(8))) short;
using s16x4  = __attribute__((ext_vector_type(4))) short;
using f32x16 = __attribute__((ext_vector_type(16))) float;
constexpr int KVBLK = 64, SHM_V = KVBLK * 128 * 2, SHM_K = KVBLK * 128 * 2;
constexpr int L_V = 0, L_K = 2 * SHM_V, L_FLAG = 2 * SHM_V + 2 * SHM_K;
#define KSWZ(row, colB) ((row) * 256 + ((colB) ^ (((row) & 7) << 4)))
#define SBAR() __builtin_amdgcn_sched_barrier(0)
__device__ __forceinline__ int crow(int r, int hi) { return (r & 3) + 8 * (r >> 2) + 4 * hi; }
__device__ __forceinline__ unsigned cvtpk(float lo, float hi) { unsigned r; asm volatile("v_cvt_pk_bf16_f32 %0, %1, %2" : "=v"(r) : "v"(lo), "v"(hi)); return r; }
__device__ __forceinline__ void qkt(f32x16& p0, f32x16& p1, const ALAS unsigned char* Ks, const bf16x8* qr, int r32, int hi) {
    p0 = f32x16{}; p1 = f32x16{};
#pragma unroll
    for (int d0 = 0; d0 < 8; ++d0) { const int cb = (d0 * 16 + hi * 8) * 2;
        const bf16x8 b0 = *(const ALAS bf16x8*)(Ks + KSWZ(r32, cb));
        const bf16x8 b1 = *(const ALAS bf16x8*)(Ks + KSWZ(32 + r32, cb));
        p0 = __builtin_amdgcn_mfma_f32_32x32x16_bf16(b0, qr[d0], p0, 0, 0, 0);
        p1 = __builtin_amdgcn_mfma_f32_32x32x16_bf16(b1, qr[d0], p1, 0, 0, 0); }
}
__device__ __forceinline__ int v_st(int k, int c) { const int kk = (k & ~0xC) | ((k & 4) << 1) | ((k & 8) >> 1); return ((kk >> 3) * 4 + (c >> 5)) * 512 + ((kk & 7) * 32 + (c & 31)) * 2; }
__device__ __forceinline__ int v_rd_base(int lane) { return ((lane & 3) << 3) | (((lane >> 2) & 3) << 6) | (((lane >> 4) & 1) << 5) | (((lane >> 5) & 1) << 8); }
constexpr int v_rd_off(int d0, int ks, int half) { return d0 * 512 + ks * 4096 + half * 2048; }
template <int OFF> __device__ __forceinline__ s16x4 tr_read(int vb) { s16x4 r; asm volatile("ds_read_b64_tr_b16 %0, %1 offset:%2" : "=&v"(r) : "v"(vb), "i"(OFF) : "memory"); return r; }
template <int D0> __device__ __forceinline__ void pv_one(f32x16& od, int vb, bf16x8 pa0, bf16x8 pa1, bf16x8 pa2, bf16x8 pa3) {
    const s16x4 l0 = tr_read<v_rd_off(D0, 0, 0)>(vb), h0 = tr_read<v_rd_off(D0, 0, 1)>(vb), l1 = tr_read<v_rd_off(D0, 1, 0)>(vb), h1 = tr_read<v_rd_off(D0, 1, 1)>(vb);
    const s16x4 l2 = tr_read<v_rd_off(D0, 2, 0)>(vb), h2 = tr_read<v_rd_off(D0, 2, 1)>(vb), l3 = tr_read<v_rd_off(D0, 3, 0)>(vb), h3 = tr_read<v_rd_off(D0, 3, 1)>(vb);
    asm volatile("s_waitcnt lgkmcnt(0)" ::: "memory"); SBAR();
#define PK(L, H) (bf16x8){L[0], L[1], L[2], L[3], H[0], H[1], H[2], H[3]}
    od = __builtin_amdgcn_mfma_f32_32x32x16_bf16(pa0, PK(l0, h0), od, 0, 0, 0);
    od = __builtin_amdgcn_mfma_f32_32x32x16_bf16(pa1, PK(l1, h1), od, 0, 0, 0);
    od = __builtin_amdgcn_mfma_f32_32x32x16_bf16(pa2, PK(l2, h2), od, 0, 0, 0);
    od = __builtin_amdgcn_mfma_f32_32x32x16_bf16(pa3, PK(l3, h3), od, 0, 0, 0);
#undef PK
}
__device__ __forceinline__ void pv_d0(f32x16* o, int vb, bf16x8 pa0, bf16x8 pa1, bf16x8 pa2, bf16x8 pa3) {
    pv_one<0>(o[0], vb, pa0, pa1, pa2, pa3); pv_one<1>(o[1], vb, pa0, pa1, pa2, pa3); pv_one<2>(o[2], vb, pa0, pa1, pa2, pa3); pv_one<3>(o[3], vb, pa0, pa1, pa2, pa3);
}
__device__ __forceinline__ void pack_p(const f32x16& p0, const f32x16& p1, bf16x8& pa0, bf16x8& pa1, bf16x8& pa2, bf16x8& pa3) {
#define PK4(P, BASE, OUT) do { unsigned a0 = cvtpk(P[BASE + 0], P[BASE + 1]), a1 = cvtpk(P[BASE + 2], P[BASE + 3]);   \
    unsigned b0 = cvtpk(P[BASE + 4], P[BASE + 5]), b1 = cvtpk(P[BASE + 6], P[BASE + 7]);                              \
    auto r0 = __builtin_amdgcn_permlane32_swap(a0, b0, false, false); auto r1 = __builtin_amdgcn_permlane32_swap(a1, b1, false, false); \
    u32x4 w = {r0[0], r1[0], r0[1], r1[1]}; OUT = *reinterpret_cast<bf16x8*>(&w); } while (0)
    PK4(p0, 0, pa0); PK4(p0, 8, pa1); PK4(p1, 0, pa2); PK4(p1, 8, pa3);
#undef PK4
}
__device__ __forceinline__ float sp2(float z2) { return fmaxf(z2, 0.f) + __builtin_amdgcn_logf(1.0f + __builtin_amdgcn_exp2f(-fabsf(z2))); }
__device__ __forceinline__ void sb_weights(f32x16& p0, f32x16& p1, float& R, int hi) {
    float nl[32];
#pragma unroll
    for (int i = 0; i < 16; ++i) { const float z = p0[i], s = sp2(z); nl[i] = s; p0[i] = z - s; }
#pragma unroll
    for (int i = 0; i < 16; ++i) { const float z = p1[i], s = sp2(z); nl[16 + i] = s; p1[i] = z - s; }
    float S[9]; S[8] = 0.f;
#pragma unroll
    for (int g = 7; g >= 0; --g) S[g] = S[g + 1] + ((nl[4 * g] + nl[4 * g + 1]) + (nl[4 * g + 2] + nl[4 * g + 3]));
    float tot; { auto rr = __builtin_amdgcn_permlane32_swap(__float_as_uint(S[0]), __float_as_uint(S[0]), false, false); tot = __uint_as_float(rr[0]) + __uint_as_float(rr[1]); }
#pragma unroll
    for (int g = 0; g < 8; ++g) {
        const float snd = hi ? S[g] : S[g + 1];
        auto rr = __builtin_amdgcn_permlane32_swap(__float_as_uint(snd), __float_as_uint(snd), false, false);
        const float rcv = hi ? __uint_as_float(rr[0]) : __uint_as_float(rr[1]);
        const float t3 = R - S[g + 1] - rcv, t2 = t3 - nl[4 * g + 3], t1 = t2 - nl[4 * g + 2], t0 = t1 - nl[4 * g + 1];
        if (g < 4) { p0[4 * g + 3] = __builtin_amdgcn_exp2f(p0[4 * g + 3] + t3); p0[4 * g + 2] = __builtin_amdgcn_exp2f(p0[4 * g + 2] + t2); p0[4 * g + 1] = __builtin_amdgcn_exp2f(p0[4 * g + 1] + t1); p0[4 * g] = __builtin_amdgcn_exp2f(p0[4 * g] + t0); }
        else { const int q = 4 * (g - 4); p1[q + 3] = __builtin_amdgcn_exp2f(p1[q + 3] + t3); p1[q + 2] = __builtin_amdgcn_exp2f(p1[q + 2] + t2); p1[q + 1] = __builtin_amdgcn_exp2f(p1[q + 1] + t1); p1[q] = __builtin_amdgcn_exp2f(p1[q] + t0); }
    }
    R -= tot;
}
constexpr float SB_EXIT = -160.0f;
template <bool EARLY>
__device__ __forceinline__ void sb_unit(ALAS unsigned char* lds, const bf16_t* __restrict__ proj, const float* __restrict__ gain, bf16_t* __restrict__ mixed, int b, int h, int qb) {
    const int tid = threadIdx.x, wid = __builtin_amdgcn_readfirstlane(tid >> 6), lane = tid & 63, r32 = lane & 31, hi = lane >> 5;
    const size_t tok0 = (size_t)b * SEQ; const int q0 = qb * 256, tw0 = q0 + 32 * wid;
    const bf16_t* Kg = proj + tok0 * NP + C_SBK + h * HD; const bf16_t* Vg = proj + tok0 * NP + C_SBV + h * HD;
    bf16x8 qr[8];
    { const bf16_t* Qw = proj + (tok0 + tw0 + r32) * NP + C_SBQ + h * HD + hi * 8;
#pragma unroll
      for (int d0 = 0; d0 < 8; ++d0) qr[d0] = *(const bf16x8*)(Qw + d0 * 16); }
    const int sr = tid >> 4, sc = (tid & 15) * 8;
    const int vst0 = v_st(sr, sc), vst1 = v_st(32 + sr, sc), kst0 = KSWZ(sr, sc * 2), kst1 = KSWZ(32 + sr, sc * 2);
    const int vb0 = (int)(unsigned)(size_t)(lds + L_V) + v_rd_base(lane);
    ALAS unsigned* flags = (ALAS unsigned*)(lds + L_FLAG);
    bf16x8 ks0, ks1, vs0, vs1;
#define SLOAD(k0) do { const size_t o0 = (size_t)((k0) + sr) * NP + sc, o1 = (size_t)((k0) + 32 + sr) * NP + sc; \
    vs0 = *(const bf16x8*)(Vg + o0); vs1 = *(const bf16x8*)(Vg + o1); ks0 = *(const bf16x8*)(Kg + o0); ks1 = *(const bf16x8*)(Kg + o1); } while (0)
#define SWRITE(bf) do { *(ALAS bf16x8*)(lds + L_V + (bf) * SHM_V + vst0) = vs0; *(ALAS bf16x8*)(lds + L_V + (bf) * SHM_V + vst1) = vs1; \
    *(ALAS bf16x8*)(lds + L_K + (bf) * SHM_K + kst0) = ks0; *(ALAS bf16x8*)(lds + L_K + (bf) * SHM_K + kst1) = ks1; } while (0)
    const int jmax = 4 * qb + 3;
    SLOAD(jmax * KVBLK); SWRITE(0); __syncthreads();
    float R = 0.f; f32x16 o[4] = {};
    for (int it = 0, j = jmax;; ++it, --j) {
        const int cur = it & 1, key0 = j * KVBLK;
        const bool act = key0 < tw0 + 31;
        if (!act && j > 0) SLOAD((j - 1) * KVBLK);
        if (act) {
            f32x16 p0, p1;
            qkt(p0, p1, lds + L_K + cur * SHM_K, qr, r32, hi);
            if (key0 + 63 >= tw0) {
                const int lim = tw0 + r32 - key0 - 4 * hi;
#pragma unroll
                for (int i = 0; i < 16; ++i) { const int kk = 8 * (i >> 2) + (i & 3); if (kk >= lim) p0[i] = -INFINITY; if (kk + 32 >= lim) p1[i] = -INFINITY; }
            }
            sb_weights(p0, p1, R, hi);
            SBAR(); if (j > 0) SLOAD((j - 1) * KVBLK); SBAR();
            bf16x8 pa0, pa1, pa2, pa3;
            pack_p(p0, p1, pa0, pa1, pa2, pa3);
            pv_d0(o, vb0 + cur * SHM_V, pa0, pa1, pa2, pa3);
        }
        if (EARLY) { const bool dn = __all(R < SB_EXIT); if (lane == 0) flags[cur * 8 + wid] = dn ? 1u : 0u; }
        if (j > 0) SWRITE(cur ^ 1);
        __syncthreads();
        if (j == 0) break;
        if (EARLY) { const u32x4 f0 = *(const ALAS u32x4*)(flags + cur * 8), f1 = *(const ALAS u32x4*)(flags + cur * 8 + 4);
            if ((f0.x & f0.y & f0.z & f0.w & f1.x & f1.y & f1.z & f1.w) != 0u) break; }
    }
#undef SLOAD
#undef SWRITE
    float rn[16];
#pragma unroll
    for (int r = 0; r < 16; ++r) { float ss = (o[0][r] * o[0][r] + o[1][r] * o[1][r]) + (o[2][r] * o[2][r] + o[3][r] * o[3][r]);
#pragma unroll
        for (int x = 1; x < 32; x <<= 1) ss += __shfl_xor(ss, x);
        rn[r] = 1.0f / sqrtf(ss * (1.0f / HD) + EPS); }
    float gn[4];
#pragma unroll
    for (int d0 = 0; d0 < 4; ++d0) gn[d0] = gain[h * HD + d0 * 32 + r32];
#pragma unroll
    for (int r = 0; r < 16; ++r) { const size_t tok = tok0 + tw0 + crow(r, hi);
        const bf16_t* gp = proj + tok * NP + C_SBG + h * HD + r32; bf16_t* op = mixed + tok * DM + h * HD + r32;
#pragma unroll
        for (int d0 = 0; d0 < 4; ++d0) { const float gt = bf2f(gp[d0 * 32]); op[d0 * 32] = (bf16_t)f2bf(o[d0][r] * rn[r] * gn[d0] * (gt / (1.0f + __expf(-gt)))); } }
}
constexpr int L_WS = L_FLAG + 64;
constexpr float DSA_THR = 11.5f;
__device__ __forceinline__ void dsa_unit(ALAS unsigned char* lds, const bf16_t* __restrict__ proj, const unsigned long long* __restrict__ mask, const float* __restrict__ gain,
                                         bf16_t* __restrict__ mixed, int b, int h, int qb) {
    const int tid = threadIdx.x, wid = __builtin_amdgcn_readfirstlane(tid >> 6), lane = tid & 63, r32 = lane & 31, hi = lane >> 5, g = h >> 2;
    const size_t tok0 = (size_t)b * SEQ; const int q0 = qb * 256, tw0 = q0 + 32 * wid;
    const bf16_t* Kg = proj + tok0 * NP + C_DK + g * HD; const bf16_t* Vg = proj + tok0 * NP + C_DV + g * HD;
    bf16x8 qr[8];
    { const bf16_t* Qw = proj + (tok0 + tw0 + r32) * NP + C_DQ + h * HD + hi * 8;
#pragma unroll
      for (int d0 = 0; d0 < 8; ++d0) qr[d0] = *(const bf16x8*)(Qw + d0 * 16); }
    const unsigned long long* mrow = mask + (tok0 + tw0 + r32) * 64;
    const int sr = tid >> 4, sc = (tid & 15) * 8;
    const int vst0 = v_st(sr, sc), vst1 = v_st(32 + sr, sc), kst0 = KSWZ(sr, sc * 2), kst1 = KSWZ(32 + sr, sc * 2);
    const int vb0 = (int)(unsigned)(size_t)(lds + L_V) + v_rd_base(lane);
    ALAS float* wsl = (ALAS float*)(lds + L_WS) + wid * 64;
    bf16x8 ks0, ks1, vs0, vs1;
#define SLOAD(k0) do { const size_t o0 = (size_t)((k0) + sr) * NP + sc, o1 = (size_t)((k0) + 32 + sr) * NP + sc; \
    vs0 = *(const bf16x8*)(Vg + o0); vs1 = *(const bf16x8*)(Vg + o1); ks0 = *(const bf16x8*)(Kg + o0); ks1 = *(const bf16x8*)(Kg + o1); } while (0)
#define SWRITE(bf) do { *(ALAS bf16x8*)(lds + L_V + (bf) * SHM_V + vst0) = vs0; *(ALAS bf16x8*)(lds + L_V + (bf) * SHM_V + vst1) = vs1; \
    *(ALAS bf16x8*)(lds + L_K + (bf) * SHM_K + kst0) = ks0; *(ALAS bf16x8*)(lds + L_K + (bf) * SHM_K + kst1) = ks1; } while (0)
    const int jmax = 4 * qb + 3;
    SLOAD(0); SWRITE(0); __syncthreads();
    float m_reg = -1e30f, l_reg = 0.f; f32x16 o[4] = {};
    for (int j = 0;; ++j) {
        const int cur = j & 1, key0 = j * KVBLK;
        const bool act = key0 <= tw0 + 31;
        unsigned long long mw = 0ull; if (act) mw = mrow[j];
        if (!act && j < jmax) SLOAD((j + 1) * KVBLK);
        if (act) {
            f32x16 p0, p1;
            qkt(p0, p1, lds + L_K + cur * SHM_K, qr, r32, hi);
            const int mlo = (int)((unsigned)mw >> (4 * hi)), mhi = (int)((unsigned)(mw >> 32) >> (4 * hi));
            const unsigned NINF = 0xff800000u;
#pragma unroll
            for (int i = 0; i < 16; ++i) { const int kk = 8 * (i >> 2) + (i & 3);
                const unsigned t0 = (unsigned)__builtin_amdgcn_sbfe(mlo, kk, 1), t1 = (unsigned)__builtin_amdgcn_sbfe(mhi, kk, 1);
                p0[i] = __uint_as_float((__float_as_uint(p0[i]) & t0) | (NINF & ~t0)); p1[i] = __uint_as_float((__float_as_uint(p1[i]) & t1) | (NINF & ~t1)); }
            float pmax = p0[0];
#pragma unroll
            for (int r = 1; r < 16; ++r) pmax = fmaxf(pmax, p0[r]);
#pragma unroll
            for (int r = 0; r < 16; ++r) pmax = fmaxf(pmax, p1[r]);
            { auto rr = __builtin_amdgcn_permlane32_swap(__float_as_uint(pmax), __float_as_uint(pmax), false, false); pmax = fmaxf(__uint_as_float(rr[0]), __uint_as_float(rr[1])); }
            float mn, alpha;
            if (__all(pmax - m_reg <= DSA_THR)) { mn = m_reg; alpha = 1.f; }
            else { mn = fmaxf(m_reg, pmax); alpha = __builtin_amdgcn_exp2f(m_reg - mn); m_reg = mn; }
            if (__any(alpha < 1.f)) { if (hi == 0) wsl[r32] = alpha; asm volatile("s_waitcnt lgkmcnt(0)" ::: "memory");
#pragma unroll
                for (int r = 0; r < 16; ++r) { const float al = wsl[crow(r, hi)];
#pragma unroll
                    for (int d = 0; d < 4; ++d) o[d][r] *= al; } }
            float ps = 0.f;
#pragma unroll
            for (int r = 0; r < 16; ++r) { p0[r] = __builtin_amdgcn_exp2f(p0[r] - mn); p1[r] = __builtin_amdgcn_exp2f(p1[r] - mn); ps += p0[r] + p1[r]; }
            { auto rr = __builtin_amdgcn_permlane32_swap(__float_as_uint(ps), __float_as_uint(ps), false, false); ps = __uint_as_float(rr[0]) + __uint_as_float(rr[1]); }
            l_reg = l_reg * alpha + ps;
            SBAR(); if (j < jmax) SLOAD((j + 1) * KVBLK); SBAR();
            bf16x8 pa0, pa1, pa2, pa3;
            pack_p(p0, p1, pa0, pa1, pa2, pa3);
            pv_d0(o, vb0 + cur * SHM_V, pa0, pa1, pa2, pa3);
        }
        if (j < jmax) SWRITE(cur ^ 1);
        __syncthreads();
        if (j == jmax) break;
    }
#undef SLOAD
#undef SWRITE
    if (hi == 0) wsl[32 + r32] = l_reg; asm volatile("s_waitcnt lgkmcnt(0)" ::: "memory");
    float rn[16];
#pragma unroll
    for (int r = 0; r < 16; ++r) { const float il = 1.0f / wsl[32 + crow(r, hi)];
#pragma unroll
        for (int d = 0; d < 4; ++d) o[d][r] *= il;
        float ss = (o[0][r] * o[0][r] + o[1][r] * o[1][r]) + (o[2][r] * o[2][r] + o[3][r] * o[3][r]);
#pragma unroll
        for (int x = 1; x < 32; x <<= 1) ss += __shfl_xor(ss, x);
        rn[r] = 1.0f / sqrtf(ss * (1.0f / HD) + EPS); }
    float gn[4];
#pragma unroll
    for (int d0 = 0; d0 < 4; ++d0) gn[d0] = gain[h * HD + d0 * 32 + r32];
#pragma unroll
    for (int r = 0; r < 16; ++r) { const size_t tok = tok0 + tw0 + crow(r, hi);
        const bf16_t* gp = proj + tok * NP + C_DG + h * HD + r32; bf16_t* op = mixed + tok * DM + 1024 + h * HD + r32;
#pragma unroll
        for (int d0 = 0; d0 < 4; ++d0) { const float gt = bf2f(gp[d0 * 32]); op[d0 * 32] = (bf16_t)f2bf(o[d0][r] * rn[r] * gn[d0] * (gt / (1.0f + __expf(-gt)))); } }
    asm volatile("s_waitcnt lgkmcnt(0)" ::: "memory");
}
}

namespace idx {
#define ILAS __attribute__((address_space(3)))
using bf16x8 = __attribute__((ext_vector_type(8))) short;
using f32x16 = __attribute__((ext_vector_type(16))) float;
constexpr int L_SC = 0, L_HIST = 131072;
__device__ __forceinline__ void index_unit(ILAS unsigned char* lds, const bf16_t* __restrict__ proj, const float* __restrict__ iw, unsigned long long* __restrict__ mask, int b, int t0) {
    const int tid = threadIdx.x, wid = __builtin_amdgcn_readfirstlane(tid >> 6), lane = tid & 63, r = lane & 31, hi = lane >> 5;
    const size_t tok0 = (size_t)b * SEQ;
    ILAS unsigned* sc = (ILAS unsigned*)(lds + L_SC);
    {
        bf16x8 af[4][4]; float wv[4][16];
#pragma unroll
        for (int T = 0; T < 4; ++T) {
            const bf16_t* qb = proj + (tok0 + t0 + 2 * T + ((r >> 2) & 1)) * NP + C_IQ + ((r & 3) + 4 * (r >> 3)) * ID + 8 * hi;
#pragma unroll
            for (int ks = 0; ks < 4; ++ks) af[T][ks] = *(const bf16x8*)(qb + 16 * ks);
            const float* wp = iw + (tok0 + t0 + 2 * T + hi) * 16;
#pragma unroll
            for (int i = 0; i < 4; ++i) { const f32x4 w4 = *(const f32x4*)(wp + 4 * i); wv[T][4 * i] = w4.x; wv[T][4 * i + 1] = w4.y; wv[T][4 * i + 2] = w4.z; wv[T][4 * i + 3] = w4.w; }
        }
        const int nt32 = 2 * ((t0 + 8 + 63) >> 6);
        const bf16_t* kb = proj + tok0 * NP + C_IK + 8 * hi + (size_t)r * NP;
        bf16x8 bf[4], bn[4];
        int jt = wid;
        if (jt < nt32) {
#pragma unroll
            for (int ks = 0; ks < 4; ++ks) bf[ks] = *(const bf16x8*)(kb + (size_t)(32 * jt) * NP + 16 * ks);
        }
        for (; jt < nt32; jt += 8) {
            const int key0 = 32 * jt;
            if (jt + 8 < nt32) {
#pragma unroll
                for (int ks = 0; ks < 4; ++ks) bn[ks] = *(const bf16x8*)(kb + (size_t)(32 * (jt + 8)) * NP + 16 * ks);
            }
#pragma unroll
            for (int T = 0; T < 4; ++T) {
                f32x16 acc = {};
#pragma unroll
                for (int ks = 0; ks < 4; ++ks) acc = __builtin_amdgcn_mfma_f32_32x32x16_bf16(af[T][ks], bf[ks], acc, 0, 0, 0);
                float sv = 0.f;
#pragma unroll
                for (int rr = 0; rr < 16; ++rr) sv = fmaf(wv[T][rr], fmaxf(acc[rr], 0.f), sv);
                const int q = 2 * T + hi, key = key0 + r;
                sc[q * SEQ + key] = (key <= t0 + q) ? fkey(sv) : 0u;
            }
#pragma unroll
            for (int ks = 0; ks < 4; ++ks) bf[ks] = bn[ks];
        }
    }
    __syncthreads();
    const int t = t0 + wid, N = t + 1, NE = (N + 63) >> 6;
    const ILAS unsigned* myrow = sc + wid * SEQ + lane;
    unsigned long long myw = 0ull;
    if (N <= TOPK) {
        for (int e = 0; e < NE; ++e) { const unsigned long long bm = __ballot(64 * e + lane <= t); if (lane == e) myw = bm; }
    } else {
        ILAS unsigned* hist = (ILAS unsigned*)(lds + L_HIST) + wid * 256;
        unsigned pref = 0u; int krem = TOPK;
        for (int pass = 0; pass < 4; ++pass) {
            const int shift = 24 - 8 * pass;
            *(ILAS u32x4*)(hist + 4 * lane) = (u32x4){0u, 0u, 0u, 0u};
            asm volatile("s_waitcnt lgkmcnt(0)" ::: "memory");
#pragma unroll 4
            for (int e = 0; e < NE; ++e) { const unsigned k = myrow[64 * e];
                const bool mt = (pass == 0) ? true : ((k >> ((shift + 8) & 31)) == pref);
                if (mt) __hip_atomic_fetch_add(hist + ((k >> shift) & 255u), 1u, __ATOMIC_RELAXED, __HIP_MEMORY_SCOPE_WORKGROUP); }
            asm volatile("s_waitcnt lgkmcnt(0)" ::: "memory");
            const u32x4 c4 = *(const ILAS u32x4*)(hist + 4 * lane);
            const unsigned s4 = (c4.x + c4.y) + (c4.z + c4.w);
            unsigned sl = s4;
#pragma unroll
            for (int off = 1; off < 64; off <<= 1) { const unsigned tt = __shfl_down(sl, off); if (lane + off < 64) sl += tt; }
            const unsigned long long bal = __ballot(sl >= (unsigned)krem);
            const int ls = 63 - __clzll((long long)bal);
            const unsigned above = (unsigned)__builtin_amdgcn_readlane((int)sl, ls) - (unsigned)__builtin_amdgcn_readlane((int)s4, ls);
            const unsigned cx = (unsigned)__builtin_amdgcn_readlane((int)c4.x, ls), cy = (unsigned)__builtin_amdgcn_readlane((int)c4.y, ls);
            const unsigned cz = (unsigned)__builtin_amdgcn_readlane((int)c4.z, ls), cw = (unsigned)__builtin_amdgcn_readlane((int)c4.w, ls);
            unsigned ab = above; int d;
            if (ab + cw >= (unsigned)krem) d = 3; else { ab += cw;
                if (ab + cz >= (unsigned)krem) d = 2; else { ab += cz;
                    if (ab + cy >= (unsigned)krem) d = 1; else { ab += cy; d = 0; } } }
            pref = (pref << 8) | (unsigned)(4 * ls + d); krem -= (int)ab;
        }
        int rleft = krem;
        for (int e = 0; e < NE; ++e) { const unsigned k = myrow[64 * e];
            const unsigned long long gt = __ballot(k > pref); unsigned long long em = __ballot(k == pref), take = 0ull;
            if (em != 0ull) { const int cnt = __popcll(em);
                if (cnt <= rleft) { take = em; rleft -= cnt; }
                else { while (rleft > 0) { const unsigned long long bb = em & (~em + 1ull); take |= bb; em ^= bb; --rleft; } } }
            const unsigned long long bm = gt | take;
            if (lane == e) myw = bm;
        }
    }
    mask[(tok0 + t) * 64 + lane] = myw;
    asm volatile("s_waitcnt lgkmcnt(0)" ::: "memory");
    __syncthreads();
}
}

#define LAS __attribute__((address_space(3)))
#define RLX_AGENT __ATOMIC_RELAXED, __HIP_MEMORY_SCOPE_AGENT
#define XB_TMO      128
#define XB_XCNT(j)  (256  + 64 * (j))
#define XB_XSUB(j)  (1280 + 64 * (j))
#define XB_XGEN(j)  (2304 + 64 * (j))
#define XB_TOP      3328
#define XB_TOPGEN   3392
#define XCD_BAR_WORDS 3456
#define XB_SPIN_CAP (1u << 18)

__device__ __forceinline__ unsigned xb_ld(unsigned* p)              { return __hip_atomic_load(p, __ATOMIC_RELAXED, __HIP_MEMORY_SCOPE_AGENT); }
__device__ __forceinline__ unsigned xb_add(unsigned* p, unsigned v) { return __hip_atomic_fetch_add(p, v, __ATOMIC_RELAXED, __HIP_MEMORY_SCOPE_AGENT); }
__device__ __forceinline__ unsigned xb_xcc_id() { return (unsigned)__builtin_amdgcn_s_getreg((3 << 11) | 20) & 0xFu; }
#define XB_SPIN(cond, bar) do { unsigned _sp = 0; while (cond) { __builtin_amdgcn_s_sleep(1); \
    if ((++_sp & 255u) == 0u) { if (xb_ld(&(bar)[XB_TMO])) break; if (_sp > XB_SPIN_CAP) { atomicAdd(&(bar)[XB_TMO], 1u); break; } } } } while (0)

struct XcdBarrier {
    unsigned* bar; unsigned x;
    volatile LAS unsigned* st;
};

__device__ __forceinline__ XcdBarrier xcd_barrier_post(unsigned* bar, volatile LAS unsigned* st) {
    XcdBarrier b; b.bar = bar; b.x = xb_xcc_id(); b.st = st;
    if (threadIdx.x == 0) (void)xb_add(&bar[XB_XCNT(b.x)], 1u);
    return b;
}
__device__ __forceinline__ void xcd_barrier_complete(unsigned* bar, unsigned x, unsigned& nloc, unsigned& nx) {
    const unsigned G = gridDim.x * gridDim.y * gridDim.z;
    unsigned sum, cnt, mine, sp = 0u;
    for (;;) {
        sum = 0u; cnt = 0u; mine = 0u;
#pragma unroll
        for (unsigned j = 0; j < 16; ++j) { const unsigned c = xb_ld(&bar[XB_XCNT(j)]); sum += c; cnt += (c > 0u) ? 1u : 0u; mine = (j == x) ? c : mine; }
        if (sum == G) break;
        __builtin_amdgcn_s_sleep(1);
        if ((++sp & 255u) == 0u) { if (xb_ld(&bar[XB_TMO])) break; if (sp > XB_SPIN_CAP) { atomicAdd(&bar[XB_TMO], 1u); break; } }
    }
    nloc = mine > 0u ? mine : 1u; nx = cnt > 0u ? cnt : 1u;
}

__device__ __forceinline__ void xcd_barrier(const XcdBarrier& b) {
    asm volatile("s_waitcnt vmcnt(0)" ::: "memory");
    __syncthreads();
    if (threadIdx.x == 0) {
        unsigned* bar = b.bar;
        __builtin_amdgcn_s_waitcnt(0);
        unsigned nloc = b.st[0], nx = b.st[1];
        if (nloc == 0u) { xcd_barrier_complete(bar, b.x, nloc, nx); b.st[0] = nloc; b.st[1] = nx; }
        const unsigned old = xb_add(&bar[XB_XSUB(b.x)], 1u);
        const unsigned gen = old / nloc;
        if (old + 1u == (gen + 1u) * nloc) {
            __builtin_amdgcn_fence(__ATOMIC_RELEASE, "agent");
            asm volatile("s_waitcnt vmcnt(0)" ::: "memory");
            const unsigned og = xb_add(&bar[XB_TOP], 1u);
            const unsigned tg = og / nx;
            if (og + 1u == (tg + 1u) * nx) xb_add(&bar[XB_TOPGEN], 1u);
            else XB_SPIN(xb_ld(&bar[XB_TOPGEN]) == tg, bar);
            __builtin_amdgcn_fence(__ATOMIC_ACQUIRE, "agent");
            xb_add(&bar[XB_XGEN(b.x)], 1u);
            asm volatile("s_waitcnt vmcnt(0)" ::: "memory");
        } else {
            XB_SPIN(xb_ld(&bar[XB_XGEN(b.x)]) == gen, bar);
            __builtin_amdgcn_fence(__ATOMIC_ACQUIRE, "agent");
            asm volatile("s_waitcnt vmcnt(0)" ::: "memory");
        }
    }
    __syncthreads();
}

#define GAS __attribute__((address_space(1)))
#define LDS_WAIT() asm volatile("s_waitcnt lgkmcnt(0)" ::: "memory")
constexpr int NWAVES = 8, LDS_BYTES = 147456;
struct Args { const float* x; const int* pos; const float* norm_g; const float* w_in; const float* sb_g; const float* dsa_g; const float* w_out; const float* final_g; float* out; unsigned char* ws; int ph_lo, ph_hi; };

__device__ __forceinline__ void transpose_item(const float* __restrict__ W, int K, int N, int NPAD, bf16_t* __restrict__ WT, LAS float* scr, int item, int lane) {
    const int nblk = NPAD / 32, kb = item / nblk, nb = item % nblk, k0 = 64 * kb, n0 = 32 * nb;
    const int n = n0 + (lane & 31); const bool ok = n < N;
#pragma unroll 8
    for (int i = 0; i < 32; ++i) { const int kk = 2 * i + (lane >> 5); scr[kk * 33 + (lane & 31)] = ok ? W[(size_t)(k0 + kk) * N + n] : 0.f; }
    LDS_WAIT();
    const int c = lane & 7;
#pragma unroll
    for (int j = 0; j < 4; ++j) { const int nn = (lane >> 3) + 8 * j; const LAS float* s = scr + (8 * c) * 33 + nn;
        u32x4 o; o.x = pk2(s[0 * 33], s[1 * 33]); o.y = pk2(s[2 * 33], s[3 * 33]); o.z = pk2(s[4 * 33], s[5 * 33]); o.w = pk2(s[6 * 33], s[7 * 33]);
        *(u32x4*)(WT + (size_t)(n0 + nn) * K + k0 + 8 * c) = o; }
    LDS_WAIT();
}
__device__ __forceinline__ void rmsnorm_row_bf16(const float* __restrict__ xrow, const float* __restrict__ g, bf16_t* __restrict__ orow, int lane) {
    const f32x4* xr = (const f32x4*)xrow + lane;
    f32x4 v[8]; float s = 0.f;
#pragma unroll
    for (int j = 0; j < 8; ++j) { v[j] = xr[64 * j]; s += (v[j].x * v[j].x + v[j].y * v[j].y) + (v[j].z * v[j].z + v[j].w * v[j].w); }
    const float r = 1.0f / sqrtf(wave_sum(s) * (1.0f / DM) + EPS);
    const f32x4* gr = (const f32x4*)g + lane;
    u32x2* o = (u32x2*)orow + lane;
#pragma unroll
    for (int j = 0; j < 8; ++j) { const f32x4 gg = gr[64 * j]; u32x2 w; w.x = pk2(v[j].x * r * gg.x, v[j].y * r * gg.y); w.y = pk2(v[j].z * r * gg.z, v[j].w * r * gg.w); o[64 * j] = w; }
}

__global__ void __launch_bounds__(NWAVES * 64, 2) mega(Args a) {
    extern __shared__ __attribute__((aligned(16))) unsigned char lds_raw[];
    LAS unsigned char* lds = (LAS unsigned char*)lds_raw;
    const int tid = threadIdx.x, lane = tid & 63, wave = __builtin_amdgcn_readfirstlane(tid >> 6);
    const int G = gridDim.x, bx = blockIdx.x;
    unsigned char* ws = a.ws;
    bf16_t* HN = (bf16_t*)(ws + WS_HN); bf16_t* WT1 = (bf16_t*)(ws + WS_WT1); bf16_t* WT2 = (bf16_t*)(ws + WS_WT2);
    float* IW = (float*)(ws + WS_IW); float* R128 = (float*)(ws + WS_R128); float* R64 = (float*)(ws + WS_R64); bf16_t* PROJ = (bf16_t*)(ws + WS_PROJ);
    bf16_t* MIXED = (bf16_t*)(ws + WS_MIXED); float* SSP = (float*)(ws + WS_SSP); unsigned long long* MASKW = (unsigned long long*)(ws + WS_MASK); const unsigned long long* MASK = MASKW;
    const int lo = a.ph_lo, hi = a.ph_hi;
#define IN(k) (lo <= (k) && (k) < hi)
    if (tid < 2) ((volatile LAS unsigned*)(lds + LDS_BYTES - 64))[tid] = 0u;
    __syncthreads();
    const XcdBarrier xbar = xcd_barrier_post((unsigned*)(ws + WS_CTL) + 4096, (volatile LAS unsigned*)(lds + LDS_BYTES - 64));
#define SEAM(k) do { if (IN(k) && IN((k) + 1)) { if ((k) == 0) cooperative_groups::this_grid().sync(); else xcd_barrier(xbar); } } while (0)
    if (IN(0)) {
        const int gw = bx * NWAVES + wave, NGW = G * NWAVES;
        LAS float* scr = (LAS float*)(lds + wave * 16384);
        constexpr int I1 = (DM / 64) * (NP / 32), I2 = (DM / 64) * (DM / 32);
        for (int it = gw; it < I1 + I2; it += NGW) {
            if (it < I1) transpose_item(a.w_in, DM, D_IN, NP, WT1, scr, it, lane);
            else transpose_item(a.w_out, DM, DM, DM, WT2, scr, it - I1, lane);
        }
        for (int m = gw; m < NTOK; m += NGW) rmsnorm_row_bf16(a.x + (size_t)m * DM, a.norm_g, HN + (size_t)m * DM, lane);
        for (int i = bx * (NWAVES * 64) + tid; i < NTOK * 24; i += G * NWAVES * 64) {
            const int tok = i / 24, j = i % 24;
            const double p = (double)a.pos[tok];
            const double l2t = 18.931568569324174;
            if (j < 16) { const double inv = exp2(-(double)j / 16.0 * l2t); const double ang = p * (double)(float)inv; R128[tok * 32 + j] = (float)cos(ang); R128[tok * 32 + 16 + j] = (float)sin(ang); }
            else { const int jj = j - 16; const double inv = exp2(-(double)jj / 8.0 * l2t); const double ang = p * (double)(float)inv; R64[tok * 16 + jj] = (float)cos(ang); R64[tok * 16 + 8 + jj] = (float)sin(ang); }
        }
    }
    SEAM(0);
    if (IN(1)) {
        pg8::Gemm g{HN, WT1, NTOK, NP, DM}; pg8::StaticOrder S; S.init(NTOK, NP, G, bx);
        pg8::EpiProj E{PROJ, IW, R128, R64};
        pg8::gemm_phase<pg8::EpiProj, pg8::StaticOrder, true, true>(lds, g, S, E);
    }
    SEAM(1);
    if (IN(2)) {
        const int vcu = (G % 8 == 0) ? (bx % 8) * (G / 8) + bx / 8 : bx;
        for (int k = 0;; ++k) {
            const int sI = k * G + ((k & 1) ? (G - 1 - vcu) : vcu);
            if (sI >= NTOK / 8) break;
            idx::index_unit(lds, PROJ, IW, MASKW, sI & 3, 8 * (511 - (sI >> 2)));
        }
    }
    SEAM(2);
    if (IN(3)) {
        const int vcu = (G % 8 == 0) ? (bx % 8) * (G / 8) + bx / 8 : bx;
        for (int p = vcu; p < BATCH * SBH * 8; p += G) {
            const int bh = p >> 3, sI = p & 7, b = bh / SBH, h = bh % SBH;
            for (int k = 0; k < 2; ++k) att::sb_unit<true>(lds, PROJ, a.sb_g, MIXED, b, h, k == 0 ? 15 - sI : sI);
        }
    }
    if (IN(3)) {
        const int vcu = (G % 8 == 0) ? (bx % 8) * (G / 8) + bx / 8 : bx;
        for (int p = vcu; p < BATCH * DSH * 8; p += G) {
            const int bh = p >> 3, sI = p & 7, b = bh / DSH, h = bh % DSH;
            for (int k = 0; k < 2; ++k) att::dsa_unit(lds, PROJ, MASK, a.dsa_g, MIXED, b, h, k == 0 ? 15 - sI : sI);
        }
    }
    SEAM(3);
    if (IN(4)) {
        pg8::Gemm g{MIXED, WT2, NTOK, DM, DM}; pg8::StaticOrder S; S.init(NTOK, DM, G, bx);
        pg8::EpiOut E{a.x, a.out, SSP};
        pg8::gemm_phase<pg8::EpiOut, pg8::StaticOrder, true, true>(lds, g, S, E);
    }
    SEAM(4);
    if (IN(5)) {
        const int gw = bx * NWAVES + wave, NGW = G * NWAVES;
        for (int m = gw; m < NTOK; m += NGW) {
            const float sp = (lane < 32) ? SSP[(size_t)m * 32 + lane] : 0.f;
            const float r = 1.0f / sqrtf(wave_sum(sp) * (1.0f / DM) + EPS);
            f32x4* yr = (f32x4*)(a.out + (size_t)m * DM) + lane; const f32x4* gr = (const f32x4*)a.final_g + lane;
#pragma unroll
            for (int j = 0; j < 8; ++j) { const f32x4 v = yr[64 * j], gg = gr[64 * j]; yr[64 * j] = (f32x4){v.x * r * gg.x, v.y * r * gg.y, v.z * r * gg.z, v.w * r * gg.w}; }
        }
    }
#undef IN
#undef SEAM
}

extern "C" void kernel_launch(void* const* d_in, const int* in_sizes, int n_in, void* d_out, int out_size, void* d_ws, size_t ws_size, hipStream_t stream) {
    static int grid = 0;
    if (grid == 0) {
        if (n_in != 8 || in_sizes[0] != NTOK * DM || out_size != NTOK * DM || ws_size < WS_END) {
            fprintf(stderr, "kernel_launch: shape mismatch n_in %d in0 %d out %d ws %zu (need %zu)\n", n_in, n_in > 0 ? in_sizes[0] : -1, out_size, ws_size, (size_t)WS_END); grid = -1; return; }
        int dev = 0, cus = 0;
        if (hipGetDevice(&dev) != hipSuccess || hipDeviceGetAttribute(&cus, hipDeviceAttributeMultiprocessorCount, dev) != hipSuccess) { grid = -1; return; }
        if (hipFuncSetAttribute((const void*)mega, hipFuncAttributeMaxDynamicSharedMemorySize, LDS_BYTES) != hipSuccess) { fprintf(stderr, "kernel_launch: hipFuncSetAttribute failed\n"); grid = -1; return; }
        int per_cu = 0;
        if (hipOccupancyMaxActiveBlocksPerMultiprocessor(&per_cu, (const void*)mega, NWAVES * 64, LDS_BYTES) != hipSuccess || per_cu < 1) { fprintf(stderr, "kernel_launch: occupancy query says %d blocks per CU\n", per_cu); grid = -1; return; }
        grid = cus;
    }
    if (grid < 0) return;
    const float* x = (const float*)d_in[0]; const float* sb_g = (const float*)d_in[4]; const float* dsa_g = (const float*)d_in[5]; const float* final_g = (const float*)d_in[7];
    unsigned char* ws = (unsigned char*)d_ws; float* out = (float*)d_out;
    bf16_t* MIXED = (bf16_t*)(ws + WS_MIXED); bf16_t* WT2 = (bf16_t*)(ws + WS_WT2);
    float* IW = (float*)(ws + WS_IW);
    unsigned long long* MASK = (unsigned long long*)(ws + WS_MASK); bf16_t* PROJ = (bf16_t*)(ws + WS_PROJ);
    hipMemsetAsync(ws + WS_CTL, 0, 1 * MiB, stream);
    Args a{};
    a.x = x; a.pos = (const int*)d_in[1]; a.norm_g = (const float*)d_in[2]; a.w_in = (const float*)d_in[3]; a.sb_g = sb_g; a.dsa_g = dsa_g; a.w_out = (const float*)d_in[6]; a.final_g = final_g;
    a.out = out; a.ws = ws;
    a.ph_lo = 0; a.ph_hi = 6;
    void* kargs[] = {(void*)&a};
    const hipError_t le = hipLaunchCooperativeKernel((const void*)mega, dim3(grid), dim3(NWAVES * 64), kargs, LDS_BYTES, stream);
    if (le != hipSuccess) fprintf(stderr, "kernel_launch: cooperative launch failed: %s (grid %d)\n", hipGetErrorString(le), grid);
}
```

```cpp
#include <hip/hip_runtime.h>
#include <cstdio>
#include <cstdint>
#include <hip/hip_cooperative_groups.h>

constexpr int BATCH = 4, SEQ = 4096, DM = 2048, NTOK = BATCH * SEQ;
constexpr int HD = 128, SBH = 8, DSH = 8, DKV = 2, IH = 16, ID = 64, TOPK = 256;
constexpr int D_IN = 7760, NP = 7936;
constexpr size_t PHS = (size_t)NTOK * 128;
constexpr size_t IKC_OFF = 60 * PHS;
constexpr int C_SBQ = 0, C_SBK = 1024, C_SBV = 2048, C_SBG = 3072, C_DQ = 4096, C_DK = 5120, C_DV = 5376, C_DG = 5632, C_IQ = 6656, C_IK = 7680, C_IW = 7744;
constexpr float EPS = 1e-6f;
constexpr float C2 = 0.08838834764831845f * 1.4426950408889634f;
constexpr float IWS = 1.0f / 32.0f;

constexpr size_t MiB = 1u << 20;
constexpr size_t WS_CTL = 0;
constexpr size_t WS_HN = 1 * MiB;
constexpr size_t WS_MIXED = WS_HN;
constexpr size_t WS_WT1 = 65 * MiB;
constexpr size_t WS_WT2 = 96 * MiB;
constexpr size_t WS_IW = 104 * MiB;
constexpr size_t WS_R128 = 105 * MiB;
constexpr size_t WS_R64 = 107 * MiB;
constexpr size_t WS_MASK = 108 * MiB;
constexpr size_t WS_PROJ = 116 * MiB;
constexpr size_t WS_SSP = 366 * MiB;
constexpr size_t WS_END = 368 * MiB;

constexpr int PROBE_REP = -1;
#define REPS(k) ((PROBE_REP == (k)) ? 2 : 1)
#define WAVE_SYNC() asm volatile("s_waitcnt lgkmcnt(0)" ::: "memory")
typedef unsigned short bf16_t;
typedef float f32x4 __attribute__((ext_vector_type(4)));
typedef unsigned u32x4 __attribute__((ext_vector_type(4)));
typedef unsigned u32x2 __attribute__((ext_vector_type(2)));

__device__ __forceinline__ unsigned f2bf(float f) { unsigned u = __builtin_bit_cast(unsigned, f); return (u + 0x7fffu + ((u >> 16) & 1u)) >> 16; }
__device__ __forceinline__ float bf2f(unsigned h) { return __builtin_bit_cast(float, h << 16); }
__device__ __forceinline__ unsigned pk2(float lo, float hi) { return f2bf(lo) | (f2bf(hi) << 16); }
__device__ __forceinline__ float wave_sum(float v) {
#pragma unroll
    for (int o = 1; o < 64; o <<= 1) v += __shfl_xor(v, o);
    return v;
}
__device__ __forceinline__ float wave_max(float v) {
#pragma unroll
    for (int o = 1; o < 64; o <<= 1) v = fmaxf(v, __shfl_xor(v, o));
    return v;
}
__device__ __forceinline__ unsigned fkey(float f) { unsigned u = __builtin_bit_cast(unsigned, f); return (u & 0x80000000u) ? ~u : (u | 0x80000000u); }

namespace pg8 {
#define PG8_LAS __attribute__((address_space(3)))
typedef unsigned short bf16_t;
typedef short bf16x8 __attribute__((ext_vector_type(8)));
typedef float f32x4 __attribute__((ext_vector_type(4)));
typedef unsigned u32x4 __attribute__((ext_vector_type(4)));
constexpr int BM = 256, BK = 64, HALF = 128, HTB = HALF * BK * 2  , STAGE_BYTES = 8 * HTB, NXCD = 8, WGM = 8;

__host__ __device__ __forceinline__ int lds_byte(int r, int c) { const int st = (r >> 4) * 2 + (c >> 5), rr = r & 15, cc = c & 31, ob = rr * 64 + cc * 2; return st * 1024 + (ob ^ (((ob >> 9) & 1) << 5)); }
__host__ __device__ __forceinline__ void stage_rc(int b, int& R, int& C) { const int st = b / 1024, sb = b % 1024, swz = sb ^ (((sb >> 9) & 1) << 5); R = (st >> 1) * 16 + swz / 64; C = (st & 1) * 32 + (swz % 64) / 2; }
__host__ __device__ __forceinline__ int perm32(int rho) { const int n = rho >> 4, i = rho & 15; return 8 * (i >> 2) + 4 * n + (i & 3); }

struct Unit { int pm, pn; };
struct Gemm { const bf16_t* A; const bf16_t* Bt; int M, N, K; };

struct StaticOrder {
    int nM, nN, nwg, G, c;
    __host__ __device__ void init(int M, int N, int G_, int c_) { nM = M / BM; nN = N / BM; nwg = nM * nN; G = G_; c = c_; }
    __host__ __device__ bool next(int i, Unit& u) const {
        const long L = (long)i * G + c; if (L >= nwg) return false;
        int wgid = (int)L; { const int q = nwg / NXCD, r = nwg % NXCD, xcd = wgid % NXCD, off = wgid / NXCD; wgid = (xcd < r ? xcd * (q + 1) : r * (q + 1) + (xcd - r) * q) + off; }
        const int nig = WGM * nN, gid = wgid / nig, fm = gid * WGM, gsz = (nM - fm) < WGM ? (nM - fm) : WGM;
        u.pm = fm + ((wgid % nig) % gsz); u.pn = (wgid % nig) / gsz; return true;
    }
    __device__ __forceinline__ void a_ready(const Unit&) const {}
    __device__ __forceinline__ void done(const Unit&) const {}
};
}

namespace pg8 {
__device__ __forceinline__ unsigned cvt_pk_bf16(float lo, float hi) { unsigned r; asm volatile("v_cvt_pk_bf16_f32 %0, %1, %2" : "=v"(r) : "v"(lo), "v"(hi)); return r; }
struct EpiProj {
    static constexpr bool PERM = true, AFTER_DRAIN = false;
    bf16_t* proj; float* iw; const float* r128; const float* r64;
    __device__ __forceinline__ void operator()(const f32x4 (&acc)[2][2][4][2], const Unit& u, int wr, int wc, int fr, int fq) const {
        const int pn = u.pn;
        const int row0 = u.pm * BM + wr * 64 + fr, col0 = pn * BM + wc * 32 + 8 * fq;
        const bool rope128 = (pn >= 16 && pn <= 20) && wc == 0;
        const bool rope64 = ((pn >= 26 && pn <= 29) && (wc & 1) == 0) || (pn == 30 && wc == 0);
        const bool iwt = (pn == 30 && wc == 2);
        const float sc = (pn < 4 || (pn >= 16 && pn < 20)) ? C2 : 1.f;
#pragma unroll
        for (int ai = 0; ai < 2; ++ai)
#pragma unroll
            for (int m = 0; m < 4; ++m) {
                const int row = row0 + ai * HALF + m * 16;
                f32x4 cs0 = {1.f, 1.f, 1.f, 1.f}, cs1 = cs0, sn0 = {0.f, 0.f, 0.f, 0.f}, sn1 = sn0;
                if (rope128) { const float* t = r128 + (size_t)row * 32 + 8 * (fq & 1); cs0 = *(const f32x4*)t; cs1 = *(const f32x4*)(t + 4); sn0 = *(const f32x4*)(t + 16); sn1 = *(const f32x4*)(t + 20);
                    if (fq < 2) { sn0 = -sn0; sn1 = -sn1; } }
                if (rope64) { const float* t = r64 + (size_t)row * 16; cs0 = *(const f32x4*)t; cs1 = *(const f32x4*)(t + 4); sn0 = *(const f32x4*)(t + 8); sn1 = *(const f32x4*)(t + 12);
                    if (fq == 0) { sn0 = -sn0; sn1 = -sn1; } if (fq >= 2) { cs0 = (f32x4){1.f, 1.f, 1.f, 1.f}; cs1 = cs0; sn0 = (f32x4){0.f, 0.f, 0.f, 0.f}; sn1 = sn0; } }
                bf16_t* rowp = (pn < 30) ? proj + (size_t)(2 * pn) * PHS + (size_t)row * 128 + wc * 32 + 8 * fq : proj + IKC_OFF + (size_t)row * 64 + wc * 32 + 8 * fq;
#pragma unroll
                for (int bj = 0; bj < 2; ++bj) {
                    f32x4 v0 = acc[ai][bj][m][0] * sc, v1 = acc[ai][bj][m][1] * sc;
                    if (rope128 || (rope64 && (pn != 30 || bj == 0))) {
                        const int xm = rope128 ? 32 : 16;
                        f32x4 p0, p1;
#pragma unroll
                        for (int e = 0; e < 4; ++e) { p0[e] = __shfl_xor(v0[e], xm); p1[e] = __shfl_xor(v1[e], xm); }
                        v0 = v0 * cs0 + p0 * sn0; v1 = v1 * cs1 + p1 * sn1;
                    }
                    if (iwt && bj == 0 && fq < 2) { float* ip = iw + (size_t)row * 16 + 8 * fq; *(f32x4*)ip = v0 * IWS; *(f32x4*)(ip + 4) = v1 * IWS; }
                    u32x4 w; w.x = cvt_pk_bf16(v0[0], v0[1]); w.y = cvt_pk_bf16(v0[2], v0[3]); w.z = cvt_pk_bf16(v1[0], v1[1]); w.w = cvt_pk_bf16(v1[2], v1[3]);
                    if (pn < 30) *(u32x4*)(rowp + (size_t)bj * PHS) = w; else if (bj == 0 && wc < 2) *(u32x4*)rowp = w;
                }
            }
    }
};
}

namespace pg8 {
struct EpiOut {
    static constexpr bool PERM = true, AFTER_DRAIN = false;
    const float* x; bf16_t* yb; float* ssp;
    __device__ __forceinline__ void operator()(const f32x4 (&acc)[2][2][4][2], const Unit& u, int wr, int wc, int fr, int fq) const {
        const int row0 = u.pm * BM + wr * 64 + fr, col0 = u.pn * BM + wc * 32 + 8 * fq;
#pragma unroll
        for (int ai = 0; ai < 2; ++ai)
#pragma unroll
            for (int m = 0; m < 4; ++m) {
                const int row = row0 + ai * HALF + m * 16; const size_t off = (size_t)row * DM + col0; float s = 0.f;
#pragma unroll
                for (int bj = 0; bj < 2; ++bj) {
                    const f32x4 y0 = *(const f32x4*)(x + off + bj * HALF) + acc[ai][bj][m][0], y1 = *(const f32x4*)(x + off + bj * HALF + 4) + acc[ai][bj][m][1];
                    u32x4 w; w.x = cvt_pk_bf16(y0[0], y0[1]); w.y = cvt_pk_bf16(y0[2], y0[3]); w.z = cvt_pk_bf16(y1[0], y1[1]); w.w = cvt_pk_bf16(y1[2], y1[3]);
                    *(u32x4*)(yb + off + bj * HALF) = w;
                    s += (y0[0] * y0[0] + y0[1] * y0[1]) + (y0[2] * y0[2] + y0[3] * y0[3]) + (y1[0] * y1[0] + y1[1] * y1[1]) + (y1[2] * y1[2] + y1[3] * y1[3]);
                }
                s += __shfl_xor(s, 16); s += __shfl_xor(s, 32);
                if (fq == 0) ssp[(size_t)row * 32 + u.pn * 4 + wc] = s;
            }
    }
};
}
namespace pg8 {
template <class Epi, class Sched, bool ALIGN_EPI = false, bool SP2 = false>
__device__ __forceinline__ void gemm_phase(PG8_LAS unsigned char* lds, const Gemm g, const Sched& S, const Epi& E) {
    int tid_ = threadIdx.x; asm volatile("" : "+v"(tid_)); const int tid = tid_, wid = __builtin_amdgcn_readfirstlane(tid >> 6), lane = tid & 63, wr = wid >> 2, wc = wid & 3, fr = lane & 15, fq = lane >> 4;
    const int K = g.K, nt = K / BK;
    unsigned voffA[2], voffB[2];
#pragma unroll
    for (int i = 0; i < 2; ++i) { int R, C; stage_rc(tid * 16 + i * 8192, R, C); const int Rb = Epi::PERM ? ((R & ~31) + perm32(R & 31)) : R;
        voffA[i] = (unsigned)(R * K + C) * 2u; voffB[i] = (unsigned)(Rb * K + C) * 2u; }
    const size_t kstep = (size_t)(BK * 2);
    const size_t hstep = (size_t)HALF * K * 2;
    const size_t tstep = 2 * hstep;
    const unsigned ldsw = (unsigned)wid * 1024u;
    const int aoff = lds_byte(wr * 64 + fr, fq * 8), boff = lds_byte(wc * 32 + fr, fq * 8);
#define PG8_SA(b, h) (((b) * 2 + (h)) * HTB)
#define PG8_SB(b, h) ((4 + (b) * 2 + (h)) * HTB)
#define PG8_STAGE(bufoff, gbase, voff) do { _Pragma("unroll") for (int _i = 0; _i < 2; ++_i) \
        __builtin_amdgcn_global_load_lds((const unsigned*)((const char*)(gbase) + (voff)[_i]), (PG8_LAS unsigned*)(lds + (bufoff) + ldsw + _i * 8192), 16, 0, 0); } while (0)
#define PG8_LDA(dst, b, h) do { _Pragma("unroll") for (int m = 0; m < 4; ++m) _Pragma("unroll") for (int k = 0; k < 2; ++k) dst[m][k] = *(const PG8_LAS bf16x8*)(lds + PG8_SA(b, h) + aoff + m * 2048 + k * 1024); } while (0)
#define PG8_LDB(dst, b, h) do { _Pragma("unroll") for (int n = 0; n < 2; ++n) _Pragma("unroll") for (int k = 0; k < 2; ++k) dst[n][k] = *(const PG8_LAS bf16x8*)(lds + PG8_SB(b, h) + boff + n * 2048 + k * 1024); } while (0)
#define PG8_MMA(ai, bj, At, Bt) do { __builtin_amdgcn_s_setprio(1); _Pragma("unroll") for (int m = 0; m < 4; ++m) _Pragma("unroll") for (int n = 0; n < 2; ++n) _Pragma("unroll") for (int k = 0; k < 2; ++k) \
        acc[ai][bj][m][n] = __builtin_amdgcn_mfma_f32_16x16x32_bf16(Bt[n][k], At[m][k], acc[ai][bj][m][n], 0, 0, 0); __builtin_amdgcn_s_setprio(0); } while (0)
#define PG8_WAIT_V(n) asm volatile("s_waitcnt vmcnt(" #n ")" ::: "memory")
#define PG8_WAIT_L(n) asm volatile("s_waitcnt lgkmcnt(" #n ")" ::: "memory")
#define PG8_BAR __builtin_amdgcn_s_barrier()
#define PG8_SCHED __builtin_amdgcn_sched_barrier(0)
    Unit cur, nxt; int ui = 0;
    if (!S.next(0, cur)) return;
    f32x4 acc[2][2][4][2];
#pragma unroll
    for (int a = 0; a < 2; ++a)
#pragma unroll
        for (int b = 0; b < 2; ++b)
#pragma unroll
            for (int m = 0; m < 4; ++m)
#pragma unroll
                for (int n = 0; n < 2; ++n) acc[a][b][m][n] = (f32x4){0.f, 0.f, 0.f, 0.f};
    bf16x8 At[4][2], B0[2][2], B1[2][2];
    const char* cA = (const char*)g.A + (size_t)cur.pm * tstep; const char* cB = (const char*)g.Bt + (size_t)cur.pn * tstep;
    S.a_ready(cur);
    if constexpr (SP2) {
        PG8_STAGE(PG8_SB(0, 0), cB, voffB); PG8_STAGE(PG8_SB(0, 1), cB + hstep, voffB); PG8_STAGE(PG8_SA(0, 0), cA, voffA); PG8_STAGE(PG8_SA(0, 1), cA + hstep, voffA);
        if (wr == 1) PG8_BAR;
        PG8_WAIT_V(2); PG8_BAR;
        PG8_STAGE(PG8_SB(1, 0), cB + kstep, voffB); PG8_STAGE(PG8_SA(1, 0), cA + kstep, voffA); PG8_STAGE(PG8_SB(1, 1), cB + hstep + kstep, voffB);
        PG8_WAIT_V(6); PG8_BAR;
    } else {
        PG8_STAGE(PG8_SB(0, 0), cB, voffB); PG8_STAGE(PG8_SA(0, 0), cA, voffA); PG8_STAGE(PG8_SB(0, 1), cB + hstep, voffB); PG8_STAGE(PG8_SA(0, 1), cA + hstep, voffA);
        if (wr == 1) PG8_BAR;
        PG8_WAIT_V(4); PG8_BAR;
        PG8_STAGE(PG8_SB(1, 0), cB + kstep, voffB); PG8_STAGE(PG8_SA(1, 0), cA + kstep, voffA); PG8_STAGE(PG8_SB(1, 1), cB + hstep + kstep, voffB);
        PG8_WAIT_V(6); PG8_BAR;
    }
    for (;;) {
        const bool has_next = S.next(ui + 1, nxt);
        const char* nA = has_next ? (const char*)g.A + (size_t)nxt.pm * tstep : cA; const char* nB = has_next ? (const char*)g.Bt + (size_t)nxt.pn * tstep : cB;
        for (int t = 0; t < nt; t += 2) {
            const bool last = (t == nt - 2);
            const char* a1 = cA + (size_t)(t + 1) * kstep;
            const char* a2 = last ? nA : cA + (size_t)(t + 2) * kstep; const char* b2 = last ? nB : cB + (size_t)(t + 2) * kstep;
            const char* a3 = a2 + kstep; const char* b3 = b2 + kstep;
            if (last && has_next) S.a_ready(nxt);
            if constexpr (SP2) {
            PG8_LDB(B0, 0, 0); PG8_LDB(B1, 0, 1); PG8_SCHED; PG8_LDA(At, 0, 0); PG8_STAGE(PG8_SA(1, 1), a1 + hstep, voffA);
            PG8_WAIT_V(8); PG8_WAIT_L(0); PG8_BAR; PG8_MMA(0, 0, At, B0); PG8_MMA(0, 1, At, B1); PG8_BAR; PG8_SCHED;
            PG8_LDA(At, 0, 1); PG8_STAGE(PG8_SB(0, 0), b2, voffB); PG8_STAGE(PG8_SB(0, 1), b2 + hstep, voffB); PG8_STAGE(PG8_SA(0, 0), a2, voffA);
            PG8_WAIT_V(8); PG8_WAIT_L(0); PG8_BAR; PG8_MMA(1, 0, At, B0); PG8_MMA(1, 1, At, B1); PG8_BAR; PG8_SCHED;
            PG8_LDB(B0, 1, 0); PG8_LDB(B1, 1, 1); PG8_SCHED; PG8_LDA(At, 1, 0); PG8_STAGE(PG8_SA(0, 1), a2 + hstep, voffA);
            PG8_WAIT_V(8); PG8_WAIT_L(0); PG8_BAR; PG8_MMA(0, 0, At, B0); PG8_MMA(0, 1, At, B1); PG8_BAR; PG8_SCHED;
            PG8_LDA(At, 1, 1); PG8_STAGE(PG8_SB(1, 0), b3, voffB); PG8_STAGE(PG8_SB(1, 1), b3 + hstep, voffB); PG8_STAGE(PG8_SA(1, 0), a3, voffA);
            PG8_WAIT_V(8); PG8_WAIT_L(0); PG8_BAR; PG8_MMA(1, 0, At, B0); PG8_MMA(1, 1, At, B1); PG8_BAR; PG8_SCHED;
            } else {
            PG8_LDB(B0, 0, 0); PG8_SCHED; PG8_LDA(At, 0, 0); PG8_STAGE(PG8_SA(1, 1), a1 + hstep, voffA);
            PG8_WAIT_L(8); PG8_BAR; PG8_WAIT_L(0); PG8_MMA(0, 0, At, B0); PG8_BAR; PG8_SCHED;
            PG8_LDB(B1, 0, 1); PG8_STAGE(PG8_SB(0, 0), b2, voffB);
            PG8_BAR; PG8_WAIT_L(0); PG8_MMA(0, 1, At, B1); PG8_BAR;
            PG8_LDA(At, 0, 1); PG8_STAGE(PG8_SA(0, 0), a2, voffA);
            PG8_BAR; PG8_WAIT_L(0); PG8_MMA(1, 0, At, B0); PG8_BAR; PG8_SCHED;
            PG8_STAGE(PG8_SB(0, 1), b2 + hstep, voffB);
            PG8_WAIT_V(6); PG8_BAR; PG8_MMA(1, 1, At, B1); PG8_BAR;
            PG8_LDB(B0, 1, 0); PG8_SCHED; PG8_LDA(At, 1, 0); PG8_STAGE(PG8_SA(0, 1), a2 + hstep, voffA);
            PG8_WAIT_L(8); PG8_BAR; PG8_WAIT_L(0); PG8_MMA(0, 0, At, B0); PG8_BAR; PG8_SCHED;
            PG8_LDB(B1, 1, 1); PG8_STAGE(PG8_SB(1, 0), b3, voffB);
            PG8_BAR; PG8_WAIT_L(0); PG8_MMA(0, 1, At, B1); PG8_BAR;
            PG8_LDA(At, 1, 1); PG8_STAGE(PG8_SA(1, 0), a3, voffA);
            PG8_BAR; PG8_WAIT_L(0); PG8_MMA(1, 0, At, B0); PG8_BAR; PG8_SCHED;
            PG8_STAGE(PG8_SB(1, 1), b3 + hstep, voffB);
            PG8_WAIT_V(6); PG8_BAR; PG8_MMA(1, 1, At, B1); PG8_BAR;
            }
        }
        if constexpr (ALIGN_EPI) { if (wr == 0) PG8_BAR; }
        if constexpr (!Epi::AFTER_DRAIN) { E(acc, cur, wr, wc, fr, fq); S.done(cur); }
        if (!has_next) break;
#pragma unroll
        for (int a = 0; a < 2; ++a)
#pragma unroll
            for (int b = 0; b < 2; ++b)
#pragma unroll
                for (int m = 0; m < 4; ++m)
#pragma unroll
                    for (int n = 0; n < 2; ++n) acc[a][b][m][n] = (f32x4){0.f, 0.f, 0.f, 0.f};
        cur = nxt; cA = nA; cB = nB; ++ui;
        if constexpr (ALIGN_EPI) { if (wr == 1) PG8_BAR; }
    }
    PG8_WAIT_V(0);
    if constexpr (!ALIGN_EPI) { if (wr == 0) PG8_BAR; }
    PG8_BAR;
    if constexpr (Epi::AFTER_DRAIN) { E.fused(acc, cur, wr, wc, fr, fq, lds, wid, lane); S.done(cur); }
#undef PG8_SA
#undef PG8_SB
#undef PG8_STAGE
#undef PG8_LDA
#undef PG8_LDB
#undef PG8_MMA
#undef PG8_WAIT_V
#undef PG8_WAIT_L
#undef PG8_BAR
#undef PG8_SCHED
}
}

namespace att {
#define ALAS __attribute__((address_space(3)))
using bf16x8 = __attribute__((ext_vector_type(8))) short;
using s16x4  = __attribute__((ext_vector_type(4))) short;
using f32x16 = __attribute__((ext_vector_type(16))) float;
constexpr int KVBLK = 64, SHM_V = KVBLK * 128 * 2, SHM_K = KVBLK * 128 * 2;
constexpr int L_V = 0, L_K = 2 * SHM_V, L_FLAG = 2 * SHM_V + 2 * SHM_K;
#define KSWZ(row, colB) ((row) * 256 + ((colB) ^ (((row) & 7) << 4)))
#define SBAR() __builtin_amdgcn_sched_barrier(0)
__device__ __forceinline__ int crow(int r, int hi) { return (r & 3) + 8 * (r >> 2) + 4 * hi; }
__device__ __forceinline__ unsigned cvtpk(float lo, float hi) { unsigned r; asm volatile("v_cvt_pk_bf16_f32 %0, %1, %2" : "=v"(r) : "v"(lo), "v"(hi)); return r; }
__device__ __forceinline__ void qkt(f32x16& p0, f32x16& p1, const ALAS unsigned char* Ks, const bf16x8* qr, int r32, int hi) {
    p0 = f32x16{}; p1 = f32x16{};
#pragma unroll
    for (int d0 = 0; d0 < 8; ++d0) { const int cb = (d0 * 16 + hi * 8) * 2;
        const bf16x8 b0 = *(const ALAS bf16x8*)(Ks + KSWZ(r32, cb));
        const bf16x8 b1 = *(const ALAS bf16x8*)(Ks + KSWZ(32 + r32, cb));
        p0 = __builtin_amdgcn_mfma_f32_32x32x16_bf16(b0, qr[d0], p0, 0, 0, 0);
        p1 = __builtin_amdgcn_mfma_f32_32x32x16_bf16(b1, qr[d0], p1, 0, 0, 0); }
}
__device__ __forceinline__ int v_st(int k, int c) { const int kk = (k & ~0xC) | ((k & 4) << 1) | ((k & 8) >> 1); return ((kk >> 3) * 4 + (c >> 5)) * 512 + ((kk & 7) * 32 + (c & 31)) * 2; }
__device__ __forceinline__ int v_rd_base(int lane) { return ((lane & 3) << 3) | (((lane >> 2) & 3) << 6) | (((lane >> 4) & 1) << 5) | (((lane >> 5) & 1) << 8); }
constexpr int v_rd_off(int d0, int ks, int half) { return d0 * 512 + ks * 4096 + half * 2048; }
template <int OFF> __device__ __forceinline__ s16x4 tr_read(int vb) { s16x4 r; asm volatile("ds_read_b64_tr_b16 %0, %1 offset:%2" : "=&v"(r) : "v"(vb), "i"(OFF) : "memory"); return r; }
template <int D0> __device__ __forceinline__ void pv_one(f32x16& od, int vb, bf16x8 pa0, bf16x8 pa1, bf16x8 pa2, bf16x8 pa3) {
    const s16x4 l0 = tr_read<v_rd_off(D0, 0, 0)>(vb), h0 = tr_read<v_rd_off(D0, 0, 1)>(vb), l1 = tr_read<v_rd_off(D0, 1, 0)>(vb), h1 = tr_read<v_rd_off(D0, 1, 1)>(vb);
    const s16x4 l2 = tr_read<v_rd_off(D0, 2, 0)>(vb), h2 = tr_read<v_rd_off(D0, 2, 1)>(vb), l3 = tr_read<v_rd_off(D0, 3, 0)>(vb), h3 = tr_read<v_rd_off(D0, 3, 1)>(vb);
    asm volatile("s_waitcnt lgkmcnt(0)" ::: "memory"); SBAR();
#define PK(L, H) (bf16x8){L[0], L[1], L[2], L[3], H[0], H[1], H[2], H[3]}
    od = __builtin_amdgcn_mfma_f32_32x32x16_bf16(pa0, PK(l0, h0), od, 0, 0, 0);
    od = __builtin_amdgcn_mfma_f32_32x32x16_bf16(pa1, PK(l1, h1), od, 0, 0, 0);
    od = __builtin_amdgcn_mfma_f32_32x32x16_bf16(pa2, PK(l2, h2), od, 0, 0, 0);
    od = __builtin_amdgcn_mfma_f32_32x32x16_bf16(pa3, PK(l3, h3), od, 0, 0, 0);
#undef PK
}
__device__ __forceinline__ void pv_d0(f32x16* o, int vb, bf16x8 pa0, bf16x8 pa1, bf16x8 pa2, bf16x8 pa3) {
    pv_one<0>(o[0], vb, pa0, pa1, pa2, pa3); pv_one<1>(o[1], vb, pa0, pa1, pa2, pa3); pv_one<2>(o[2], vb, pa0, pa1, pa2, pa3); pv_one<3>(o[3], vb, pa0, pa1, pa2, pa3);
}
__device__ __forceinline__ void pack_p(const f32x16& p0, const f32x16& p1, bf16x8& pa0, bf16x8& pa1, bf16x8& pa2, bf16x8& pa3) {
#define PK4(P, BASE, OUT) do { unsigned a0 = cvtpk(P[BASE + 0], P[BASE + 1]), a1 = cvtpk(P[BASE + 2], P[BASE + 3]);   \
    unsigned b0 = cvtpk(P[BASE + 4], P[BASE + 5]), b1 = cvtpk(P[BASE + 6], P[BASE + 7]);                              \
    auto r0 = __builtin_amdgcn_permlane32_swap(a0, b0, false, false); auto r1 = __builtin_amdgcn_permlane32_swap(a1, b1, false, false); \
    u32x4 w = {r0[0], r1[0], r0[1], r1[1]}; OUT = *reinterpret_cast<bf16x8*>(&w); } while (0)
    PK4(p0, 0, pa0); PK4(p0, 8, pa1); PK4(p1, 0, pa2); PK4(p1, 8, pa3);
#undef PK4
}
__device__ __forceinline__ float sp2(float z2) { return fmaxf(z2, 0.f) + __builtin_amdgcn_logf(1.0f + __builtin_amdgcn_exp2f(-fabsf(z2))); }
__device__ __forceinline__ void sb_weights(f32x16& p0, f32x16& p1, float& R, int hi) {
    float nl[32];
#pragma unroll
    for (int i = 0; i < 16; ++i) { const float z = p0[i], s = sp2(z); nl[i] = s; p0[i] = z - s; }
#pragma unroll
    for (int i = 0; i < 16; ++i) { const float z = p1[i], s = sp2(z); nl[16 + i] = s; p1[i] = z - s; }
    float S[9]; S[8] = 0.f;
#pragma unroll
    for (int g = 7; g >= 0; --g) S[g] = S[g + 1] + ((nl[4 * g] + nl[4 * g + 1]) + (nl[4 * g + 2] + nl[4 * g + 3]));
    float tot; { auto rr = __builtin_amdgcn_permlane32_swap(__float_as_uint(S[0]), __float_as_uint(S[0]), false, false); tot = __uint_as_float(rr[0]) + __uint_as_float(rr[1]); }
#pragma unroll
    for (int g = 0; g < 8; ++g) {
        const float snd = hi ? S[g] : S[g + 1];
        auto rr = __builtin_amdgcn_permlane32_swap(__float_as_uint(snd), __float_as_uint(snd), false, false);
        const float rcv = hi ? __uint_as_float(rr[0]) : __uint_as_float(rr[1]);
        const float t3 = R - S[g + 1] - rcv, t2 = t3 - nl[4 * g + 3], t1 = t2 - nl[4 * g + 2], t0 = t1 - nl[4 * g + 1];
        if (g < 4) { p0[4 * g + 3] = __builtin_amdgcn_exp2f(p0[4 * g + 3] + t3); p0[4 * g + 2] = __builtin_amdgcn_exp2f(p0[4 * g + 2] + t2); p0[4 * g + 1] = __builtin_amdgcn_exp2f(p0[4 * g + 1] + t1); p0[4 * g] = __builtin_amdgcn_exp2f(p0[4 * g] + t0); }
        else { const int q = 4 * (g - 4); p1[q + 3] = __builtin_amdgcn_exp2f(p1[q + 3] + t3); p1[q + 2] = __builtin_amdgcn_exp2f(p1[q + 2] + t2); p1[q + 1] = __builtin_amdgcn_exp2f(p1[q + 1] + t1); p1[q] = __builtin_amdgcn_exp2f(p1[q] + t0); }
    }
    R -= tot;
}
constexpr int L_STG = 69632;
__device__ __forceinline__ void epi_rows(ALAS unsigned char* lds, const f32x16* o, const float* rn, const bf16_t* __restrict__ gate0, const float* __restrict__ gain, bf16_t* __restrict__ out0, int wid, int lane) {
    const int r32 = lane & 31, hi = lane >> 5;
    ALAS bf16_t* stg = (ALAS bf16_t*)(lds + L_STG + wid * 8192);
#pragma unroll
    for (int r = 0; r < 16; ++r)
#pragma unroll
        for (int d0 = 0; d0 < 4; ++d0) stg[crow(r, hi) * 128 + 32 * d0 + r32] = (bf16_t)cvtpk(o[d0][r] * rn[r], 0.f);
    asm volatile("s_waitcnt lgkmcnt(0)" ::: "memory");
    const int cc = lane & 15, rr0 = lane >> 4;
    const f32x4 g0 = *(const f32x4*)(gain + 8 * cc), g1 = *(const f32x4*)(gain + 8 * cc + 4);
    u32x4 gt[8];
#pragma unroll
    for (int i = 0; i < 8; ++i) gt[i] = *(const u32x4*)(gate0 + (size_t)(4 * i + rr0) * 128 + 8 * cc);
#pragma unroll
    for (int i = 0; i < 8; ++i) { const int row = 4 * i + rr0;
        const u32x4 v = *(const ALAS u32x4*)(stg + row * 128 + 8 * cc); const u32x4 g = gt[i];
        float y[8], q[8];
        y[0] = bf2f(v.x & 0xffffu); y[1] = bf2f(v.x >> 16); y[2] = bf2f(v.y & 0xffffu); y[3] = bf2f(v.y >> 16); y[4] = bf2f(v.z & 0xffffu); y[5] = bf2f(v.z >> 16); y[6] = bf2f(v.w & 0xffffu); y[7] = bf2f(v.w >> 16);
        q[0] = bf2f(g.x & 0xffffu); q[1] = bf2f(g.x >> 16); q[2] = bf2f(g.y & 0xffffu); q[3] = bf2f(g.y >> 16); q[4] = bf2f(g.z & 0xffffu); q[5] = bf2f(g.z >> 16); q[6] = bf2f(g.w & 0xffffu); q[7] = bf2f(g.w >> 16);
#pragma unroll
        for (int e = 0; e < 8; ++e) y[e] = y[e] * (e < 4 ? g0[e & 3] : g1[e & 3]) * (q[e] / (1.0f + __expf(-q[e])));
        u32x4 w; w.x = cvtpk(y[0], y[1]); w.y = cvtpk(y[2], y[3]); w.z = cvtpk(y[4], y[5]); w.w = cvtpk(y[6], y[7]);
        *(u32x4*)(out0 + (size_t)row * DM + 8 * cc) = w; }
    asm volatile("s_waitcnt lgkmcnt(0)" ::: "memory");
}
constexpr float SB_EXIT = -160.0f;
template <bool EARLY>
__device__ __forceinline__ void sb_unit(ALAS unsigned char* lds, const bf16_t* __restrict__ proj, const float* __restrict__ gain, bf16_t* __restrict__ mixed, int b, int h, int qb) {
    int tid_ = threadIdx.x; asm volatile("" : "+v"(tid_)); const int tid = tid_, wid = __builtin_amdgcn_readfirstlane(tid >> 6), lane = tid & 63, r32 = lane & 31, hi = lane >> 5;
    const size_t tok0 = (size_t)b * SEQ; const int q0 = qb * 256, tw0 = q0 + 32 * wid;
    const bf16_t* Kg = proj + (size_t)(8 + h) * PHS + tok0 * 128; const bf16_t* Vg = proj + (size_t)(16 + h) * PHS + tok0 * 128;
    bf16x8 qr[8];
    { const bf16_t* Qw = proj + (size_t)h * PHS + (tok0 + tw0 + r32) * 128 + hi * 8;
#pragma unroll
      for (int d0 = 0; d0 < 8; ++d0) qr[d0] = *(const bf16x8*)(Qw + d0 * 16); }
    const int sr = tid >> 4, sc = (tid & 15) * 8;
    const int vst0 = v_st(sr, sc), vst1 = v_st(32 + sr, sc), kst0 = KSWZ(sr, sc * 2), kst1 = KSWZ(32 + sr, sc * 2);
    const int vb0 = (int)(unsigned)(size_t)(lds + L_V) + v_rd_base(lane);
    ALAS unsigned* flags = (ALAS unsigned*)(lds + L_FLAG);
    bf16x8 ks0, ks1, vs0, vs1;
#define SLOAD(k0) do { const size_t o0 = (size_t)((k0) + sr) * 128 + sc, o1 = (size_t)((k0) + 32 + sr) * 128 + sc; \
    vs0 = *(const bf16x8*)(Vg + o0); vs1 = *(const bf16x8*)(Vg + o1); ks0 = *(const bf16x8*)(Kg + o0); ks1 = *(const bf16x8*)(Kg + o1); } while (0)
#define SWRITE(bf) do { *(ALAS bf16x8*)(lds + L_V + (bf) * SHM_V + vst0) = vs0; *(ALAS bf16x8*)(lds + L_V + (bf) * SHM_V + vst1) = vs1; \
    *(ALAS bf16x8*)(lds + L_K + (bf) * SHM_K + kst0) = ks0; *(ALAS bf16x8*)(lds + L_K + (bf) * SHM_K + kst1) = ks1; } while (0)
    const int jmax = 4 * qb + 3;
    SLOAD(jmax * KVBLK); SWRITE(0); __syncthreads();
    float R = 0.f; f32x16 o[4] = {};
    for (int it = 0, j = jmax;; ++it, --j) {
        const int cur = it & 1, key0 = j * KVBLK;
        const bool act = key0 < tw0 + 31;
        if (!act && j > 0) SLOAD((j - 1) * KVBLK);
        if (act) {
            f32x16 p0, p1;
            qkt(p0, p1, lds + L_K + cur * SHM_K, qr, r32, hi);
            if (key0 + 63 >= tw0) {
                const int lim = tw0 + r32 - key0 - 4 * hi;
#pragma unroll
                for (int i = 0; i < 16; ++i) { const int kk = 8 * (i >> 2) + (i & 3); if (kk >= lim) p0[i] = -INFINITY; if (kk + 32 >= lim) p1[i] = -INFINITY; }
            }
            sb_weights(p0, p1, R, hi);
            SBAR(); if (j > 0) SLOAD((j - 1) * KVBLK); SBAR();
            bf16x8 pa0, pa1, pa2, pa3;
            pack_p(p0, p1, pa0, pa1, pa2, pa3);
            pv_d0(o, vb0 + cur * SHM_V, pa0, pa1, pa2, pa3);
        }
        if (EARLY) { const bool dn = __all(R < SB_EXIT); if (lane == 0) flags[cur * 8 + wid] = dn ? 1u : 0u; }
        if (j > 0) SWRITE(cur ^ 1);
        __syncthreads();
        if (j == 0) break;
        if (EARLY) { const u32x4 f0 = *(const ALAS u32x4*)(flags + cur * 8), f1 = *(const ALAS u32x4*)(flags + cur * 8 + 4);
            if ((f0.x & f0.y & f0.z & f0.w & f1.x & f1.y & f1.z & f1.w) != 0u) break; }
    }
#undef SLOAD
#undef SWRITE
    float rn[16];
#pragma unroll
    for (int r = 0; r < 16; ++r) { float ss = (o[0][r] * o[0][r] + o[1][r] * o[1][r]) + (o[2][r] * o[2][r] + o[3][r] * o[3][r]);
#pragma unroll
        for (int x = 1; x < 32; x <<= 1) ss += __shfl_xor(ss, x);
        rn[r] = 1.0f / sqrtf(ss * (1.0f / HD) + EPS); }
    epi_rows(lds, o, rn, proj + (size_t)(24 + h) * PHS + (tok0 + tw0) * 128, gain + h * HD, mixed + (tok0 + tw0) * DM + h * HD, wid, lane);
}
constexpr int L_WS = L_FLAG + 64;
constexpr float DSA_THR = 11.5f;
__device__ __forceinline__ void dsa_unit(ALAS unsigned char* lds, const bf16_t* __restrict__ proj, const unsigned long long* __restrict__ mask, const float* __restrict__ gain,
                                         bf16_t* __restrict__ mixed, int b, int h, int qb) {
    int tid_ = threadIdx.x; asm volatile("" : "+v"(tid_)); const int tid = tid_, wid = __builtin_amdgcn_readfirstlane(tid >> 6), lane = tid & 63, r32 = lane & 31, hi = lane >> 5, g = h >> 2;
    const size_t tok0 = (size_t)b * SEQ; const int q0 = qb * 256, tw0 = q0 + 32 * wid;
    const bf16_t* Kg = proj + (size_t)(40 + g) * PHS + tok0 * 128; const bf16_t* Vg = proj + (size_t)(42 + g) * PHS + tok0 * 128;
    bf16x8 qr[8];
    { const bf16_t* Qw = proj + (size_t)(32 + h) * PHS + (tok0 + tw0 + r32) * 128 + hi * 8;
#pragma unroll
      for (int d0 = 0; d0 < 8; ++d0) qr[d0] = *(const bf16x8*)(Qw + d0 * 16); }
    const unsigned long long* mrow = mask + (tok0 + tw0 + r32) * 64;
    const int sr = tid >> 4, sc = (tid & 15) * 8;
    const int vst0 = v_st(sr, sc), vst1 = v_st(32 + sr, sc), kst0 = KSWZ(sr, sc * 2), kst1 = KSWZ(32 + sr, sc * 2);
    const int vb0 = (int)(unsigned)(size_t)(lds + L_V) + v_rd_base(lane);
    ALAS float* wsl = (ALAS float*)(lds + L_WS) + wid * 64;
    bf16x8 ks0, ks1, vs0, vs1;
#define SLOAD(k0) do { const size_t o0 = (size_t)((k0) + sr) * 128 + sc, o1 = (size_t)((k0) + 32 + sr) * 128 + sc; \
    vs0 = *(const bf16x8*)(Vg + o0); vs1 = *(const bf16x8*)(Vg + o1); ks0 = *(const bf16x8*)(Kg + o0); ks1 = *(const bf16x8*)(Kg + o1); } while (0)
#define SWRITE(bf) do { *(ALAS bf16x8*)(lds + L_V + (bf) * SHM_V + vst0) = vs0; *(ALAS bf16x8*)(lds + L_V + (bf) * SHM_V + vst1) = vs1; \
    *(ALAS bf16x8*)(lds + L_K + (bf) * SHM_K + kst0) = ks0; *(ALAS bf16x8*)(lds + L_K + (bf) * SHM_K + kst1) = ks1; } while (0)
    const int jmax = 4 * qb + 3;
    SLOAD(0); SWRITE(0); __syncthreads();
    float m_reg = -1e30f, l_reg = 0.f; f32x16 o[4] = {};
    for (int j = 0;; ++j) {
        const int cur = j & 1, key0 = j * KVBLK;
        const bool act = key0 <= tw0 + 31;
        unsigned long long mw = 0ull; if (act) mw = mrow[j];
        if (!act && j < jmax) SLOAD((j + 1) * KVBLK);
        if (act) {
            f32x16 p0, p1;
            qkt(p0, p1, lds + L_K + cur * SHM_K, qr, r32, hi);
            const int mlo = (int)((unsigned)mw >> (4 * hi)), mhi = (int)((unsigned)(mw >> 32) >> (4 * hi));
            const unsigned NINF = 0xff800000u;
#pragma unroll
            for (int i = 0; i < 16; ++i) { const int kk = 8 * (i >> 2) + (i & 3);
                const unsigned t0 = (unsigned)__builtin_amdgcn_sbfe(mlo, kk, 1), t1 = (unsigned)__builtin_amdgcn_sbfe(mhi, kk, 1);
                p0[i] = __uint_as_float((__float_as_uint(p0[i]) & t0) | (NINF & ~t0)); p1[i] = __uint_as_float((__float_as_uint(p1[i]) & t1) | (NINF & ~t1)); }
            float pmax = p0[0];
#pragma unroll
            for (int r = 1; r < 16; ++r) pmax = fmaxf(pmax, p0[r]);
#pragma unroll
            for (int r = 0; r < 16; ++r) pmax = fmaxf(pmax, p1[r]);
            { auto rr = __builtin_amdgcn_permlane32_swap(__float_as_uint(pmax), __float_as_uint(pmax), false, false); pmax = fmaxf(__uint_as_float(rr[0]), __uint_as_float(rr[1])); }
            float mn, alpha;
            if (__all(pmax - m_reg <= DSA_THR)) { mn = m_reg; alpha = 1.f; }
            else { mn = fmaxf(m_reg, pmax); alpha = __builtin_amdgcn_exp2f(m_reg - mn); m_reg = mn; }
            if (__any(alpha < 1.f)) { if (hi == 0) wsl[r32] = alpha; asm volatile("s_waitcnt lgkmcnt(0)" ::: "memory");
#pragma unroll
                for (int r = 0; r < 16; ++r) { const float al = wsl[crow(r, hi)];
#pragma unroll
                    for (int d = 0; d < 4; ++d) o[d][r] *= al; } }
            float ps = 0.f;
#pragma unroll
            for (int r = 0; r < 16; ++r) { p0[r] = __builtin_amdgcn_exp2f(p0[r] - mn); p1[r] = __builtin_amdgcn_exp2f(p1[r] - mn); ps += p0[r] + p1[r]; }
            { auto rr = __builtin_amdgcn_permlane32_swap(__float_as_uint(ps), __float_as_uint(ps), false, false); ps = __uint_as_float(rr[0]) + __uint_as_float(rr[1]); }
            l_reg = l_reg * alpha + ps;
            SBAR(); if (j < jmax) SLOAD((j + 1) * KVBLK); SBAR();
            bf16x8 pa0, pa1, pa2, pa3;
            pack_p(p0, p1, pa0, pa1, pa2, pa3);
            pv_d0(o, vb0 + cur * SHM_V, pa0, pa1, pa2, pa3);
        }
        if (j < jmax) SWRITE(cur ^ 1);
        __syncthreads();
        if (j == jmax) break;
    }
#undef SLOAD
#undef SWRITE
    if (hi == 0) wsl[32 + r32] = l_reg; asm volatile("s_waitcnt lgkmcnt(0)" ::: "memory");
    float rn[16];
#pragma unroll
    for (int r = 0; r < 16; ++r) { const float il = 1.0f / wsl[32 + crow(r, hi)];
#pragma unroll
        for (int d = 0; d < 4; ++d) o[d][r] *= il;
        float ss = (o[0][r] * o[0][r] + o[1][r] * o[1][r]) + (o[2][r] * o[2][r] + o[3][r] * o[3][r]);
#pragma unroll
        for (int x = 1; x < 32; x <<= 1) ss += __shfl_xor(ss, x);
        rn[r] = 1.0f / sqrtf(ss * (1.0f / HD) + EPS); }
    epi_rows(lds, o, rn, proj + (size_t)(44 + h) * PHS + (tok0 + tw0) * 128, gain + h * HD, mixed + (tok0 + tw0) * DM + 1024 + h * HD, wid, lane);
    asm volatile("s_waitcnt lgkmcnt(0)" ::: "memory");
}
}

namespace idx {
#define ILAS __attribute__((address_space(3)))
using bf16x8 = __attribute__((ext_vector_type(8))) short;
using f32x16 = __attribute__((ext_vector_type(16))) float;
constexpr int L_SC = 0, L_HIST = 131072, L_CAND = 131072 + 8192, CAND_CAP = 256;
__device__ __forceinline__ int lbin(float v, float mn, float scale) { return (int)fminf(fmaxf((v - mn) * scale, 0.f), 255.f); }
__device__ __forceinline__ void index_unit(ILAS unsigned char* lds, const bf16_t* __restrict__ proj, const float* __restrict__ iw, unsigned long long* __restrict__ mask, int b, int t0) {
    int tid_ = threadIdx.x; asm volatile("" : "+v"(tid_)); const int tid = tid_, wid = __builtin_amdgcn_readfirstlane(tid >> 6), lane = tid & 63, r = lane & 31, hi = lane >> 5;
    const size_t tok0 = (size_t)b * SEQ;
    ILAS unsigned* sc = (ILAS unsigned*)(lds + L_SC);
    {
        bf16x8 af[4][4]; float wv[4][16];
#pragma unroll
        for (int T = 0; T < 4; ++T) {
            const int hd_ = (r & 3) + 4 * (r >> 3);
            const bf16_t* qb = proj + (size_t)(52 + (hd_ >> 1)) * PHS + (tok0 + t0 + 2 * T + ((r >> 2) & 1)) * 128 + (hd_ & 1) * ID + 8 * hi;
#pragma unroll
            for (int ks = 0; ks < 4; ++ks) af[T][ks] = *(const bf16x8*)(qb + 16 * ks);
            const float* wp = iw + (tok0 + t0 + 2 * T + hi) * 16;
#pragma unroll
            for (int i = 0; i < 4; ++i) { const f32x4 w4 = *(const f32x4*)(wp + 4 * i); wv[T][4 * i] = w4.x; wv[T][4 * i + 1] = w4.y; wv[T][4 * i + 2] = w4.z; wv[T][4 * i + 3] = w4.w; }
        }
        const int nt32 = 2 * ((t0 + 8 + 63) >> 6), nt32p = (nt32 + 15) & ~15;
        const bf16_t* kb = proj + IKC_OFF + (tok0 + r) * 64 + 8 * hi;
        for (int rq_ = 0; rq_ < REPS(20); ++rq_) {
        bf16x8 b0[4], b1[4], b2[4];
        int jt = wid;
#define KLOAD(dst, j) do { _Pragma("unroll") for (int ks = 0; ks < 4; ++ks) dst[ks] = *(const bf16x8*)(kb + (size_t)(32 * (j)) * 64 + 16 * ks); } while (0)
        if (jt < nt32) KLOAD(b0, jt);
        if (jt + 8 < nt32) KLOAD(b1, jt + 8);
        for (; jt < nt32; jt += 8) {
            const int key0 = 32 * jt;
            if (jt + 16 < nt32) KLOAD(b2, jt + 16);
#pragma unroll
            for (int T = 0; T < 4; ++T) {
                f32x16 acc = {};
#pragma unroll
                for (int ks = 0; ks < 4; ++ks) acc = __builtin_amdgcn_mfma_f32_32x32x16_bf16(af[T][ks], b0[ks], acc, 0, 0, 0);
                float sv = 0.f;
#pragma unroll
                for (int rr = 0; rr < 16; ++rr) sv = fmaf(wv[T][rr], fmaxf(acc[rr], 0.f), sv);
                const int q = 2 * T + hi, key = key0 + r;
                sc[q * SEQ + key] = (key <= t0 + q) ? __float_as_uint(sv) : 0xff800000u;
            }
#pragma unroll
            for (int ks = 0; ks < 4; ++ks) { b0[ks] = b1[ks]; b1[ks] = b2[ks]; }
        }
        for (; jt < nt32p; jt += 8) {
#pragma unroll
            for (int T = 0; T < 4; ++T) sc[(2 * T + hi) * SEQ + 32 * jt + r] = 0xff800000u;
        }
#undef KLOAD
        }
    }
    if (PROBE_REP == 29) { float x = (float)lane; for (int i = 0; i < 4096; ++i) { asm volatile("v_fma_f32 %0, %0, %0, %0" : "+v"(x)); } if (x == 12345.f) sc[0] = 0u; }
    __syncthreads();
    const int t = t0 + wid, N = t + 1, NE = (N + 63) >> 6;
    const ILAS unsigned* myrow = sc + wid * SEQ + lane;
    unsigned long long myw = 0ull;
    for (int rs_ = 0; rs_ < REPS(21); ++rs_)
    if (N <= TOPK) {
        for (int e = 0; e < NE; ++e) { const unsigned long long bm = __ballot(64 * e + lane <= t); if (lane == e) myw = bm; }
    } else {
        ILAS unsigned* hist = (ILAS unsigned*)(lds + L_HIST) + wid * 256;
        ILAS unsigned* cand = (ILAS unsigned*)(lds + L_CAND) + wid * CAND_CAP;
        const int NE4 = (NE + 7) & ~7, NF = N >> 6;
        float mx = -INFINITY, mn = INFINITY;
        for (int rp24 = 0; rp24 < REPS(24); ++rp24)
        for (int e = 0; e < NE4; e += 8) { float v[8];
#pragma unroll
            for (int i = 0; i < 8; ++i) v[i] = __uint_as_float(myrow[64 * (e + i)]);
            if (e + 8 <= NF) {
#pragma unroll
                for (int i = 0; i < 8; ++i) { mx = fmaxf(mx, v[i]); mn = fminf(mn, v[i]); }
            } else {
#pragma unroll
                for (int i = 0; i < 8; ++i) { mx = fmaxf(mx, v[i]); mn = fminf(mn, (64 * (e + i) + lane <= t) ? v[i] : INFINITY); }
            } }
#pragma unroll
        for (int o = 1; o < 64; o <<= 1) { mx = fmaxf(mx, __shfl_xor(mx, o)); mn = fminf(mn, __shfl_xor(mn, o)); }
        const float scale = (mx > mn) ? 256.0f / (mx - mn) : 0.f;
        *(ILAS u32x4*)(hist + 4 * lane) = (u32x4){0u, 0u, 0u, 0u};
        asm volatile("s_waitcnt lgkmcnt(0)" ::: "memory");
        for (int rp25 = 0; rp25 < REPS(25); ++rp25) { if (rp25) { *(ILAS u32x4*)(hist + 4 * lane) = (u32x4){0u, 0u, 0u, 0u}; asm volatile("s_waitcnt lgkmcnt(0)" ::: "memory"); }
        for (int e = 0; e < NE4; e += 8) { float v[8]; int bn_[8];
#pragma unroll
            for (int i = 0; i < 8; ++i) v[i] = __uint_as_float(myrow[64 * (e + i)]);
#pragma unroll
            for (int i = 0; i < 8; ++i) bn_[i] = lbin(v[i], mn, scale);
#pragma unroll
            for (int i = 0; i < 8; ++i) __hip_atomic_fetch_add(hist + bn_[i], 1u, __ATOMIC_RELAXED, __HIP_MEMORY_SCOPE_WORKGROUP); } }
        asm volatile("s_waitcnt lgkmcnt(0)" ::: "memory");
        unsigned pref; int krem; unsigned ceq;
        int bstar, need; unsigned cb;
        {
            const u32x4 c4 = *(const ILAS u32x4*)(hist + 4 * lane);
            const unsigned s4 = (c4.x + c4.y) + (c4.z + c4.w);
            unsigned sl = s4;
#pragma unroll
            for (int off = 1; off < 64; off <<= 1) { const unsigned tt = __shfl_down(sl, off); if (lane + off < 64) sl += tt; }
            const unsigned long long bal = __ballot(sl >= (unsigned)TOPK);
            const int ls = 63 - __clzll((long long)bal);
            const unsigned above = (unsigned)__builtin_amdgcn_readlane((int)sl, ls) - (unsigned)__builtin_amdgcn_readlane((int)s4, ls);
            const unsigned cx = (unsigned)__builtin_amdgcn_readlane((int)c4.x, ls), cy = (unsigned)__builtin_amdgcn_readlane((int)c4.y, ls);
            const unsigned cz = (unsigned)__builtin_amdgcn_readlane((int)c4.z, ls), cw = (unsigned)__builtin_amdgcn_readlane((int)c4.w, ls);
            unsigned ab = above; int d;
            if (ab + cw >= (unsigned)TOPK) { d = 3; cb = cw; } else { ab += cw;
                if (ab + cz >= (unsigned)TOPK) { d = 2; cb = cz; } else { ab += cz;
                    if (ab + cy >= (unsigned)TOPK) { d = 1; cb = cy; } else { ab += cy; d = 0; cb = cx; } } }
            bstar = 4 * ls + d; need = TOPK - (int)ab;
        }
        unsigned tau; int req;
        if (cb <= (unsigned)CAND_CAP) {
            int base = 0;
            for (int rp26 = 0; rp26 < REPS(26); ++rp26) { base = 0;
            for (int e = 0; e < NE4; e += 8) { unsigned vb[8]; bool in[8]; unsigned long long m[8];
#pragma unroll
                for (int i = 0; i < 8; ++i) vb[i] = myrow[64 * (e + i)];
#pragma unroll
                for (int i = 0; i < 8; ++i) { in[i] = lbin(__uint_as_float(vb[i]), mn, scale) == bstar; m[i] = __ballot(in[i]); }
                if ((m[0] | m[1] | m[2] | m[3] | m[4] | m[5] | m[6] | m[7]) != 0ull) {
#pragma unroll
                    for (int i = 0; i < 8; ++i) { if (in[i]) cand[base + __builtin_amdgcn_mbcnt_hi((unsigned)(m[i] >> 32), __builtin_amdgcn_mbcnt_lo((unsigned)m[i], 0u))] = fkey(__uint_as_float(vb[i])); base += __popcll(m[i]); }
                } } }
            asm volatile("s_waitcnt lgkmcnt(0)" ::: "memory");
            unsigned k0 = 0u, k1 = 0u, k2 = 0u, k3 = 0u; int c0 = 0, c1 = 0, c2 = 0, c3 = 0;
            const int ncb = (int)cb;
            if (lane < ncb) k0 = cand[lane]; if (64 + lane < ncb) k1 = cand[64 + lane]; if (128 + lane < ncb) k2 = cand[128 + lane]; if (192 + lane < ncb) k3 = cand[192 + lane];
            asm volatile("s_waitcnt lgkmcnt(0)" ::: "memory");
            for (int rp27 = 0; rp27 < REPS(27); ++rp27) { c0 = c1 = c2 = c3 = 0;
            for (int j = 0; j < ncb; ++j) { const unsigned kj = cand[j];
                c0 += (kj > k0 || (kj == k0 && j < lane)) ? 1 : 0;
                if (ncb > 64) { c1 += (kj > k1 || (kj == k1 && j < 64 + lane)) ? 1 : 0; c2 += (kj > k2 || (kj == k2 && j < 128 + lane)) ? 1 : 0; c3 += (kj > k3 || (kj == k3 && j < 192 + lane)) ? 1 : 0; } } }
            const unsigned long long h0 = __ballot(lane < ncb && c0 == need - 1), h1 = __ballot(64 + lane < ncb && c1 == need - 1), h2 = __ballot(128 + lane < ncb && c2 == need - 1), h3 = __ballot(192 + lane < ncb && c3 == need - 1);
            if (h0) tau = (unsigned)__builtin_amdgcn_readlane((int)k0, __builtin_ctzll(h0)); else if (h1) tau = (unsigned)__builtin_amdgcn_readlane((int)k1, __builtin_ctzll(h1));
            else if (h2) tau = (unsigned)__builtin_amdgcn_readlane((int)k2, __builtin_ctzll(h2)); else tau = (unsigned)__builtin_amdgcn_readlane((int)k3, __builtin_ctzll(h3));
            req = __popcll(__ballot(lane < ncb && c0 < need && k0 == tau)) + __popcll(__ballot(64 + lane < ncb && c1 < need && k1 == tau))
                + __popcll(__ballot(128 + lane < ncb && c2 < need && k2 == tau)) + __popcll(__ballot(192 + lane < ncb && c3 < need && k3 == tau));
        } else {
            pref = 0u; krem = TOPK; ceq = 0u;
            for (int pass = 0; pass < 4; ++pass) {
                const int shift = 24 - 8 * pass;
                *(ILAS u32x4*)(hist + 4 * lane) = (u32x4){0u, 0u, 0u, 0u};
                asm volatile("s_waitcnt lgkmcnt(0)" ::: "memory");
                for (int e = 0; e < NE; ++e) { const unsigned k = fkey(__uint_as_float(myrow[64 * e]));
                    const bool mt = (pass == 0) ? true : ((k >> ((shift + 8) & 31)) == pref);
                    if (mt) __hip_atomic_fetch_add(hist + ((k >> shift) & 255u), 1u, __ATOMIC_RELAXED, __HIP_MEMORY_SCOPE_WORKGROUP); }
                asm volatile("s_waitcnt lgkmcnt(0)" ::: "memory");
                const u32x4 c4 = *(const ILAS u32x4*)(hist + 4 * lane);
                const unsigned s4 = (c4.x + c4.y) + (c4.z + c4.w);
                unsigned sl = s4;
#pragma unroll
                for (int off = 1; off < 64; off <<= 1) { const unsigned tt = __shfl_down(sl, off); if (lane + off < 64) sl += tt; }
                const unsigned long long bal = __ballot(sl >= (unsigned)krem);
                const int ls = 63 - __clzll((long long)bal);
                const unsigned above = (unsigned)__builtin_amdgcn_readlane((int)sl, ls) - (unsigned)__builtin_amdgcn_readlane((int)s4, ls);
                const unsigned cx = (unsigned)__builtin_amdgcn_readlane((int)c4.x, ls), cy = (unsigned)__builtin_amdgcn_readlane((int)c4.y, ls);
                const unsigned cz = (unsigned)__builtin_amdgcn_readlane((int)c4.z, ls), cw = (unsigned)__builtin_amdgcn_readlane((int)c4.w, ls);
                unsigned ab = above; int d;
                if (ab + cw >= (unsigned)krem) d = 3; else { ab += cw;
                    if (ab + cz >= (unsigned)krem) d = 2; else { ab += cz;
                        if (ab + cy >= (unsigned)krem) d = 1; else { ab += cy; d = 0; } } }
                pref = (pref << 8) | (unsigned)(4 * ls + d); krem -= (int)ab;
            }
            tau = pref; req = krem;
        }
        int rleft = req;
        for (int rp28 = 0; rp28 < REPS(28); ++rp28) { rleft = req;
        for (int e = 0; e < NE4; e += 8) { unsigned k[8];
#pragma unroll
            for (int i = 0; i < 8; ++i) k[i] = fkey(__uint_as_float(myrow[64 * (e + i)]));
#pragma unroll
            for (int i = 0; i < 8; ++i) {
                const unsigned long long gt = __ballot(k[i] > tau); unsigned long long em = __ballot(k[i] == tau), take = 0ull;
                if (em != 0ull) { const int cnt = __popcll(em);
                    if (cnt <= rleft) { take = em; rleft -= cnt; }
                    else { while (rleft > 0) { const unsigned long long bb = em & (~em + 1ull); take |= bb; em ^= bb; --rleft; } } }
                const unsigned long long bm = gt | take;
                if (lane == e + i) myw = bm;
            } } }
    }
    mask[(tok0 + t) * 64 + lane] = myw;
    asm volatile("s_waitcnt lgkmcnt(0)" ::: "memory");
    __syncthreads();
}
}

#define LAS __attribute__((address_space(3)))
#define RLX_AGENT __ATOMIC_RELAXED, __HIP_MEMORY_SCOPE_AGENT
#define XB_TMO      128
#define XB_XCNT(j)  (256  + 64 * (j))
#define XB_XSUB(j)  (1280 + 64 * (j))
#define XB_XGEN(j)  (2304 + 64 * (j))
#define XB_TOP      3328
#define XB_TOPGEN   3392
#define XCD_BAR_WORDS 3456
#define XB_SPIN_CAP (1u << 18)

__device__ __forceinline__ unsigned xb_ld(unsigned* p)              { return __hip_atomic_load(p, __ATOMIC_RELAXED, __HIP_MEMORY_SCOPE_AGENT); }
__device__ __forceinline__ unsigned xb_add(unsigned* p, unsigned v) { return __hip_atomic_fetch_add(p, v, __ATOMIC_RELAXED, __HIP_MEMORY_SCOPE_AGENT); }
__device__ __forceinline__ unsigned xb_xcc_id() { return (unsigned)__builtin_amdgcn_s_getreg((3 << 11) | 20) & 0xFu; }
#define XB_SPIN(cond, bar) do { unsigned _sp = 0; while (cond) { __builtin_amdgcn_s_sleep(1); \
    if ((++_sp & 255u) == 0u) { if (xb_ld(&(bar)[XB_TMO])) break; if (_sp > XB_SPIN_CAP) { atomicAdd(&(bar)[XB_TMO], 1u); break; } } } } while (0)

struct XcdBarrier {
    unsigned* bar; unsigned x;
    volatile LAS unsigned* st;
};

__device__ __forceinline__ XcdBarrier xcd_barrier_post(unsigned* bar, volatile LAS unsigned* st) {
    XcdBarrier b; b.bar = bar; b.x = xb_xcc_id(); b.st = st;
    if (threadIdx.x == 0) (void)xb_add(&bar[XB_XCNT(b.x)], 1u);
    return b;
}
__device__ __forceinline__ void xcd_barrier_complete(unsigned* bar, unsigned x, unsigned& nloc, unsigned& nx) {
    const unsigned G = gridDim.x * gridDim.y * gridDim.z;
    unsigned sum, cnt, mine, sp = 0u;
    for (;;) {
        sum = 0u; cnt = 0u; mine = 0u;
#pragma unroll
        for (unsigned j = 0; j < 16; ++j) { const unsigned c = xb_ld(&bar[XB_XCNT(j)]); sum += c; cnt += (c > 0u) ? 1u : 0u; mine = (j == x) ? c : mine; }
        if (sum == G) break;
        __builtin_amdgcn_s_sleep(1);
        if ((++sp & 255u) == 0u) { if (xb_ld(&bar[XB_TMO])) break; if (sp > XB_SPIN_CAP) { atomicAdd(&bar[XB_TMO], 1u); break; } }
    }
    nloc = mine > 0u ? mine : 1u; nx = cnt > 0u ? cnt : 1u;
}

__device__ __forceinline__ void xcd_barrier(const XcdBarrier& b) {
    asm volatile("s_waitcnt vmcnt(0)" ::: "memory");
    __syncthreads();
    if (threadIdx.x == 0) {
        unsigned* bar = b.bar;
        __builtin_amdgcn_s_waitcnt(0);
        unsigned nloc = b.st[0], nx = b.st[1];
        if (nloc == 0u) { xcd_barrier_complete(bar, b.x, nloc, nx); b.st[0] = nloc; b.st[1] = nx; }
        const unsigned old = xb_add(&bar[XB_XSUB(b.x)], 1u);
        const unsigned gen = old / nloc;
        if (old + 1u == (gen + 1u) * nloc) {
            __builtin_amdgcn_fence(__ATOMIC_RELEASE, "agent");
            asm volatile("s_waitcnt vmcnt(0)" ::: "memory");
            const unsigned og = xb_add(&bar[XB_TOP], 1u);
            const unsigned tg = og / nx;
            if (og + 1u == (tg + 1u) * nx) xb_add(&bar[XB_TOPGEN], 1u);
            else XB_SPIN(xb_ld(&bar[XB_TOPGEN]) == tg, bar);
            __builtin_amdgcn_fence(__ATOMIC_ACQUIRE, "agent");
            xb_add(&bar[XB_XGEN(b.x)], 1u);
            asm volatile("s_waitcnt vmcnt(0)" ::: "memory");
        } else {
            XB_SPIN(xb_ld(&bar[XB_XGEN(b.x)]) == gen, bar);
            __builtin_amdgcn_fence(__ATOMIC_ACQUIRE, "agent");
            asm volatile("s_waitcnt vmcnt(0)" ::: "memory");
        }
    }
    __syncthreads();
}

#define GAS __attribute__((address_space(1)))
#define LDS_WAIT() asm volatile("s_waitcnt lgkmcnt(0)" ::: "memory")
constexpr int NWAVES = 8, LDS_BYTES = 149504;

struct Args { const float* x; const int* pos; const float* norm_g; const float* w_in; const float* sb_g; const float* dsa_g; const float* w_out; const float* final_g; float* out; unsigned char* ws; int ph_lo, ph_hi; };

__device__ __forceinline__ void transpose_item(const float* __restrict__ W, int K, int N, int NPAD, bf16_t* __restrict__ WT, LAS float* scr, int item, int lane) {
    const int nblk = NPAD / 32, kb = item / nblk, nb = item % nblk, k0 = 64 * kb, n0 = 32 * nb;
    const int n = n0 + (lane & 31); const bool ok = n < N;
    float tv[32];
#pragma unroll
    for (int i = 0; i < 32; ++i) tv[i] = ok ? W[(size_t)(k0 + 2 * i + (lane >> 5)) * N + n] : 0.f;
#pragma unroll
    for (int i = 0; i < 32; ++i) scr[(2 * i + (lane >> 5)) * 33 + (lane & 31)] = tv[i];
    LDS_WAIT();
    const int c = lane & 7;
#pragma unroll
    for (int j = 0; j < 4; ++j) { const int nn = (lane >> 3) + 8 * j; const LAS float* s = scr + (8 * c) * 33 + nn;
        u32x4 o; o.x = pk2(s[0 * 33], s[1 * 33]); o.y = pk2(s[2 * 33], s[3 * 33]); o.z = pk2(s[4 * 33], s[5 * 33]); o.w = pk2(s[6 * 33], s[7 * 33]);
        *(u32x4*)(WT + (size_t)(n0 + nn) * K + k0 + 8 * c) = o; }
    LDS_WAIT();
}
__device__ __forceinline__ void rmsnorm_2rows_bf16(const float* __restrict__ x0, const float* __restrict__ x1, const float* __restrict__ g, bf16_t* __restrict__ o0, bf16_t* __restrict__ o1, int lane) {
    const f32x4* xa = (const f32x4*)x0 + lane; const f32x4* xb = (const f32x4*)x1 + lane;
    f32x4 va[8], vb[8]; float sa = 0.f, sb = 0.f;
#pragma unroll
    for (int j = 0; j < 8; ++j) { va[j] = xa[64 * j]; vb[j] = xb[64 * j]; }
#pragma unroll
    for (int j = 0; j < 8; ++j) { sa += (va[j].x * va[j].x + va[j].y * va[j].y) + (va[j].z * va[j].z + va[j].w * va[j].w); sb += (vb[j].x * vb[j].x + vb[j].y * vb[j].y) + (vb[j].z * vb[j].z + vb[j].w * vb[j].w); }
#pragma unroll
    for (int o = 1; o < 64; o <<= 1) { sa += __shfl_xor(sa, o); sb += __shfl_xor(sb, o); }
    const float ra = 1.0f / sqrtf(sa * (1.0f / DM) + EPS), rb = 1.0f / sqrtf(sb * (1.0f / DM) + EPS);
    const f32x4* gr = (const f32x4*)g + lane; u32x2* pa = (u32x2*)o0 + lane; u32x2* pb = (u32x2*)o1 + lane;
#pragma unroll
    for (int j = 0; j < 8; ++j) { const f32x4 gg = gr[64 * j]; u32x2 w;
        w.x = pk2(va[j].x * ra * gg.x, va[j].y * ra * gg.y); w.y = pk2(va[j].z * ra * gg.z, va[j].w * ra * gg.w); pa[64 * j] = w;
        w.x = pk2(vb[j].x * rb * gg.x, vb[j].y * rb * gg.y); w.y = pk2(vb[j].z * rb * gg.z, vb[j].w * rb * gg.w); pb[64 * j] = w; }
}

__global__ void __launch_bounds__(NWAVES * 64, 2) mega(Args a) {
    extern __shared__ __attribute__((aligned(16))) unsigned char lds_raw[];
    LAS unsigned char* lds = (LAS unsigned char*)lds_raw;
    int tid_ = threadIdx.x; asm volatile("" : "+v"(tid_)); const int tid = tid_, lane = tid & 63, wave = __builtin_amdgcn_readfirstlane(tid >> 6);
    const int G = gridDim.x, bx = blockIdx.x;
    unsigned char* ws = a.ws;
    bf16_t* HN = (bf16_t*)(ws + WS_HN); bf16_t* WT1 = (bf16_t*)(ws + WS_WT1); bf16_t* WT2 = (bf16_t*)(ws + WS_WT2);
    float* IW = (float*)(ws + WS_IW); float* R128 = (float*)(ws + WS_R128); float* R64 = (float*)(ws + WS_R64); bf16_t* PROJ = (bf16_t*)(ws + WS_PROJ);
    bf16_t* MIXED = (bf16_t*)(ws + WS_MIXED); bf16_t* YB = (bf16_t*)(ws + WS_PROJ); float* SSP = (float*)(ws + WS_SSP); unsigned long long* MASKW = (unsigned long long*)(ws + WS_MASK); const unsigned long long* MASK = MASKW;
    const int lo = a.ph_lo, hi = a.ph_hi;
#define IN(k) (lo <= (k) && (k) < hi)
    if (tid < 2) ((volatile LAS unsigned*)(lds + LDS_BYTES - 64))[tid] = 0u;
    __syncthreads();
    const XcdBarrier xbar = xcd_barrier_post((unsigned*)(ws + WS_CTL) + 4096, (volatile LAS unsigned*)(lds + LDS_BYTES - 64));
#define SEAM(k) do { if (IN(k) && IN((k) + 1)) { if ((k) == 0) cooperative_groups::this_grid().sync(); else xcd_barrier(xbar); } } while (0)
    if (IN(0)) for (int rp_ = 0; rp_ < REPS(0); ++rp_) { if (rp_) xcd_barrier(xbar);
        const int gw = bx * NWAVES + wave, NGW = G * NWAVES;
        LAS float* scr = (LAS float*)(lds + wave * 16384);
        constexpr int I1 = (DM / 64) * (NP / 32), I2 = (DM / 64) * (DM / 32);
        for (int i = bx * (NWAVES * 64) + tid; i < NTOK * 24; i += G * NWAVES * 64) {
            const int tok = i / 24, j = i % 24; const float p = (float)a.pos[tok];
            const float l2t = 18.931568569324174f;
            float sn, cs;
            if (j < 16) { const float inv = exp2f(-(float)j * (1.0f / 16.0f) * l2t); sincosf(p * inv, &sn, &cs); R128[tok * 32 + j] = cs; R128[tok * 32 + 16 + j] = sn; }
            else { const int jj = j - 16; const float inv = exp2f(-(float)jj * (1.0f / 8.0f) * l2t); sincosf(p * inv, &sn, &cs); R64[tok * 16 + jj] = cs; R64[tok * 16 + 8 + jj] = sn; }
        }
        for (int it = gw; it < I1 + I2; it += NGW) {
            if (it < I1) transpose_item(a.w_in, DM, D_IN, NP, WT1, scr, it, lane);
            else transpose_item(a.w_out, DM, DM, DM, WT2, scr, it - I1, lane);
        }
        for (int m = gw; m < NTOK; m += 2 * NGW) { const int m1 = (m + NGW < NTOK) ? m + NGW : m;
            rmsnorm_2rows_bf16(a.x + (size_t)m * DM, a.x + (size_t)m1 * DM, a.norm_g, HN + (size_t)m * DM, HN + (size_t)m1 * DM, lane); }
    }
    SEAM(0);
    if (IN(1)) for (int rp_ = 0; rp_ < REPS(1); ++rp_) { if (rp_) xcd_barrier(xbar);
        pg8::Gemm g{HN, WT1, NTOK, NP, DM}; pg8::StaticOrder S; S.init(NTOK, NP, G, bx);
        pg8::EpiProj E{PROJ, IW, R128, R64};
        pg8::gemm_phase<pg8::EpiProj, pg8::StaticOrder, true, true>(lds, g, S, E);
    }
    SEAM(1);
    if (IN(2)) for (int rp_ = 0; rp_ < REPS(2); ++rp_) { if (rp_) xcd_barrier(xbar);
        const int vcu = (G % 8 == 0) ? (bx % 8) * (G / 8) + bx / 8 : bx;
        for (int k = 0;; ++k) {
            const int sI = k * G + ((k & 1) ? (G - 1 - vcu) : vcu);
            if (sI >= NTOK / 8) break;
            idx::index_unit(lds, PROJ, IW, MASKW, sI & 3, 8 * (511 - (sI >> 2)));
            if (PROBE_REP == 22) idx::index_unit(lds, PROJ, IW, MASKW, sI & 3, 256);
        }
    }
    SEAM(2);
    if (IN(3)) for (int rp_ = 0; rp_ < REPS(30); ++rp_) { if (rp_) xcd_barrier(xbar);
        const int vcu = (G % 8 == 0) ? (bx % 8) * (G / 8) + bx / 8 : bx;
        for (int p = vcu; p < BATCH * SBH * 8; p += G) {
            const int bh = p >> 3, sI = p & 7, b = bh / SBH, h = bh % SBH;
            for (int k = 0; k < 2; ++k) att::sb_unit<true>(lds, PROJ, a.sb_g, MIXED, b, h, k == 0 ? 15 - sI : sI);
        }
    }
    if (IN(3)) for (int rp_ = 0; rp_ < REPS(31); ++rp_) { if (rp_) xcd_barrier(xbar);
        const int vcu = (G % 8 == 0) ? (bx % 8) * (G / 8) + bx / 8 : bx;
        for (int p = vcu; p < BATCH * DSH * 8; p += G) {
            const int bh = p >> 3, sI = p & 7, b = bh / DSH, h = bh % DSH;
            for (int k = 0; k < 2; ++k) att::dsa_unit(lds, PROJ, MASK, a.dsa_g, MIXED, b, h, k == 0 ? 15 - sI : sI);
        }
    }
    SEAM(3);
    if (IN(4)) for (int rp_ = 0; rp_ < REPS(4); ++rp_) { if (rp_) xcd_barrier(xbar);
        pg8::Gemm g{MIXED, WT2, NTOK, DM, DM}; pg8::StaticOrder S; S.init(NTOK, DM, G, bx);
        pg8::EpiOut E{a.x, YB, SSP};
        pg8::gemm_phase<pg8::EpiOut, pg8::StaticOrder, true, true>(lds, g, S, E);
    }
    SEAM(4);
    if (IN(5)) {
        const int gw = bx * NWAVES + wave, NGW = G * NWAVES;
        for (int m = gw; m < NTOK; m += NGW) {
            const float sp = (lane < 32) ? SSP[(size_t)m * 32 + lane] : 0.f;
            const float r = 1.0f / sqrtf(wave_sum(sp) * (1.0f / DM) + EPS);
            const u32x4* yr = (const u32x4*)(YB + (size_t)m * DM) + lane; const f32x4* gr = (const f32x4*)a.final_g + 2 * lane; f32x4* orow = (f32x4*)(a.out + (size_t)m * DM) + 2 * lane;
#pragma unroll
            for (int j = 0; j < 4; ++j) { const u32x4 v = yr[64 * j]; const f32x4 g0 = gr[128 * j], g1 = gr[128 * j + 1];
                orow[128 * j] = (f32x4){bf2f(v.x & 0xffffu) * r * g0.x, bf2f(v.x >> 16) * r * g0.y, bf2f(v.y & 0xffffu) * r * g0.z, bf2f(v.y >> 16) * r * g0.w};
                orow[128 * j + 1] = (f32x4){bf2f(v.z & 0xffffu) * r * g1.x, bf2f(v.z >> 16) * r * g1.y, bf2f(v.w & 0xffffu) * r * g1.z, bf2f(v.w >> 16) * r * g1.w}; }
        }
    }
#undef IN
#undef SEAM
}

extern "C" void kernel_launch(void* const* d_in, const int* in_sizes, int n_in, void* d_out, int out_size, void* d_ws, size_t ws_size, hipStream_t stream) {
    static int grid = 0;
    if (grid == 0) {
        if (n_in != 8 || in_sizes[0] != NTOK * DM || out_size != NTOK * DM || ws_size < WS_END) {
            fprintf(stderr, "kernel_launch: shape mismatch n_in %d in0 %d out %d ws %zu (need %zu)\n", n_in, n_in > 0 ? in_sizes[0] : -1, out_size, ws_size, (size_t)WS_END); grid = -1; return; }
        int dev = 0, cus = 0;
        if (hipGetDevice(&dev) != hipSuccess || hipDeviceGetAttribute(&cus, hipDeviceAttributeMultiprocessorCount, dev) != hipSuccess) { grid = -1; return; }
        if (hipFuncSetAttribute((const void*)mega, hipFuncAttributeMaxDynamicSharedMemorySize, LDS_BYTES) != hipSuccess) { fprintf(stderr, "kernel_launch: hipFuncSetAttribute failed\n"); grid = -1; return; }
        int per_cu = 0;
        if (hipOccupancyMaxActiveBlocksPerMultiprocessor(&per_cu, (const void*)mega, NWAVES * 64, LDS_BYTES) != hipSuccess || per_cu < 1) { fprintf(stderr, "kernel_launch: occupancy query says %d blocks per CU\n", per_cu); grid = -1; return; }
        grid = cus;
    }
    if (grid < 0) return;
    const float* x = (const float*)d_in[0]; const float* sb_g = (const float*)d_in[4]; const float* dsa_g = (const float*)d_in[5]; const float* final_g = (const float*)d_in[7];
    unsigned char* ws = (unsigned char*)d_ws; float* out = (float*)d_out;
    bf16_t* MIXED = (bf16_t*)(ws + WS_MIXED); bf16_t* WT2 = (bf16_t*)(ws + WS_WT2);
    float* IW = (float*)(ws + WS_IW);
    unsigned long long* MASK = (unsigned long long*)(ws + WS_MASK); bf16_t* PROJ = (bf16_t*)(ws + WS_PROJ);
    hipMemsetAsync(ws + WS_CTL, 0, 1 * MiB, stream);
    Args a{};
    a.x = x; a.pos = (const int*)d_in[1]; a.norm_g = (const float*)d_in[2]; a.w_in = (const float*)d_in[3]; a.sb_g = sb_g; a.dsa_g = dsa_g; a.w_out = (const float*)d_in[6]; a.final_g = final_g;
    a.out = out; a.ws = ws;
    a.ph_lo = 0; a.ph_hi = 6;
    void* kargs[] = {(void*)&a};
    const hipError_t le = hipLaunchCooperativeKernel((const void*)mega, dim3(grid), dim3(NWAVES * 64), kargs, LDS_BYTES, stream);
    if (le != hipSuccess) fprintf(stderr, "kernel_launch: cooperative launch failed: %s (grid %d)\n", hipGetErrorString(le), grid);
}
```

```cpp
#include <hip/hip_runtime.h>
#include <cstdio>
#include <cstdint>
#include <hip/hip_cooperative_groups.h>

constexpr int BATCH = 4, SEQ = 4096, DM = 2048, NTOK = BATCH * SEQ;
constexpr int HD = 128, SBH = 8, DSH = 8, DKV = 2, IH = 16, ID = 64, TOPK = 256;
constexpr int D_IN = 7760, NP = 7936;
constexpr size_t PHS = (size_t)NTOK * 128;
constexpr size_t IQF_OFF = 52 * PHS;
constexpr size_t IKC_OFF = 60 * PHS;
constexpr int C_SBQ = 0, C_SBK = 1024, C_SBV = 2048, C_SBG = 3072, C_DQ = 4096, C_DK = 5120, C_DV = 5376, C_DG = 5632, C_IQ = 6656, C_IK = 7680, C_IW = 7744;
constexpr float EPS = 1e-6f;
constexpr float C2 = 0.08838834764831845f * 1.4426950408889634f;
constexpr float IWS = 1.0f / 32.0f;

constexpr size_t MiB = 1u << 20;
constexpr size_t WS_CTL = 0;
constexpr size_t WS_HN = 1 * MiB;
constexpr size_t WS_MIXED = WS_HN;
constexpr size_t WS_WT1 = 65 * MiB;
constexpr size_t WS_WT2 = 96 * MiB;
constexpr size_t WS_IW = 104 * MiB;
constexpr size_t WS_R128 = 105 * MiB;
constexpr size_t WS_R64 = 107 * MiB;
constexpr size_t WS_MASK = 108 * MiB;
constexpr size_t WS_PROJ = 116 * MiB;
constexpr size_t WS_SSP = 366 * MiB;
constexpr size_t WS_END = 368 * MiB;

#define WAVE_SYNC() asm volatile("s_waitcnt lgkmcnt(0)" ::: "memory")
typedef unsigned short bf16_t;
typedef float f32x4 __attribute__((ext_vector_type(4)));
typedef unsigned u32x4 __attribute__((ext_vector_type(4)));
typedef unsigned u32x2 __attribute__((ext_vector_type(2)));

__device__ __forceinline__ unsigned f2bf(float f) { unsigned u = __builtin_bit_cast(unsigned, f); return (u + 0x7fffu + ((u >> 16) & 1u)) >> 16; }
__device__ __forceinline__ float bf2f(unsigned h) { return __builtin_bit_cast(float, h << 16); }
__device__ __forceinline__ unsigned pk2(float lo, float hi) { return f2bf(lo) | (f2bf(hi) << 16); }
__device__ __forceinline__ float wave_sum(float v) {
#pragma unroll
    for (int o = 1; o < 64; o <<= 1) v += __shfl_xor(v, o);
    return v;
}
__device__ __forceinline__ float wave_max(float v) {
#pragma unroll
    for (int o = 1; o < 64; o <<= 1) v = fmaxf(v, __shfl_xor(v, o));
    return v;
}

template <int CTRL> __device__ __forceinline__ float dppf(float v) { return __builtin_bit_cast(float, __builtin_amdgcn_update_dpp(0, __builtin_bit_cast(int, v), CTRL, 0xf, 0xf, true)); }
__device__ __forceinline__ float wave_max_dpp(float v) {
    v = fmaxf(v, dppf<0xB1>(v)); v = fmaxf(v, dppf<0x4E>(v)); v = fmaxf(v, dppf<0x141>(v)); v = fmaxf(v, dppf<0x140>(v));
    const int iv = __builtin_bit_cast(int, v);
    const float a = __builtin_bit_cast(float, __builtin_amdgcn_readlane(iv, 0)), b = __builtin_bit_cast(float, __builtin_amdgcn_readlane(iv, 16)), c = __builtin_bit_cast(float, __builtin_amdgcn_readlane(iv, 32)), d = __builtin_bit_cast(float, __builtin_amdgcn_readlane(iv, 48));
    return fmaxf(fmaxf(a, b), fmaxf(c, d));
}
__device__ __forceinline__ float wave_sum_dpp(float v) {
    v += dppf<0xB1>(v); v += dppf<0x4E>(v); v += dppf<0x141>(v); v += dppf<0x140>(v);
    const int iv = __builtin_bit_cast(int, v);
    const float a = __builtin_bit_cast(float, __builtin_amdgcn_readlane(iv, 0)), b = __builtin_bit_cast(float, __builtin_amdgcn_readlane(iv, 16)), c = __builtin_bit_cast(float, __builtin_amdgcn_readlane(iv, 32)), d = __builtin_bit_cast(float, __builtin_amdgcn_readlane(iv, 48));
    return (a + b) + (c + d);
}
__device__ __forceinline__ float wave_min_dpp(float v) { return -wave_max_dpp(-v); }
__device__ __forceinline__ float relu_i(float x) { return __builtin_bit_cast(float, max(__builtin_bit_cast(int, x), 0)); }
__device__ __forceinline__ float max3_asm(float a, float b, float c) { float r; asm("v_max3_f32 %0, %1, %2, %3" : "=v"(r) : "v"(a), "v"(b), "v"(c)); return r; }
__device__ __forceinline__ unsigned fkey(float f) { unsigned u = __builtin_bit_cast(unsigned, f); return (u & 0x80000000u) ? ~u : (u | 0x80000000u); }

namespace pg8 {
#define PG8_LAS __attribute__((address_space(3)))
typedef unsigned short bf16_t;
typedef short bf16x8 __attribute__((ext_vector_type(8)));
typedef float f32x4 __attribute__((ext_vector_type(4)));
typedef unsigned u32x4 __attribute__((ext_vector_type(4)));
constexpr int BM = 256, BK = 64, HALF = 128, HTB = HALF * BK * 2  , STAGE_BYTES = 8 * HTB, NXCD = 8, WGM = 8;

__host__ __device__ __forceinline__ int lds_byte(int r, int c) { const int st = (r >> 4) * 2 + (c >> 5), rr = r & 15, cc = c & 31, ob = rr * 64 + cc * 2; return st * 1024 + (ob ^ (((ob >> 9) & 1) << 5)); }
__host__ __device__ __forceinline__ void stage_rc(int b, int& R, int& C) { const int st = b / 1024, sb = b % 1024, swz = sb ^ (((sb >> 9) & 1) << 5); R = (st >> 1) * 16 + swz / 64; C = (st & 1) * 32 + (swz % 64) / 2; }
__host__ __device__ __forceinline__ int perm32(int rho) { const int n = rho >> 4, i = rho & 15; return 8 * (i >> 2) + 4 * n + (i & 3); }

struct Unit { int pm, pn; };
struct Gemm { const bf16_t* A; const bf16_t* Bt; int M, N, K; };

struct StaticOrder {
    int nM, nN, nwg, G, c;
    __host__ __device__ void init(int M, int N, int G_, int c_) { nM = M / BM; nN = N / BM; nwg = nM * nN; G = G_; c = c_; }
    __host__ __device__ __forceinline__ bool next(int i, Unit& u) const {
        const long L = (long)i * G + c; if (L >= nwg) return false;
        int wgid = (int)L; { const int q = nwg / NXCD, r = nwg % NXCD, xcd = wgid % NXCD, off = wgid / NXCD; wgid = (xcd < r ? xcd * (q + 1) : r * (q + 1) + (xcd - r) * q) + off; }
        const int nig = WGM * nN, gid = wgid / nig, fm = gid * WGM, gsz = (nM - fm) < WGM ? (nM - fm) : WGM;
        u.pm = fm + ((wgid % nig) % gsz); u.pn = (wgid % nig) / gsz; return true;
    }
    __device__ __forceinline__ void a_ready(const Unit&) const {}
    __device__ __forceinline__ void done(const Unit&) const {}
};
}

namespace pg8 {
__device__ __forceinline__ unsigned cvt_pk_bf16(float lo, float hi) { unsigned r; asm volatile("v_cvt_pk_bf16_f32 %0, %1, %2" : "=v"(r) : "v"(lo), "v"(hi)); return r; }
struct EpiProj {
    static constexpr bool PERM = true, AFTER_DRAIN = false;
    bf16_t* proj; float* iw; const float* r128; const float* r64;
    __device__ __forceinline__ void operator()(const f32x4 (&acc)[2][2][4][2], const Unit& u, int wr, int wc, int fr, int fq) const {
        const int pn = u.pn;
        const int row0 = u.pm * BM + wr * 64 + fr, col0 = pn * BM + wc * 32 + 8 * fq;
        const bool rope128 = (pn >= 16 && pn <= 20) && wc == 0;
        const bool rope64 = ((pn >= 26 && pn <= 29) && (wc & 1) == 0) || (pn == 30 && wc == 0);
        const bool iwt = (pn == 30 && wc == 2);
        const float sc = (pn < 4 || (pn >= 16 && pn < 20)) ? C2 : 1.f;
#pragma unroll
        for (int ai = 0; ai < 2; ++ai)
#pragma unroll
            for (int m = 0; m < 4; ++m) {
                const int row = row0 + ai * HALF + m * 16;
                f32x4 cs0 = {1.f, 1.f, 1.f, 1.f}, cs1 = cs0, sn0 = {0.f, 0.f, 0.f, 0.f}, sn1 = sn0;
                if (rope128) { const float* t = r128 + (size_t)row * 32 + 8 * (fq & 1); cs0 = *(const f32x4*)t; cs1 = *(const f32x4*)(t + 4); sn0 = *(const f32x4*)(t + 16); sn1 = *(const f32x4*)(t + 20);
                    if (fq < 2) { sn0 = -sn0; sn1 = -sn1; } }
                if (rope64) { const float* t = r64 + (size_t)row * 16; cs0 = *(const f32x4*)t; cs1 = *(const f32x4*)(t + 4); sn0 = *(const f32x4*)(t + 8); sn1 = *(const f32x4*)(t + 12);
                    if (fq == 0) { sn0 = -sn0; sn1 = -sn1; } if (fq >= 2) { cs0 = (f32x4){1.f, 1.f, 1.f, 1.f}; cs1 = cs0; sn0 = (f32x4){0.f, 0.f, 0.f, 0.f}; sn1 = sn0; } }
#pragma unroll
                for (int bj = 0; bj < 2; ++bj) {
                    f32x4 v0 = acc[ai][bj][m][0] * sc, v1 = acc[ai][bj][m][1] * sc;
                    if (rope128 || (rope64 && (pn != 30 || bj == 0))) {
                        const int xm = rope128 ? 32 : 16;
                        f32x4 p0, p1;
#pragma unroll
                        for (int e = 0; e < 4; ++e) { p0[e] = __shfl_xor(v0[e], xm); p1[e] = __shfl_xor(v1[e], xm); }
                        v0 = v0 * cs0 + p0 * sn0; v1 = v1 * cs1 + p1 * sn1;
                    }
                    if (iwt && bj == 0 && fq < 2) { float* ip = iw + (size_t)row * 16 + 8 * fq; *(f32x4*)ip = v0 * IWS; *(f32x4*)(ip + 4) = v1 * IWS; }
                    u32x4 w; w.x = cvt_pk_bf16(v0[0], v0[1]); w.y = cvt_pk_bf16(v0[2], v0[3]); w.z = cvt_pk_bf16(v1[0], v1[1]); w.w = cvt_pk_bf16(v1[2], v1[3]);
                    if (pn < 26) *(u32x4*)(proj + (size_t)(2 * pn + bj) * PHS + (size_t)row * 128 + wc * 32 + 8 * fq) = w;
                    else if (pn < 30) {
                        const int c = (pn - 26) * 256 + 128 * bj + 32 * wc + 8 * fq, head = c >> 6, ks = (c >> 4) & 3, hi_ = (c >> 3) & 1;
                        const int rho = (head & 3) + 4 * (row & 1) + 8 * (head >> 2);
                        *(u32x4*)(proj + IQF_OFF + ((((size_t)(row >> 3) * 4 + ((row >> 1) & 3)) * 4 + ks) * 64 + hi_ * 32 + rho) * 8) = w;
                    } else if (bj == 0 && wc < 2) {
                        const int c = 32 * wc + 8 * fq, ks = c >> 4, hi_ = (c >> 3) & 1;
                        *(u32x4*)(proj + IKC_OFF + ((((size_t)(row >> 5)) * 4 + ks) * 64 + hi_ * 32 + (row & 31)) * 8) = w;
                    }
                }
            }
    }
};
}

namespace pg8 {
struct EpiOut {
    static constexpr bool PERM = true, AFTER_DRAIN = false;
    const float* x; bf16_t* yb; float* ssp;
    __device__ __forceinline__ void operator()(const f32x4 (&acc)[2][2][4][2], const Unit& u, int wr, int wc, int fr, int fq) const {
        const int row0 = u.pm * BM + wr * 64 + fr, col0 = u.pn * BM + wc * 32 + 8 * fq;
#pragma unroll
        for (int ai = 0; ai < 2; ++ai)
#pragma unroll
            for (int m = 0; m < 4; ++m) {
                const int row = row0 + ai * HALF + m * 16; const size_t off = (size_t)row * DM + col0; float s = 0.f;
#pragma unroll
                for (int bj = 0; bj < 2; ++bj) {
                    const f32x4 y0 = *(const f32x4*)(x + off + bj * HALF) + acc[ai][bj][m][0], y1 = *(const f32x4*)(x + off + bj * HALF + 4) + acc[ai][bj][m][1];
                    u32x4 w; w.x = cvt_pk_bf16(y0[0], y0[1]); w.y = cvt_pk_bf16(y0[2], y0[3]); w.z = cvt_pk_bf16(y1[0], y1[1]); w.w = cvt_pk_bf16(y1[2], y1[3]);
                    *(u32x4*)(yb + off + bj * HALF) = w;
                    s += (y0[0] * y0[0] + y0[1] * y0[1]) + (y0[2] * y0[2] + y0[3] * y0[3]) + (y1[0] * y1[0] + y1[1] * y1[1]) + (y1[2] * y1[2] + y1[3] * y1[3]);
                }
                s += __shfl_xor(s, 16); s += __shfl_xor(s, 32);
                if (fq == 0) ssp[(size_t)row * 32 + u.pn * 4 + wc] = s;
            }
    }
};
}
namespace pg8 {
template <class Epi, class Sched, bool ALIGN_EPI = false, bool SP2 = false>
__device__ __forceinline__ void gemm_phase(PG8_LAS unsigned char* lds, const Gemm g, const Sched& S, const Epi& E) {
    int tid_ = threadIdx.x; asm volatile("" : "+v"(tid_)); const int tid = tid_, wid = __builtin_amdgcn_readfirstlane(tid >> 6), lane = tid & 63, wr = wid >> 2, wc = wid & 3, fr = lane & 15, fq = lane >> 4;
    const int K = g.K, nt = K / BK;
    unsigned voffA[2], voffB[2];
#pragma unroll
    for (int i = 0; i < 2; ++i) { int R, C; stage_rc(tid * 16 + i * 8192, R, C); const int Rb = Epi::PERM ? ((R & ~31) + perm32(R & 31)) : R;
        voffA[i] = (unsigned)(R * K + C) * 2u; voffB[i] = (unsigned)(Rb * K + C) * 2u; }
    const size_t kstep = (size_t)(BK * 2);
    const size_t hstep = (size_t)HALF * K * 2;
    const size_t tstep = 2 * hstep;
    const unsigned ldsw = (unsigned)wid * 1024u;
    const int aoff = lds_byte(wr * 64 + fr, fq * 8), boff = lds_byte(wc * 32 + fr, fq * 8);
#define PG8_SA(b, h) (((b) * 2 + (h)) * HTB)
#define PG8_SB(b, h) ((4 + (b) * 2 + (h)) * HTB)
#define PG8_STAGE(bufoff, gbase, voff) do { _Pragma("unroll") for (int _i = 0; _i < 2; ++_i) \
        __builtin_amdgcn_global_load_lds((const unsigned*)((const char*)(gbase) + (voff)[_i]), (PG8_LAS unsigned*)(lds + (bufoff) + ldsw + _i * 8192), 16, 0, 0); } while (0)
#define PG8_LDA(dst, b, h) do { _Pragma("unroll") for (int m = 0; m < 4; ++m) _Pragma("unroll") for (int k = 0; k < 2; ++k) dst[m][k] = *(const PG8_LAS bf16x8*)(lds + PG8_SA(b, h) + aoff + m * 2048 + k * 1024); } while (0)
#define PG8_LDB(dst, b, h) do { _Pragma("unroll") for (int n = 0; n < 2; ++n) _Pragma("unroll") for (int k = 0; k < 2; ++k) dst[n][k] = *(const PG8_LAS bf16x8*)(lds + PG8_SB(b, h) + boff + n * 2048 + k * 1024); } while (0)
#define PG8_MMA(ai, bj, At, Bt) do { __builtin_amdgcn_s_setprio(1); _Pragma("unroll") for (int m = 0; m < 4; ++m) _Pragma("unroll") for (int n = 0; n < 2; ++n) _Pragma("unroll") for (int k = 0; k < 2; ++k) \
        acc[ai][bj][m][n] = __builtin_amdgcn_mfma_f32_16x16x32_bf16(Bt[n][k], At[m][k], acc[ai][bj][m][n], 0, 0, 0); __builtin_amdgcn_s_setprio(0); } while (0)
#define PG8_WAIT_V(n) asm volatile("s_waitcnt vmcnt(" #n ")" ::: "memory")
#define PG8_WAIT_L(n) asm volatile("s_waitcnt lgkmcnt(" #n ")" ::: "memory")
#define PG8_BAR __builtin_amdgcn_s_barrier()
#define PG8_SCHED __builtin_amdgcn_sched_barrier(0)
    Unit cur, nxt; int ui = 0;
    if (!S.next(0, cur)) return;
    f32x4 acc[2][2][4][2];
#pragma unroll
    for (int a = 0; a < 2; ++a)
#pragma unroll
        for (int b = 0; b < 2; ++b)
#pragma unroll
            for (int m = 0; m < 4; ++m)
#pragma unroll
                for (int n = 0; n < 2; ++n) acc[a][b][m][n] = (f32x4){0.f, 0.f, 0.f, 0.f};
    bf16x8 At[4][2], B0[2][2], B1[2][2];
    const char* cA = (const char*)g.A + (size_t)cur.pm * tstep; const char* cB = (const char*)g.Bt + (size_t)cur.pn * tstep;
    S.a_ready(cur);
    if constexpr (SP2) {
        PG8_STAGE(PG8_SB(0, 0), cB, voffB); PG8_STAGE(PG8_SB(0, 1), cB + hstep, voffB); PG8_STAGE(PG8_SA(0, 0), cA, voffA); PG8_STAGE(PG8_SA(0, 1), cA + hstep, voffA);
        if (wr == 1) PG8_BAR;
        PG8_WAIT_V(2); PG8_BAR;
        PG8_STAGE(PG8_SB(1, 0), cB + kstep, voffB); PG8_STAGE(PG8_SA(1, 0), cA + kstep, voffA); PG8_STAGE(PG8_SB(1, 1), cB + hstep + kstep, voffB);
        PG8_WAIT_V(6); PG8_BAR;
    } else {
        PG8_STAGE(PG8_SB(0, 0), cB, voffB); PG8_STAGE(PG8_SA(0, 0), cA, voffA); PG8_STAGE(PG8_SB(0, 1), cB + hstep, voffB); PG8_STAGE(PG8_SA(0, 1), cA + hstep, voffA);
        if (wr == 1) PG8_BAR;
        PG8_WAIT_V(4); PG8_BAR;
        PG8_STAGE(PG8_SB(1, 0), cB + kstep, voffB); PG8_STAGE(PG8_SA(1, 0), cA + kstep, voffA); PG8_STAGE(PG8_SB(1, 1), cB + hstep + kstep, voffB);
        PG8_WAIT_V(6); PG8_BAR;
    }
    for (;;) {
        const bool has_next = S.next(ui + 1, nxt);
        const char* nA = has_next ? (const char*)g.A + (size_t)nxt.pm * tstep : cA; const char* nB = has_next ? (const char*)g.Bt + (size_t)nxt.pn * tstep : cB;
        for (int t = 0; t < nt; t += 2) {
            const bool last = (t == nt - 2);
            const char* a1 = cA + (size_t)(t + 1) * kstep;
            const char* a2 = last ? nA : cA + (size_t)(t + 2) * kstep; const char* b2 = last ? nB : cB + (size_t)(t + 2) * kstep;
            const char* a3 = a2 + kstep; const char* b3 = b2 + kstep;
            if (last && has_next) S.a_ready(nxt);
            if constexpr (SP2) {
            PG8_LDB(B0, 0, 0); PG8_LDB(B1, 0, 1); PG8_SCHED; PG8_LDA(At, 0, 0); PG8_STAGE(PG8_SA(1, 1), a1 + hstep, voffA);
            PG8_WAIT_V(8); PG8_WAIT_L(0); PG8_BAR; PG8_MMA(0, 0, At, B0); PG8_MMA(0, 1, At, B1); PG8_BAR; PG8_SCHED;
            PG8_LDA(At, 0, 1); PG8_STAGE(PG8_SB(0, 0), b2, voffB); PG8_STAGE(PG8_SB(0, 1), b2 + hstep, voffB); PG8_STAGE(PG8_SA(0, 0), a2, voffA);
            PG8_WAIT_V(8); PG8_WAIT_L(0); PG8_BAR; PG8_MMA(1, 0, At, B0); PG8_MMA(1, 1, At, B1); PG8_BAR; PG8_SCHED;
            PG8_LDB(B0, 1, 0); PG8_LDB(B1, 1, 1); PG8_SCHED; PG8_LDA(At, 1, 0); PG8_STAGE(PG8_SA(0, 1), a2 + hstep, voffA);
            PG8_WAIT_V(8); PG8_WAIT_L(0); PG8_BAR; PG8_MMA(0, 0, At, B0); PG8_MMA(0, 1, At, B1); PG8_BAR; PG8_SCHED;
            PG8_LDA(At, 1, 1); PG8_STAGE(PG8_SB(1, 0), b3, voffB); PG8_STAGE(PG8_SB(1, 1), b3 + hstep, voffB); PG8_STAGE(PG8_SA(1, 0), a3, voffA);
            PG8_WAIT_V(8); PG8_WAIT_L(0); PG8_BAR; PG8_MMA(1, 0, At, B0); PG8_MMA(1, 1, At, B1); PG8_BAR; PG8_SCHED;
            } else {
            PG8_LDB(B0, 0, 0); PG8_SCHED; PG8_LDA(At, 0, 0); PG8_STAGE(PG8_SA(1, 1), a1 + hstep, voffA);
            PG8_WAIT_L(8); PG8_BAR; PG8_WAIT_L(0); PG8_MMA(0, 0, At, B0); PG8_BAR; PG8_SCHED;
            PG8_LDB(B1, 0, 1); PG8_STAGE(PG8_SB(0, 0), b2, voffB);
            PG8_BAR; PG8_WAIT_L(0); PG8_MMA(0, 1, At, B1); PG8_BAR;
            PG8_LDA(At, 0, 1); PG8_STAGE(PG8_SA(0, 0), a2, voffA);
            PG8_BAR; PG8_WAIT_L(0); PG8_MMA(1, 0, At, B0); PG8_BAR; PG8_SCHED;
            PG8_STAGE(PG8_SB(0, 1), b2 + hstep, voffB);
            PG8_WAIT_V(6); PG8_BAR; PG8_MMA(1, 1, At, B1); PG8_BAR;
            PG8_LDB(B0, 1, 0); PG8_SCHED; PG8_LDA(At, 1, 0); PG8_STAGE(PG8_SA(0, 1), a2 + hstep, voffA);
            PG8_WAIT_L(8); PG8_BAR; PG8_WAIT_L(0); PG8_MMA(0, 0, At, B0); PG8_BAR; PG8_SCHED;
            PG8_LDB(B1, 1, 1); PG8_STAGE(PG8_SB(1, 0), b3, voffB);
            PG8_BAR; PG8_WAIT_L(0); PG8_MMA(0, 1, At, B1); PG8_BAR;
            PG8_LDA(At, 1, 1); PG8_STAGE(PG8_SA(1, 0), a3, voffA);
            PG8_BAR; PG8_WAIT_L(0); PG8_MMA(1, 0, At, B0); PG8_BAR; PG8_SCHED;
            PG8_STAGE(PG8_SB(1, 1), b3 + hstep, voffB);
            PG8_WAIT_V(6); PG8_BAR; PG8_MMA(1, 1, At, B1); PG8_BAR;
            }
        }
        if constexpr (ALIGN_EPI) { if (wr == 0) PG8_BAR; }
        if constexpr (!Epi::AFTER_DRAIN) { E(acc, cur, wr, wc, fr, fq); S.done(cur); }
        if (!has_next) break;
#pragma unroll
        for (int a = 0; a < 2; ++a)
#pragma unroll
            for (int b = 0; b < 2; ++b)
#pragma unroll
                for (int m = 0; m < 4; ++m)
#pragma unroll
                    for (int n = 0; n < 2; ++n) acc[a][b][m][n] = (f32x4){0.f, 0.f, 0.f, 0.f};
        cur = nxt; cA = nA; cB = nB; ++ui;
        if constexpr (ALIGN_EPI) { if (wr == 1) PG8_BAR; }
    }
    PG8_WAIT_V(0);
    if constexpr (!ALIGN_EPI) { if (wr == 0) PG8_BAR; }
    PG8_BAR;
    if constexpr (Epi::AFTER_DRAIN) { E.fused(acc, cur, wr, wc, fr, fq, lds, wid, lane); S.done(cur); }
#undef PG8_SA
#undef PG8_SB
#undef PG8_STAGE
#undef PG8_LDA
#undef PG8_LDB
#undef PG8_MMA
#undef PG8_WAIT_V
#undef PG8_WAIT_L
#undef PG8_BAR
#undef PG8_SCHED
}
}

namespace att {
#define ALAS __attribute__((address_space(3)))
using bf16x8 = __attribute__((ext_vector_type(8))) short;
using s16x4  = __attribute__((ext_vector_type(4))) short;
using f32x16 = __attribute__((ext_vector_type(16))) float;
constexpr int KVBLK = 64, SHM_V = KVBLK * 128 * 2, SHM_K = KVBLK * 128 * 2;
constexpr int L_V = 0, L_K = 2 * SHM_V, L_FLAG = 2 * SHM_V + 2 * SHM_K;
#define KSWZ(row, colB) ((row) * 256 + ((colB) ^ (((row) & 7) << 4)))
#define SBAR() __builtin_amdgcn_sched_barrier(0)
__device__ __forceinline__ int crow(int r, int hi) { return (r & 3) + 8 * (r >> 2) + 4 * hi; }
__device__ __forceinline__ unsigned cvtpk(float lo, float hi) { unsigned r; asm volatile("v_cvt_pk_bf16_f32 %0, %1, %2" : "=v"(r) : "v"(lo), "v"(hi)); return r; }
__device__ __forceinline__ void qkt(f32x16& p0, f32x16& p1, const ALAS unsigned char* Ks, const bf16x8* qr, int r32, int hi) {
    p0 = f32x16{}; p1 = f32x16{};
#pragma unroll
    for (int d0 = 0; d0 < 8; ++d0) { const int cb = (d0 * 16 + hi * 8) * 2;
        const bf16x8 b0 = *(const ALAS bf16x8*)(Ks + KSWZ(r32, cb));
        const bf16x8 b1 = *(const ALAS bf16x8*)(Ks + KSWZ(32 + r32, cb));
        p0 = __builtin_amdgcn_mfma_f32_32x32x16_bf16(b0, qr[d0], p0, 0, 0, 0);
        p1 = __builtin_amdgcn_mfma_f32_32x32x16_bf16(b1, qr[d0], p1, 0, 0, 0); }
}
__device__ __forceinline__ int v_st(int k, int c) { const int kk = (k & ~0xC) | ((k & 4) << 1) | ((k & 8) >> 1); return ((kk >> 3) * 4 + (c >> 5)) * 512 + ((kk & 7) * 32 + (c & 31)) * 2; }
__device__ __forceinline__ int v_rd_base(int lane) { return ((lane & 3) << 3) | (((lane >> 2) & 3) << 6) | (((lane >> 4) & 1) << 5) | (((lane >> 5) & 1) << 8); }
constexpr int v_rd_off(int d0, int ks, int half) { return d0 * 512 + ks * 4096 + half * 2048; }
template <int OFF> __device__ __forceinline__ s16x4 tr_read(int vb) { s16x4 r; asm volatile("ds_read_b64_tr_b16 %0, %1 offset:%2" : "=&v"(r) : "v"(vb), "i"(OFF) : "memory"); return r; }
template <int D0> __device__ __forceinline__ void pv_one(f32x16& od, int vb, bf16x8 pa0, bf16x8 pa1, bf16x8 pa2, bf16x8 pa3) {
    const s16x4 l0 = tr_read<v_rd_off(D0, 0, 0)>(vb), h0 = tr_read<v_rd_off(D0, 0, 1)>(vb), l1 = tr_read<v_rd_off(D0, 1, 0)>(vb), h1 = tr_read<v_rd_off(D0, 1, 1)>(vb);
    const s16x4 l2 = tr_read<v_rd_off(D0, 2, 0)>(vb), h2 = tr_read<v_rd_off(D0, 2, 1)>(vb), l3 = tr_read<v_rd_off(D0, 3, 0)>(vb), h3 = tr_read<v_rd_off(D0, 3, 1)>(vb);
    asm volatile("s_waitcnt lgkmcnt(0)" ::: "memory"); SBAR();
#define PK(L, H) (bf16x8){L[0], L[1], L[2], L[3], H[0], H[1], H[2], H[3]}
    od = __builtin_amdgcn_mfma_f32_32x32x16_bf16(pa0, PK(l0, h0), od, 0, 0, 0);
    od = __builtin_amdgcn_mfma_f32_32x32x16_bf16(pa1, PK(l1, h1), od, 0, 0, 0);
    od = __builtin_amdgcn_mfma_f32_32x32x16_bf16(pa2, PK(l2, h2), od, 0, 0, 0);
    od = __builtin_amdgcn_mfma_f32_32x32x16_bf16(pa3, PK(l3, h3), od, 0, 0, 0);
#undef PK
}
__device__ __forceinline__ void pv_d0(f32x16* o, int vb, bf16x8 pa0, bf16x8 pa1, bf16x8 pa2, bf16x8 pa3) {
    pv_one<0>(o[0], vb, pa0, pa1, pa2, pa3); pv_one<1>(o[1], vb, pa0, pa1, pa2, pa3); pv_one<2>(o[2], vb, pa0, pa1, pa2, pa3); pv_one<3>(o[3], vb, pa0, pa1, pa2, pa3);
}
__device__ __forceinline__ void pack_p(const f32x16& p0, const f32x16& p1, bf16x8& pa0, bf16x8& pa1, bf16x8& pa2, bf16x8& pa3) {
#define PK4(P, BASE, OUT) do { unsigned a0 = cvtpk(P[BASE + 0], P[BASE + 1]), a1 = cvtpk(P[BASE + 2], P[BASE + 3]);   \
    unsigned b0 = cvtpk(P[BASE + 4], P[BASE + 5]), b1 = cvtpk(P[BASE + 6], P[BASE + 7]);                              \
    auto r0 = __builtin_amdgcn_permlane32_swap(a0, b0, false, false); auto r1 = __builtin_amdgcn_permlane32_swap(a1, b1, false, false); \
    u32x4 w = {r0[0], r1[0], r0[1], r1[1]}; OUT = *reinterpret_cast<bf16x8*>(&w); } while (0)
    PK4(p0, 0, pa0); PK4(p0, 8, pa1); PK4(p1, 0, pa2); PK4(p1, 8, pa3);
#undef PK4
}
__device__ __forceinline__ float sp2(float z2) { return relu_i(z2) + __builtin_amdgcn_logf(1.0f + __builtin_amdgcn_exp2f(-fabsf(z2))); }
__device__ __forceinline__ void sb_weights(f32x16& p0, f32x16& p1, float& R, int hi) {
    float nl[32];
#pragma unroll
    for (int i = 0; i < 16; ++i) { const float z = p0[i], s = sp2(z); nl[i] = s; p0[i] = z - s; }
#pragma unroll
    for (int i = 0; i < 16; ++i) { const float z = p1[i], s = sp2(z); nl[16 + i] = s; p1[i] = z - s; }
    float S[9]; S[8] = 0.f;
#pragma unroll
    for (int g = 7; g >= 0; --g) S[g] = S[g + 1] + ((nl[4 * g] + nl[4 * g + 1]) + (nl[4 * g + 2] + nl[4 * g + 3]));
    float tot; { auto rr = __builtin_amdgcn_permlane32_swap(__float_as_uint(S[0]), __float_as_uint(S[0]), false, false); tot = __uint_as_float(rr[0]) + __uint_as_float(rr[1]); }
#pragma unroll
    for (int g = 0; g < 8; ++g) {
        const float snd = hi ? S[g] : S[g + 1];
        auto rr = __builtin_amdgcn_permlane32_swap(__float_as_uint(snd), __float_as_uint(snd), false, false);
        const float rcv = hi ? __uint_as_float(rr[0]) : __uint_as_float(rr[1]);
        const float t3 = R - S[g + 1] - rcv, t2 = t3 - nl[4 * g + 3], t1 = t2 - nl[4 * g + 2], t0 = t1 - nl[4 * g + 1];
        if (g < 4) { p0[4 * g + 3] = __builtin_amdgcn_exp2f(p0[4 * g + 3] + t3); p0[4 * g + 2] = __builtin_amdgcn_exp2f(p0[4 * g + 2] + t2); p0[4 * g + 1] = __builtin_amdgcn_exp2f(p0[4 * g + 1] + t1); p0[4 * g] = __builtin_amdgcn_exp2f(p0[4 * g] + t0); }
        else { const int q = 4 * (g - 4); p1[q + 3] = __builtin_amdgcn_exp2f(p1[q + 3] + t3); p1[q + 2] = __builtin_amdgcn_exp2f(p1[q + 2] + t2); p1[q + 1] = __builtin_amdgcn_exp2f(p1[q + 1] + t1); p1[q] = __builtin_amdgcn_exp2f(p1[q] + t0); }
    }
    R -= tot;
}
constexpr int L_STG = 69632;
__device__ __forceinline__ void epi_rows(ALAS unsigned char* lds, const f32x16* o, const float* rn, const bf16_t* __restrict__ gate0, const float* __restrict__ gain, bf16_t* __restrict__ out0, int wid, int lane) {
    const int r32 = lane & 31, hi = lane >> 5;
    ALAS bf16_t* stg = (ALAS bf16_t*)(lds + L_STG + wid * 8192);
#pragma unroll
    for (int r = 0; r < 16; ++r)
#pragma unroll
        for (int d0 = 0; d0 < 4; ++d0) stg[crow(r, hi) * 128 + 32 * d0 + r32] = (bf16_t)cvtpk(o[d0][r] * rn[r], 0.f);
    asm volatile("s_waitcnt lgkmcnt(0)" ::: "memory");
    const int cc = lane & 15, rr0 = lane >> 4;
    const f32x4 g0 = *(const f32x4*)(gain + 8 * cc), g1 = *(const f32x4*)(gain + 8 * cc + 4);
    u32x4 gt[8];
#pragma unroll
    for (int i = 0; i < 8; ++i) gt[i] = *(const u32x4*)(gate0 + (size_t)(4 * i + rr0) * 128 + 8 * cc);
#pragma unroll
    for (int i = 0; i < 8; ++i) { const int row = 4 * i + rr0;
        const u32x4 v = *(const ALAS u32x4*)(stg + row * 128 + 8 * cc); const u32x4 g = gt[i];
        float y[8], q[8];
        y[0] = bf2f(v.x & 0xffffu); y[1] = bf2f(v.x >> 16); y[2] = bf2f(v.y & 0xffffu); y[3] = bf2f(v.y >> 16); y[4] = bf2f(v.z & 0xffffu); y[5] = bf2f(v.z >> 16); y[6] = bf2f(v.w & 0xffffu); y[7] = bf2f(v.w >> 16);
        q[0] = bf2f(g.x & 0xffffu); q[1] = bf2f(g.x >> 16); q[2] = bf2f(g.y & 0xffffu); q[3] = bf2f(g.y >> 16); q[4] = bf2f(g.z & 0xffffu); q[5] = bf2f(g.z >> 16); q[6] = bf2f(g.w & 0xffffu); q[7] = bf2f(g.w >> 16);
#pragma unroll
        for (int e = 0; e < 8; ++e) y[e] = y[e] * (e < 4 ? g0[e & 3] : g1[e & 3]) * (q[e] / (1.0f + __expf(-q[e])));
        u32x4 w; w.x = cvtpk(y[0], y[1]); w.y = cvtpk(y[2], y[3]); w.z = cvtpk(y[4], y[5]); w.w = cvtpk(y[6], y[7]);
        *(u32x4*)(out0 + (size_t)row * DM + 8 * cc) = w; }
    asm volatile("s_waitcnt lgkmcnt(0)" ::: "memory");
}
constexpr float SB_EXIT = -160.0f;
template <bool EARLY>
__device__ __forceinline__ void sb_unit(ALAS unsigned char* lds, const bf16_t* __restrict__ proj, const float* __restrict__ gain, bf16_t* __restrict__ mixed, int b, int h, int qb) {
    int tid_ = threadIdx.x; asm volatile("" : "+v"(tid_)); const int tid = tid_, wid = __builtin_amdgcn_readfirstlane(tid >> 6), lane = tid & 63, r32 = lane & 31, hi = lane >> 5;
    const size_t tok0 = (size_t)b * SEQ; const int q0 = qb * 256, tw0 = q0 + 32 * wid;
    const bf16_t* Kg = proj + (size_t)(8 + h) * PHS + tok0 * 128; const bf16_t* Vg = proj + (size_t)(16 + h) * PHS + tok0 * 128;
    bf16x8 qr[8];
    { const bf16_t* Qw = proj + (size_t)h * PHS + (tok0 + tw0 + r32) * 128 + hi * 8;
#pragma unroll
      for (int d0 = 0; d0 < 8; ++d0) qr[d0] = *(const bf16x8*)(Qw + d0 * 16); }
    const int sr = tid >> 4, sc = (tid & 15) * 8;
    const int vst0 = v_st(sr, sc), vst1 = v_st(32 + sr, sc), kst0 = KSWZ(sr, sc * 2), kst1 = KSWZ(32 + sr, sc * 2);
    const int vb0 = (int)(unsigned)(size_t)(lds + L_V) + v_rd_base(lane);
    ALAS unsigned* flags = (ALAS unsigned*)(lds + L_FLAG);
    bf16x8 ks0, ks1, vs0, vs1;
#define SLOAD(k0) do { const size_t o0 = (size_t)((k0) + sr) * 128 + sc, o1 = (size_t)((k0) + 32 + sr) * 128 + sc; \
    vs0 = *(const bf16x8*)(Vg + o0); vs1 = *(const bf16x8*)(Vg + o1); ks0 = *(const bf16x8*)(Kg + o0); ks1 = *(const bf16x8*)(Kg + o1); } while (0)
#define SWRITE(bf) do { *(ALAS bf16x8*)(lds + L_V + (bf) * SHM_V + vst0) = vs0; *(ALAS bf16x8*)(lds + L_V + (bf) * SHM_V + vst1) = vs1; \
    *(ALAS bf16x8*)(lds + L_K + (bf) * SHM_K + kst0) = ks0; *(ALAS bf16x8*)(lds + L_K + (bf) * SHM_K + kst1) = ks1; } while (0)
    const int jmax = 4 * qb + 3;
    SLOAD(jmax * KVBLK); SWRITE(0); __syncthreads();
    float R = 0.f; f32x16 o[4] = {};
    for (int it = 0, j = jmax;; ++it, --j) {
        const int cur = it & 1, key0 = j * KVBLK;
        const bool act = (key0 < tw0 + 31) && !(EARLY && __all(R < SB_EXIT));
        if (!act && j > 0) SLOAD((j - 1) * KVBLK);
        if (act) {
            f32x16 p0, p1;
            qkt(p0, p1, lds + L_K + cur * SHM_K, qr, r32, hi);
            if (key0 + 63 >= tw0) {
                const int lim = tw0 + r32 - key0 - 4 * hi;
#pragma unroll
                for (int i = 0; i < 16; ++i) { const int kk = 8 * (i >> 2) + (i & 3); if (kk >= lim) p0[i] = -INFINITY; if (kk + 32 >= lim) p1[i] = -INFINITY; }
            }
            sb_weights(p0, p1, R, hi);
            SBAR(); if (j > 0) SLOAD((j - 1) * KVBLK); SBAR();
            bf16x8 pa0, pa1, pa2, pa3;
            pack_p(p0, p1, pa0, pa1, pa2, pa3);
            pv_d0(o, vb0 + cur * SHM_V, pa0, pa1, pa2, pa3);
        }
        if (EARLY) { const bool dn = __all(R < SB_EXIT); if (lane == 0) flags[cur * 8 + wid] = dn ? 1u : 0u; }
        if (j > 0) SWRITE(cur ^ 1);
        __syncthreads();
        if (j == 0) break;
        if (EARLY) { const u32x4 f0 = *(const ALAS u32x4*)(flags + cur * 8), f1 = *(const ALAS u32x4*)(flags + cur * 8 + 4);
            if ((f0.x & f0.y & f0.z & f0.w & f1.x & f1.y & f1.z & f1.w) != 0u) break; }
    }
#undef SLOAD
#undef SWRITE
    float rn[16];
#pragma unroll
    for (int r = 0; r < 16; ++r) { float ss = (o[0][r] * o[0][r] + o[1][r] * o[1][r]) + (o[2][r] * o[2][r] + o[3][r] * o[3][r]);
#pragma unroll
        for (int x = 1; x < 32; x <<= 1) ss += __shfl_xor(ss, x);
        rn[r] = 1.0f / sqrtf(ss * (1.0f / HD) + EPS); }
    epi_rows(lds, o, rn, proj + (size_t)(24 + h) * PHS + (tok0 + tw0) * 128, gain + h * HD, mixed + (tok0 + tw0) * DM + h * HD, wid, lane);
}
constexpr int L_WS = L_FLAG + 64;
constexpr float DSA_THR = 11.5f;
__device__ __forceinline__ void dsa_partial(f32x16& p0, f32x16& p1, unsigned long long mw, int hi, float& m_reg, float& mn, float& alpha) {
    const int mlo = (int)((unsigned)mw >> (4 * hi)), mhi = (int)((unsigned)(mw >> 32) >> (4 * hi));
    const unsigned NINF = 0xff800000u;
#pragma unroll
    for (int i = 0; i < 16; ++i) { const int kk = 8 * (i >> 2) + (i & 3);
        const unsigned t0 = (unsigned)__builtin_amdgcn_sbfe(mlo, kk, 1), t1 = (unsigned)__builtin_amdgcn_sbfe(mhi, kk, 1);
        p0[i] = __uint_as_float((__float_as_uint(p0[i]) & t0) | (NINF & ~t0)); p1[i] = __uint_as_float((__float_as_uint(p1[i]) & t1) | (NINF & ~t1)); }
    float pmax, pmb;
    pmax = max3_asm(p0[0], p0[1], p0[2]); pmb = max3_asm(p1[0], p1[1], p1[2]);
#pragma unroll
    for (int r = 3; r < 15; r += 2) { pmax = max3_asm(pmax, p0[r], p0[r + 1]); pmb = max3_asm(pmb, p1[r], p1[r + 1]); }
    pmax = max3_asm(pmax, p0[15], p1[15]); pmax = max3_asm(pmax, pmb, pmb);
    { auto rr = __builtin_amdgcn_permlane32_swap(__float_as_uint(pmax), __float_as_uint(pmax), false, false); pmax = max3_asm(__uint_as_float(rr[0]), __uint_as_float(rr[1]), __uint_as_float(rr[1])); }
    if (__builtin_expect(__all(pmax - m_reg <= DSA_THR), 1)) { mn = m_reg; alpha = 1.f; }
    else { mn = fmaxf(m_reg, pmax); alpha = __builtin_amdgcn_exp2f(m_reg - mn); m_reg = mn; }
#pragma unroll
    for (int r = 0; r < 16; ++r) { p0[r] -= mn; p1[r] -= mn; }
#pragma unroll
    for (int r = 0; r < 16; ++r) p0[r] = __builtin_amdgcn_exp2f(p0[r]);
}
__device__ __forceinline__ void dsa_finish(f32x16& p0, f32x16& p1, float alpha, float& l_reg, bf16x8& pa0, bf16x8& pa1, bf16x8& pa2, bf16x8& pa3) {
#pragma unroll
    for (int r = 0; r < 16; ++r) p1[r] = __builtin_amdgcn_exp2f(p1[r]);
    float ps = 0.f;
#pragma unroll
    for (int r = 0; r < 16; ++r) ps += p0[r];
#pragma unroll
    for (int r = 0; r < 16; ++r) ps += p1[r];
    { auto rr = __builtin_amdgcn_permlane32_swap(__float_as_uint(ps), __float_as_uint(ps), false, false); ps = __uint_as_float(rr[0]) + __uint_as_float(rr[1]); }
    l_reg = l_reg * alpha + ps;
    pack_p(p0, p1, pa0, pa1, pa2, pa3);
}
__device__ __forceinline__ void dsa_unit(ALAS unsigned char* lds, const bf16_t* __restrict__ proj, const unsigned long long* __restrict__ mask, const float* __restrict__ gain,
                                         bf16_t* __restrict__ mixed, int b, int h, int qb) {
    int tid_ = threadIdx.x; asm volatile("" : "+v"(tid_)); const int tid = tid_, wid = __builtin_amdgcn_readfirstlane(tid >> 6), lane = tid & 63, r32 = lane & 31, hi = lane >> 5, g = h >> 2;
    const size_t tok0 = (size_t)b * SEQ; const int q0 = qb * 256, tw0 = q0 + 32 * wid;
    const bf16_t* Kg = proj + (size_t)(40 + g) * PHS + tok0 * 128; const bf16_t* Vg = proj + (size_t)(42 + g) * PHS + tok0 * 128;
    bf16x8 qr[8];
    { const bf16_t* Qw = proj + (size_t)(32 + h) * PHS + (tok0 + tw0 + r32) * 128 + hi * 8;
#pragma unroll
      for (int d0 = 0; d0 < 8; ++d0) qr[d0] = *(const bf16x8*)(Qw + d0 * 16); }
    const unsigned long long* mrow = mask + (tok0 + tw0 + r32) * 64;
    const int sr = tid >> 4, sc = (tid & 15) * 8;
    const int vst0 = v_st(sr, sc), vst1 = v_st(32 + sr, sc), kst0 = KSWZ(sr, sc * 2), kst1 = KSWZ(32 + sr, sc * 2);
    const int vb0 = (int)(unsigned)(size_t)(lds + L_V) + v_rd_base(lane);
    ALAS float* wsl = (ALAS float*)(lds + L_WS) + wid * 64;
    bf16x8 eV0, eV1, eK0, eK1, oV0, oV1, oK0, oK1;
#define SLOAD_E(k0) do { const size_t o0 = (size_t)((k0) + sr) * 128 + sc, o1 = (size_t)((k0) + 32 + sr) * 128 + sc; eV0 = *(const bf16x8*)(Vg + o0); eV1 = *(const bf16x8*)(Vg + o1); eK0 = *(const bf16x8*)(Kg + o0); eK1 = *(const bf16x8*)(Kg + o1); } while (0)
#define SLOAD_O(k0) do { const size_t o0 = (size_t)((k0) + sr) * 128 + sc, o1 = (size_t)((k0) + 32 + sr) * 128 + sc; oV0 = *(const bf16x8*)(Vg + o0); oV1 = *(const bf16x8*)(Vg + o1); oK0 = *(const bf16x8*)(Kg + o0); oK1 = *(const bf16x8*)(Kg + o1); } while (0)
#define SWRITE_E() do { *(ALAS bf16x8*)(lds + L_V + vst0) = eV0; *(ALAS bf16x8*)(lds + L_V + vst1) = eV1; *(ALAS bf16x8*)(lds + L_K + kst0) = eK0; *(ALAS bf16x8*)(lds + L_K + kst1) = eK1; } while (0)
#define SWRITE_O() do { *(ALAS bf16x8*)(lds + L_V + SHM_V + vst0) = oV0; *(ALAS bf16x8*)(lds + L_V + SHM_V + vst1) = oV1; *(ALAS bf16x8*)(lds + L_K + SHM_K + kst0) = oK0; *(ALAS bf16x8*)(lds + L_K + SHM_K + kst1) = oK1; } while (0)
#define SWAIT() asm volatile("s_waitcnt vmcnt(4)" ::: "memory")
#define RESC(a) do { if (__any((a) < 1.f)) { if (hi == 0) wsl[r32] = (a); asm volatile("s_waitcnt lgkmcnt(0)" ::: "memory"); \
    _Pragma("unroll") for (int r = 0; r < 16; ++r) { const float al_ = wsl[crow(r, hi)]; _Pragma("unroll") for (int d = 0; d < 4; ++d) o[d][r] *= al_; } } } while (0)
    const int NT = 4 * qb + 4;
    float m_reg = -1e30f, l_reg = 0.f; f32x16 o[4] = {};
    f32x16 pA0, pA1, pB0, pB1; float mnA, mnB, alA, alB; bf16x8 pa0, pa1, pa2, pa3;
    SLOAD_E(0); unsigned long long mwA = mrow[0], mwB; asm volatile("s_waitcnt vmcnt(0)" ::: "memory"); SWRITE_E(); __syncthreads();
    qkt(pA0, pA1, lds + L_K, qr, r32, hi); dsa_partial(pA0, pA1, mwA, hi, m_reg, mnA, alA);
    SLOAD_O(KVBLK); SLOAD_E(2 * KVBLK);
    SWAIT(); SWRITE_O(); __syncthreads();
    for (int j = 1; j + 1 < NT; j += 2) {
        mwB = mrow[j];
        SBAR(); qkt(pB0, pB1, lds + L_K + SHM_K, qr, r32, hi);
        dsa_finish(pA0, pA1, alA, l_reg, pa0, pa1, pa2, pa3); SBAR();
        SLOAD_O((j + 2) * KVBLK); SBAR();
        pv_d0(o, vb0, pa0, pa1, pa2, pa3); dsa_partial(pB0, pB1, mwB, hi, m_reg, mnB, alB);
        __syncthreads(); SWAIT(); SWRITE_E();
        RESC(alB); __syncthreads();
        mwA = mrow[j + 1];
        SBAR(); qkt(pA0, pA1, lds + L_K, qr, r32, hi);
        dsa_finish(pB0, pB1, alB, l_reg, pa0, pa1, pa2, pa3); SBAR();
        if (j + 3 < NT) SLOAD_E((j + 3) * KVBLK); SBAR();
        pv_d0(o, vb0 + SHM_V, pa0, pa1, pa2, pa3); dsa_partial(pA0, pA1, mwA, hi, m_reg, mnA, alA);
        __syncthreads(); SWAIT(); SWRITE_O();
        RESC(alA); __syncthreads();
    }
    mwB = mrow[NT - 1];
    SBAR(); qkt(pB0, pB1, lds + L_K + SHM_K, qr, r32, hi);
    dsa_finish(pA0, pA1, alA, l_reg, pa0, pa1, pa2, pa3); SBAR();
    pv_d0(o, vb0, pa0, pa1, pa2, pa3); dsa_partial(pB0, pB1, mwB, hi, m_reg, mnB, alB);
    RESC(alB);
    dsa_finish(pB0, pB1, alB, l_reg, pa0, pa1, pa2, pa3); SBAR();
    pv_d0(o, vb0 + SHM_V, pa0, pa1, pa2, pa3);
    __syncthreads();
#undef SLOAD_E
#undef SLOAD_O
#undef SWRITE_E
#undef SWRITE_O
#undef SWAIT
#undef RESC
    if (hi == 0) wsl[32 + r32] = l_reg; asm volatile("s_waitcnt lgkmcnt(0)" ::: "memory");
    float rn[16];
#pragma unroll
    for (int r = 0; r < 16; ++r) { const float il = 1.0f / wsl[32 + crow(r, hi)];
#pragma unroll
        for (int d = 0; d < 4; ++d) o[d][r] *= il;
        float ss = (o[0][r] * o[0][r] + o[1][r] * o[1][r]) + (o[2][r] * o[2][r] + o[3][r] * o[3][r]);
#pragma unroll
        for (int x = 1; x < 32; x <<= 1) ss += __shfl_xor(ss, x);
        rn[r] = 1.0f / sqrtf(ss * (1.0f / HD) + EPS); }
    epi_rows(lds, o, rn, proj + (size_t)(44 + h) * PHS + (tok0 + tw0) * 128, gain + h * HD, mixed + (tok0 + tw0) * DM + 1024 + h * HD, wid, lane);
    asm volatile("s_waitcnt lgkmcnt(0)" ::: "memory");
}
}

namespace idx {
#define ILAS __attribute__((address_space(3)))
using bf16x8 = __attribute__((ext_vector_type(8))) short;
using f32x16 = __attribute__((ext_vector_type(16))) float;
constexpr int L_SC = 0, L_HIST = 131072, L_CAND = 131072 + 8192, L_TCTR = 131072 + 16384, CAND_CAP = 256;
__device__ __forceinline__ int lbin(float v, float mn, float scale) { return (int)fminf(fmaxf((v - mn) * scale, 0.f), 255.f); }
__device__ __forceinline__ void index_unit(ILAS unsigned char* lds, const bf16_t* __restrict__ proj, const float* __restrict__ iw, unsigned long long* __restrict__ mask, int b, int t0, int uidx) {
    int tid_ = threadIdx.x; asm volatile("" : "+v"(tid_)); const int tid = tid_, wid = __builtin_amdgcn_readfirstlane(tid >> 6), lane = tid & 63, r = lane & 31, hi = lane >> 5;
    const size_t tok0 = (size_t)b * SEQ;
    ILAS unsigned* sc = (ILAS unsigned*)(lds + L_SC);
    ILAS unsigned* tctr = (ILAS unsigned*)(lds + L_TCTR);
    {
        bf16x8 af[4][4]; float wv[4][16];
#pragma unroll
        for (int T = 0; T < 4; ++T) {
            const bf16_t* qb = proj + IQF_OFF + ((((tok0 + t0) >> 3) * 4 + T) * 4 * 64 + lane) * 8;
#pragma unroll
            for (int ks = 0; ks < 4; ++ks) af[T][ks] = *(const bf16x8*)(qb + ks * 512);
            const float* wp = iw + (tok0 + t0 + 2 * T + hi) * 16;
#pragma unroll
            for (int i = 0; i < 4; ++i) { const f32x4 w4 = *(const f32x4*)(wp + 4 * i); wv[T][4 * i] = w4.x; wv[T][4 * i + 1] = w4.y; wv[T][4 * i + 2] = w4.z; wv[T][4 * i + 3] = w4.w; }
        }
        const int nt32 = 2 * ((t0 + 8 + 63) >> 6), nt32p = (nt32 + 15) & ~15;
        const bf16_t* kb = proj + IKC_OFF + (tok0 >> 5) * (4 * 64 * 8) + lane * 8;
        bf16x8 b0[4], b1[4], b2[4];
#define KLOAD(dst, j) do { _Pragma("unroll") for (int ks = 0; ks < 4; ++ks) dst[ks] = *(const bf16x8*)(kb + (size_t)(j) * (4 * 64 * 8) + ks * 512); } while (0)
#define CLAIM(dst) do { unsigned c_ = 0u; if (lane == 0) c_ = __hip_atomic_fetch_add(tctr + (uidx & 1), 1u, __ATOMIC_RELAXED, __HIP_MEMORY_SCOPE_WORKGROUP); dst = __builtin_amdgcn_readfirstlane((int)c_); } while (0)
        int j0, j1, j2;
        CLAIM(j0); CLAIM(j1);
        if (j0 < nt32) KLOAD(b0, j0);
        if (j1 < nt32) KLOAD(b1, j1);
        while (j0 < nt32p) {
            CLAIM(j2);
            if (j2 < nt32) KLOAD(b2, j2);
            const int key0 = 32 * j0;
            if (j0 < nt32) {
#pragma unroll
                for (int T = 0; T < 4; ++T) {
                    f32x16 acc = {};
#pragma unroll
                    for (int ks = 0; ks < 4; ++ks) acc = __builtin_amdgcn_mfma_f32_32x32x16_bf16(af[T][ks], b0[ks], acc, 0, 0, 0);
                    float sv = 0.f;
#pragma unroll
                    for (int rr = 0; rr < 16; ++rr) sv = fmaf(wv[T][rr], relu_i(acc[rr]), sv);
                    const int q = 2 * T + hi, key = key0 + r;
                    sc[q * SEQ + key] = (key <= t0 + q) ? __float_as_uint(sv) : 0xff800000u;
                }
            } else {
#pragma unroll
                for (int T = 0; T < 4; ++T) sc[(2 * T + hi) * SEQ + key0 + r] = 0xff800000u;
            }
#pragma unroll
            for (int ks = 0; ks < 4; ++ks) { b0[ks] = b1[ks]; b1[ks] = b2[ks]; }
            j0 = j1; j1 = j2;
        }
#undef KLOAD
#undef CLAIM
    }
    asm volatile("s_waitcnt lgkmcnt(0)" ::: "memory");
    __syncthreads();
    if (tid == 0) tctr[(uidx + 1) & 1] = 0u;
    const int t = t0 + wid, N = t + 1, NE = (N + 63) >> 6, NE8 = (NE + 7) & ~7;
    const ILAS unsigned* myrow = sc + wid * SEQ + lane;
    float v[64];
#pragma unroll
    for (int c = 0; c < 8; ++c) {
        if (8 * c < NE8) {
#pragma unroll
            for (int i = 0; i < 8; ++i) v[8 * c + i] = __uint_as_float(myrow[64 * (8 * c + i)]);
        } else {
#pragma unroll
            for (int i = 0; i < 8; ++i) v[8 * c + i] = -INFINITY;
        }
    }
    asm volatile("s_waitcnt lgkmcnt(0)" ::: "memory");
    __syncthreads();
    unsigned long long myw = 0ull;
    if (N <= TOPK) {
        for (int e = 0; e < NE; ++e) { const unsigned long long bm = __ballot(64 * e + lane <= t); if (lane == e) myw = bm; }
    } else {
        ILAS unsigned* hist = (ILAS unsigned*)(lds + L_HIST) + wid * 256;
        ILAS unsigned* cand = (ILAS unsigned*)(lds + L_CAND) + wid * CAND_CAP;
        float mx = -INFINITY, mn = INFINITY;
#pragma unroll
        for (int c = 0; c < 8; ++c) if (8 * c < NE8) {
            if (64 * (8 * c + 8) <= N) {
#pragma unroll
                for (int i = 0; i < 8; ++i) { mx = fmaxf(mx, v[8 * c + i]); mn = fminf(mn, v[8 * c + i]); }
            } else {
#pragma unroll
                for (int i = 0; i < 8; ++i) { mx = fmaxf(mx, v[8 * c + i]); mn = fminf(mn, (64 * (8 * c + i) + lane <= t) ? v[8 * c + i] : INFINITY); }
            }
        }
        mx = wave_max_dpp(mx); mn = wave_min_dpp(mn);
        const float scale = (mx > mn) ? 256.0f / (mx - mn) : 0.f;
        *(ILAS u32x4*)(hist + 4 * lane) = (u32x4){0u, 0u, 0u, 0u};
        asm volatile("s_waitcnt lgkmcnt(0)" ::: "memory");
#pragma unroll
        for (int c = 0; c < 8; ++c) if (8 * c < NE8) {
#pragma unroll
            for (int i = 0; i < 8; ++i) __hip_atomic_fetch_add(hist + lbin(v[8 * c + i], mn, scale), 1u, __ATOMIC_RELAXED, __HIP_MEMORY_SCOPE_WORKGROUP);
        }
        asm volatile("s_waitcnt lgkmcnt(0)" ::: "memory");
        int bstar, need; unsigned cb;
        {
            const u32x4 c4 = *(const ILAS u32x4*)(hist + 4 * lane);
            const unsigned s4 = (c4.x + c4.y) + (c4.z + c4.w);
            unsigned sl = s4;
#pragma unroll
            for (int off = 1; off < 64; off <<= 1) { const unsigned tt = __shfl_down(sl, off); if (lane + off < 64) sl += tt; }
            const unsigned long long bal = __ballot(sl >= (unsigned)TOPK);
            const int ls = 63 - __clzll((long long)bal);
            const unsigned above = (unsigned)__builtin_amdgcn_readlane((int)sl, ls) - (unsigned)__builtin_amdgcn_readlane((int)s4, ls);
            const unsigned cx = (unsigned)__builtin_amdgcn_readlane((int)c4.x, ls), cy = (unsigned)__builtin_amdgcn_readlane((int)c4.y, ls);
            const unsigned cz = (unsigned)__builtin_amdgcn_readlane((int)c4.z, ls), cw = (unsigned)__builtin_amdgcn_readlane((int)c4.w, ls);
            unsigned ab = above; int d;
            if (ab + cw >= (unsigned)TOPK) { d = 3; cb = cw; } else { ab += cw;
                if (ab + cz >= (unsigned)TOPK) { d = 2; cb = cz; } else { ab += cz;
                    if (ab + cy >= (unsigned)TOPK) { d = 1; cb = cy; } else { ab += cy; d = 0; cb = cx; } } }
            bstar = 4 * ls + d; need = TOPK - (int)ab;
        }
        unsigned tau; int req;
        if (cb <= (unsigned)CAND_CAP) {
            int base = 0;
#pragma unroll
            for (int c = 0; c < 8; ++c) if (8 * c < NE8) {
#pragma unroll
                for (int i = 0; i < 8; ++i) { const float vv = v[8 * c + i]; const bool in = lbin(vv, mn, scale) == bstar; const unsigned long long m = __ballot(in);
                    if (m != 0ull) { if (in) cand[base + __builtin_amdgcn_mbcnt_hi((unsigned)(m >> 32), __builtin_amdgcn_mbcnt_lo((unsigned)m, 0u))] = fkey(vv); base += __popcll(m); } }
            }
            asm volatile("s_waitcnt lgkmcnt(0)" ::: "memory");
            unsigned k0 = 0u, k1 = 0u, k2 = 0u, k3 = 0u; int c0 = 0, c1 = 0, c2 = 0, c3 = 0;
            const int ncb = (int)cb;
            if (lane < ncb) k0 = cand[lane]; if (64 + lane < ncb) k1 = cand[64 + lane]; if (128 + lane < ncb) k2 = cand[128 + lane]; if (192 + lane < ncb) k3 = cand[192 + lane];
            asm volatile("s_waitcnt lgkmcnt(0)" ::: "memory");
#define RANK_FROM(KV, OFS) do { const int nj_ = min(64, ncb - (OFS)); for (int jj = 0; jj < nj_; ++jj) { const unsigned kj = (unsigned)__builtin_amdgcn_readlane((int)(KV), jj); const int j = (OFS) + jj; \
                c0 += (kj > k0 || (kj == k0 && j < lane)) ? 1 : 0; \
                if (ncb > 64) { c1 += (kj > k1 || (kj == k1 && j < 64 + lane)) ? 1 : 0; c2 += (kj > k2 || (kj == k2 && j < 128 + lane)) ? 1 : 0; c3 += (kj > k3 || (kj == k3 && j < 192 + lane)) ? 1 : 0; } } } while (0)
            RANK_FROM(k0, 0); if (ncb > 64) RANK_FROM(k1, 64); if (ncb > 128) RANK_FROM(k2, 128); if (ncb > 192) RANK_FROM(k3, 192);
#undef RANK_FROM
            const unsigned long long h0 = __ballot(lane < ncb && c0 == need - 1), h1 = __ballot(64 + lane < ncb && c1 == need - 1), h2 = __ballot(128 + lane < ncb && c2 == need - 1), h3 = __ballot(192 + lane < ncb && c3 == need - 1);
            if (h0) tau = (unsigned)__builtin_amdgcn_readlane((int)k0, __builtin_ctzll(h0)); else if (h1) tau = (unsigned)__builtin_amdgcn_readlane((int)k1, __builtin_ctzll(h1));
            else if (h2) tau = (unsigned)__builtin_amdgcn_readlane((int)k2, __builtin_ctzll(h2)); else tau = (unsigned)__builtin_amdgcn_readlane((int)k3, __builtin_ctzll(h3));
            req = __popcll(__ballot(lane < ncb && c0 < need && k0 == tau)) + __popcll(__ballot(64 + lane < ncb && c1 < need && k1 == tau))
                + __popcll(__ballot(128 + lane < ncb && c2 < need && k2 == tau)) + __popcll(__ballot(192 + lane < ncb && c3 < need && k3 == tau));
        } else {
            unsigned pref = 0u; int krem = TOPK;
            for (int pass = 0; pass < 4; ++pass) {
                const int shift = 24 - 8 * pass;
                *(ILAS u32x4*)(hist + 4 * lane) = (u32x4){0u, 0u, 0u, 0u};
                asm volatile("s_waitcnt lgkmcnt(0)" ::: "memory");
#pragma unroll
                for (int c = 0; c < 8; ++c) if (8 * c < NE8) {
#pragma unroll
                    for (int i = 0; i < 8; ++i) { const unsigned k = fkey(v[8 * c + i]);
                        const bool mt = (pass == 0) ? true : ((k >> ((shift + 8) & 31)) == pref);
                        if (mt) __hip_atomic_fetch_add(hist + ((k >> shift) & 255u), 1u, __ATOMIC_RELAXED, __HIP_MEMORY_SCOPE_WORKGROUP); }
                }
                asm volatile("s_waitcnt lgkmcnt(0)" ::: "memory");
                const u32x4 c4 = *(const ILAS u32x4*)(hist + 4 * lane);
                const unsigned s4 = (c4.x + c4.y) + (c4.z + c4.w);
                unsigned sl = s4;
#pragma unroll
                for (int off = 1; off < 64; off <<= 1) { const unsigned tt = __shfl_down(sl, off); if (lane + off < 64) sl += tt; }
                const unsigned long long bal = __ballot(sl >= (unsigned)krem);
                const int ls = 63 - __clzll((long long)bal);
                const unsigned above = (unsigned)__builtin_amdgcn_readlane((int)sl, ls) - (unsigned)__builtin_amdgcn_readlane((int)s4, ls);
                const unsigned cx = (unsigned)__builtin_amdgcn_readlane((int)c4.x, ls), cy = (unsigned)__builtin_amdgcn_readlane((int)c4.y, ls);
                const unsigned cz = (unsigned)__builtin_amdgcn_readlane((int)c4.z, ls), cw = (unsigned)__builtin_amdgcn_readlane((int)c4.w, ls);
                unsigned ab = above; int d;
                if (ab + cw >= (unsigned)krem) d = 3; else { ab += cw;
                    if (ab + cz >= (unsigned)krem) d = 2; else { ab += cz;
                        if (ab + cy >= (unsigned)krem) d = 1; else { ab += cy; d = 0; } } }
                pref = (pref << 8) | (unsigned)(4 * ls + d); krem -= (int)ab;
            }
            tau = pref; req = krem;
        }
        int rleft = req; int wlo = 0, whi = 0;
        const float tauf = __uint_as_float((tau & 0x80000000u) ? (tau & 0x7fffffffu) : ~tau);
#pragma unroll
        for (int c = 0; c < 8; ++c) if (8 * c < NE8) {
#pragma unroll
            for (int i = 0; i < 8; ++i) { const float vv = v[8 * c + i];
                const unsigned long long gt = __ballot(vv > tauf); unsigned long long em = __ballot(vv == tauf), take = 0ull;
                if (em != 0ull) { const int cnt = __popcll(em);
                    if (cnt <= rleft) { take = em; rleft -= cnt; }
                    else { while (rleft > 0) { const unsigned long long bb = em & (~em + 1ull); take |= bb; em ^= bb; --rleft; } } }
                const unsigned long long bm = gt | take;
                if (lane == 8 * c + i) { wlo = (int)(unsigned)bm; whi = (int)(unsigned)(bm >> 32); }
            }
        }
        myw = ((unsigned long long)(unsigned)whi << 32) | (unsigned long long)(unsigned)wlo;
    }
    mask[(tok0 + t) * 64 + lane] = myw;
}
}

#define LAS __attribute__((address_space(3)))
#define RLX_AGENT __ATOMIC_RELAXED, __HIP_MEMORY_SCOPE_AGENT
#define XB_TMO      128
#define XB_XCNT(j)  (256  + 64 * (j))
#define XB_XSUB(j)  (1280 + 64 * (j))
#define XB_XGEN(j)  (2304 + 64 * (j))
#define XB_TOP      3328
#define XB_TOPGEN   3392
#define XCD_BAR_WORDS 3456
#define XB_SPIN_CAP (1u << 18)

__device__ __forceinline__ unsigned xb_ld(unsigned* p)              { return __hip_atomic_load(p, __ATOMIC_RELAXED, __HIP_MEMORY_SCOPE_AGENT); }
__device__ __forceinline__ unsigned xb_add(unsigned* p, unsigned v) { return __hip_atomic_fetch_add(p, v, __ATOMIC_RELAXED, __HIP_MEMORY_SCOPE_AGENT); }
__device__ __forceinline__ unsigned xb_xcc_id() { return (unsigned)__builtin_amdgcn_s_getreg((3 << 11) | 20) & 0xFu; }
#define XB_SPIN(cond, bar) do { unsigned _sp = 0; while (cond) { __builtin_amdgcn_s_sleep(1); \
    if ((++_sp & 255u) == 0u) { if (xb_ld(&(bar)[XB_TMO])) break; if (_sp > XB_SPIN_CAP) { atomicAdd(&(bar)[XB_TMO], 1u); break; } } } } while (0)

struct XcdBarrier {
    unsigned* bar; unsigned x;
    volatile LAS unsigned* st;
};

__device__ __forceinline__ XcdBarrier xcd_barrier_post(unsigned* bar, volatile LAS unsigned* st) {
    XcdBarrier b; b.bar = bar; b.x = xb_xcc_id(); b.st = st;
    if (threadIdx.x == 0) (void)xb_add(&bar[XB_XCNT(b.x)], 1u);
    return b;
}
__device__ __forceinline__ void xcd_barrier_complete(unsigned* bar, unsigned x, unsigned& nloc, unsigned& nx) {
    const unsigned G = gridDim.x * gridDim.y * gridDim.z;
    unsigned sum, cnt, mine, sp = 0u;
    for (;;) {
        sum = 0u; cnt = 0u; mine = 0u;
#pragma unroll
        for (unsigned j = 0; j < 16; ++j) { const unsigned c = xb_ld(&bar[XB_XCNT(j)]); sum += c; cnt += (c > 0u) ? 1u : 0u; mine = (j == x) ? c : mine; }
        if (sum == G) break;
        __builtin_amdgcn_s_sleep(1);
        if ((++sp & 255u) == 0u) { if (xb_ld(&bar[XB_TMO])) break; if (sp > XB_SPIN_CAP) { atomicAdd(&bar[XB_TMO], 1u); break; } }
    }
    nloc = mine > 0u ? mine : 1u; nx = cnt > 0u ? cnt : 1u;
}

__device__ __forceinline__ void xcd_barrier(const XcdBarrier& b) {
    asm volatile("s_waitcnt vmcnt(0)" ::: "memory");
    __syncthreads();
    if (threadIdx.x == 0) {
        unsigned* bar = b.bar;
        __builtin_amdgcn_s_waitcnt(0);
        unsigned nloc = b.st[0], nx = b.st[1];
        if (nloc == 0u) { xcd_barrier_complete(bar, b.x, nloc, nx); b.st[0] = nloc; b.st[1] = nx; }
        const unsigned old = xb_add(&bar[XB_XSUB(b.x)], 1u);
        const unsigned gen = old / nloc;
        if (old + 1u == (gen + 1u) * nloc) {
            __builtin_amdgcn_fence(__ATOMIC_RELEASE, "agent");
            asm volatile("s_waitcnt vmcnt(0)" ::: "memory");
            const unsigned og = xb_add(&bar[XB_TOP], 1u);
            const unsigned tg = og / nx;
            if (og + 1u == (tg + 1u) * nx) xb_add(&bar[XB_TOPGEN], 1u);
            else XB_SPIN(xb_ld(&bar[XB_TOPGEN]) == tg, bar);
            __builtin_amdgcn_fence(__ATOMIC_ACQUIRE, "agent");
            xb_add(&bar[XB_XGEN(b.x)], 1u);
            asm volatile("s_waitcnt vmcnt(0)" ::: "memory");
        } else {
            XB_SPIN(xb_ld(&bar[XB_XGEN(b.x)]) == gen, bar);
            __builtin_amdgcn_fence(__ATOMIC_ACQUIRE, "agent");
            asm volatile("s_waitcnt vmcnt(0)" ::: "memory");
        }
    }
    __syncthreads();
}

#define GAS __attribute__((address_space(1)))
#define LDS_WAIT() asm volatile("s_waitcnt lgkmcnt(0)" ::: "memory")
constexpr int NWAVES = 8, LDS_BYTES = 149504;

struct Args { const float* x; const int* pos; const float* norm_g; const float* w_in; const float* sb_g; const float* dsa_g; const float* w_out; const float* final_g; float* out; unsigned char* ws; int ph_lo, ph_hi; };

__device__ __forceinline__ void transpose_item(const float* __restrict__ W, int K, int N, int NPAD, bf16_t* __restrict__ WT, LAS float* scr, int item, int lane) {
    const int nblk = NPAD / 32, kb = item / nblk, nb = item % nblk, k0 = 64 * kb, n0 = 32 * nb;
    const int n = n0 + (lane & 31); const bool ok = n < N;
    float tv[32];
#pragma unroll
    for (int i = 0; i < 32; ++i) tv[i] = ok ? W[(size_t)(k0 + 2 * i + (lane >> 5)) * N + n] : 0.f;
#pragma unroll
    for (int i = 0; i < 32; ++i) scr[(2 * i + (lane >> 5)) * 33 + (lane & 31)] = tv[i];
    LDS_WAIT();
    const int c = lane & 7;
#pragma unroll
    for (int j = 0; j < 4; ++j) { const int nn = (lane >> 3) + 8 * j; const LAS float* s = scr + (8 * c) * 33 + nn;
        u32x4 o; o.x = pk2(s[0 * 33], s[1 * 33]); o.y = pk2(s[2 * 33], s[3 * 33]); o.z = pk2(s[4 * 33], s[5 * 33]); o.w = pk2(s[6 * 33], s[7 * 33]);
        *(u32x4*)(WT + (size_t)(n0 + nn) * K + k0 + 8 * c) = o; }
    LDS_WAIT();
}
__device__ __forceinline__ void rmsnorm_4rows_bf16(const float* __restrict__ x, const float* __restrict__ g, bf16_t* __restrict__ hn, int m0, int mstep, int lane) {
    f32x4 v[4][8]; float ss[4];
#pragma unroll
    for (int q = 0; q < 4; ++q) { const int m = min(m0 + q * mstep, NTOK - 1); const f32x4* xr = (const f32x4*)(x + (size_t)m * DM) + lane;
#pragma unroll
        for (int j = 0; j < 8; ++j) v[q][j] = xr[64 * j]; }
#pragma unroll
    for (int q = 0; q < 4; ++q) { float s = 0.f;
#pragma unroll
        for (int j = 0; j < 8; ++j) s += (v[q][j].x * v[q][j].x + v[q][j].y * v[q][j].y) + (v[q][j].z * v[q][j].z + v[q][j].w * v[q][j].w);
        ss[q] = 1.0f / sqrtf(wave_sum_dpp(s) * (1.0f / DM) + EPS); }
    const f32x4* gr = (const f32x4*)g + lane;
#pragma unroll
    for (int j = 0; j < 8; ++j) { const f32x4 gg = gr[64 * j];
#pragma unroll
        for (int q = 0; q < 4; ++q) { const int m = m0 + q * mstep; if (m < NTOK) { const float r = ss[q]; u32x2 w;
            w.x = pk2(v[q][j].x * r * gg.x, v[q][j].y * r * gg.y); w.y = pk2(v[q][j].z * r * gg.z, v[q][j].w * r * gg.w);
            ((u32x2*)(hn + (size_t)m * DM) + lane)[64 * j] = w; } } }
}

__global__ void __launch_bounds__(NWAVES * 64, 2) mega(Args a) {
    extern __shared__ __attribute__((aligned(16))) unsigned char lds_raw[];
    LAS unsigned char* lds = (LAS unsigned char*)lds_raw;
    int tid_ = threadIdx.x; asm volatile("" : "+v"(tid_)); const int tid = tid_, lane = tid & 63, wave = __builtin_amdgcn_readfirstlane(tid >> 6);
    const int G = gridDim.x, bx = blockIdx.x;
    unsigned char* ws = a.ws;
    bf16_t* HN = (bf16_t*)(ws + WS_HN); bf16_t* WT1 = (bf16_t*)(ws + WS_WT1); bf16_t* WT2 = (bf16_t*)(ws + WS_WT2);
    float* IW = (float*)(ws + WS_IW); float* R128 = (float*)(ws + WS_R128); float* R64 = (float*)(ws + WS_R64); bf16_t* PROJ = (bf16_t*)(ws + WS_PROJ);
    bf16_t* MIXED = (bf16_t*)(ws + WS_MIXED); bf16_t* YB = (bf16_t*)(ws + WS_PROJ); float* SSP = (float*)(ws + WS_SSP); unsigned long long* MASKW = (unsigned long long*)(ws + WS_MASK); const unsigned long long* MASK = MASKW;
    const int lo = a.ph_lo, hi = a.ph_hi;
#define IN(k) (lo <= (k) && (k) < hi)
    if (tid < 2) ((volatile LAS unsigned*)(lds + LDS_BYTES - 64))[tid] = 0u;
    __syncthreads();
    unsigned* const xbw = (unsigned*)(ws + WS_CTL) + 4096;
    if (bx == 0) for (int i = tid; i < XCD_BAR_WORDS; i += NWAVES * 64) __hip_atomic_store(xbw + i, 0u, __ATOMIC_RELAXED, __HIP_MEMORY_SCOPE_AGENT);
    XcdBarrier xbar; xbar.bar = xbw; xbar.x = 0u; xbar.st = (volatile LAS unsigned*)(lds + LDS_BYTES - 64);
#define SEAM(k) do { if (IN(k) && IN((k) + 1)) { if ((k) == 0) { cooperative_groups::this_grid().sync(); xbar = xcd_barrier_post(xbw, (volatile LAS unsigned*)(lds + LDS_BYTES - 64)); } else xcd_barrier(xbar); } } while (0)

    if (IN(0)) {
        const int gw = bx * NWAVES + wave, NGW = G * NWAVES;
        LAS float* scr = (LAS float*)(lds + wave * 16384);
        constexpr int I1 = (DM / 64) * (NP / 32), I2 = (DM / 64) * (DM / 32);
        {
            static const double IRV[16] = {0.15915494309189535, 0.070086521587798503, 0.03086376340470123, 0.013591370636193905, 0.0059851857127137054, 0.002635675898667414, 0.001160663641240061, 0.00051111750453754386,
                                           0.00022507907903927653, 9.9117309369019355e-05, 4.3647952792802891e-05, 1.9221100684944863e-05, 8.4643308082414014e-06, 3.7274086019153519e-06, 1.6414262627950345e-06, 7.2282930688328648e-07};
            for (int i = bx * (NWAVES * 64) + tid; i < NTOK * 24; i += G * NWAVES * 64) {
                const int tok = i / 24, j = i % 24; const double rev = (double)a.pos[tok] * IRV[j < 16 ? j : 2 * (j - 16)];
                const float rr = (float)(rev - floor(rev)); const float sn = __builtin_amdgcn_sinf(rr), cs = __builtin_amdgcn_cosf(rr);
                if (j < 16) { R128[tok * 32 + j] = cs; R128[tok * 32 + 16 + j] = sn; } else { R64[tok * 16 + (j - 16)] = cs; R64[tok * 16 + 8 + (j - 16)] = sn; }
            }
        }

        for (int it = gw; it < I1 + I2; it += NGW) {
            if (it < I1) transpose_item(a.w_in, DM, D_IN, NP, WT1, scr, it, lane);
            else transpose_item(a.w_out, DM, DM, DM, WT2, scr, it - I1, lane);
        }

        for (int m = gw; m < NTOK; m += 4 * NGW) rmsnorm_4rows_bf16(a.x, a.norm_g, HN, m, NGW, lane);

    }
    SEAM(0);
    if (IN(1)) {
        pg8::Gemm g{HN, WT1, NTOK, NP, DM}; pg8::StaticOrder S; S.init(NTOK, NP, G, bx);
        pg8::EpiProj E{PROJ, IW, R128, R64};
        pg8::gemm_phase<pg8::EpiProj, pg8::StaticOrder, true, true>(lds, g, S, E);
    }
    SEAM(1);
    if (IN(2)) {
        const int vcu = (G % 8 == 0) ? (bx % 8) * (G / 8) + bx / 8 : bx;
        if (tid < 2) ((LAS unsigned*)(lds + idx::L_TCTR))[tid] = 0u;
        __syncthreads();
        for (int k = 0;; ++k) {
            const int sI = k * G + ((k & 1) ? (G - 1 - vcu) : vcu);
            if (sI >= NTOK / 8) break;
            idx::index_unit(lds, PROJ, IW, MASKW, sI & 3, 8 * (511 - (sI >> 2)), k);
        }
        __syncthreads();
    }

    SEAM(2);
    if (IN(3)) {
        const int vcu = (G % 8 == 0) ? (bx % 8) * (G / 8) + bx / 8 : bx;
        for (int p = vcu; p < BATCH * SBH * 8; p += G) {
            const int bh = p >> 3, sI = p & 7, b = bh / SBH, h = bh % SBH;
            for (int k = 0; k < 2; ++k) att::sb_unit<true>(lds, PROJ, a.sb_g, MIXED, b, h, k == 0 ? 15 - sI : sI);
        }
    }

    if (IN(3)) {
        const int vcu = (G % 8 == 0) ? (bx % 8) * (G / 8) + bx / 8 : bx;
        for (int p = vcu; p < BATCH * DSH * 8; p += G) {
            const int bh = p >> 3, sI = p & 7, b = bh / DSH, h = bh % DSH;
            for (int k = 0; k < 2; ++k) att::dsa_unit(lds, PROJ, MASK, a.dsa_g, MIXED, b, h, k == 0 ? 15 - sI : sI);
        }
    }

    SEAM(3);
    if (IN(4)) {
        pg8::Gemm g{MIXED, WT2, NTOK, DM, DM}; pg8::StaticOrder S; S.init(NTOK, DM, G, bx);
        pg8::EpiOut E{a.x, YB, SSP};
        pg8::gemm_phase<pg8::EpiOut, pg8::StaticOrder, true, true>(lds, g, S, E);
    }
    SEAM(4);
    if (IN(5)) {
        const int gw = bx * NWAVES + wave, NGW = G * NWAVES;
        for (int m = gw; m < NTOK; m += NGW) {
            const float sp = (lane < 32) ? SSP[(size_t)m * 32 + lane] : 0.f;
            const float r = 1.0f / sqrtf(wave_sum(sp) * (1.0f / DM) + EPS);
            const u32x4* yr = (const u32x4*)(YB + (size_t)m * DM) + lane; const f32x4* gr = (const f32x4*)a.final_g + 2 * lane; f32x4* orow = (f32x4*)(a.out + (size_t)m * DM) + 2 * lane;
#pragma unroll
            for (int j = 0; j < 4; ++j) { const u32x4 v = yr[64 * j]; const f32x4 g0 = gr[128 * j], g1 = gr[128 * j + 1];
                orow[128 * j] = (f32x4){bf2f(v.x & 0xffffu) * r * g0.x, bf2f(v.x >> 16) * r * g0.y, bf2f(v.y & 0xffffu) * r * g0.z, bf2f(v.y >> 16) * r * g0.w};
                orow[128 * j + 1] = (f32x4){bf2f(v.z & 0xffffu) * r * g1.x, bf2f(v.z >> 16) * r * g1.y, bf2f(v.w & 0xffffu) * r * g1.z, bf2f(v.w >> 16) * r * g1.w}; }
        }
    }

#undef IN
#undef SEAM
}

extern "C" void kernel_launch(void* const* d_in, const int* in_sizes, int n_in, void* d_out, int out_size, void* d_ws, size_t ws_size, hipStream_t stream) {
    static int grid = 0;
    if (grid == 0) {
        if (n_in != 8 || in_sizes[0] != NTOK * DM || out_size != NTOK * DM || ws_size < WS_END) {
            fprintf(stderr, "kernel_launch: shape mismatch n_in %d in0 %d out %d ws %zu (need %zu)\n", n_in, n_in > 0 ? in_sizes[0] : -1, out_size, ws_size, (size_t)WS_END); grid = -1; return; }
        int dev = 0, cus = 0;
        if (hipGetDevice(&dev) != hipSuccess || hipDeviceGetAttribute(&cus, hipDeviceAttributeMultiprocessorCount, dev) != hipSuccess) { grid = -1; return; }
        if (hipFuncSetAttribute((const void*)mega, hipFuncAttributeMaxDynamicSharedMemorySize, LDS_BYTES) != hipSuccess) { fprintf(stderr, "kernel_launch: hipFuncSetAttribute failed\n"); grid = -1; return; }
        int per_cu = 0;
        if (hipOccupancyMaxActiveBlocksPerMultiprocessor(&per_cu, (const void*)mega, NWAVES * 64, LDS_BYTES) != hipSuccess || per_cu < 1) { fprintf(stderr, "kernel_launch: occupancy query says %d blocks per CU\n", per_cu); grid = -1; return; }
        grid = cus;
    }
    if (grid < 0) return;
    const float* x = (const float*)d_in[0]; const float* sb_g = (const float*)d_in[4]; const float* dsa_g = (const float*)d_in[5]; const float* final_g = (const float*)d_in[7];
    unsigned char* ws = (unsigned char*)d_ws; float* out = (float*)d_out;
    bf16_t* MIXED = (bf16_t*)(ws + WS_MIXED); bf16_t* WT2 = (bf16_t*)(ws + WS_WT2);
    float* IW = (float*)(ws + WS_IW);
    unsigned long long* MASK = (unsigned long long*)(ws + WS_MASK); bf16_t* PROJ = (bf16_t*)(ws + WS_PROJ);
    Args a{};
    a.x = x; a.pos = (const int*)d_in[1]; a.norm_g = (const float*)d_in[2]; a.w_in = (const float*)d_in[3]; a.sb_g = sb_g; a.dsa_g = dsa_g; a.w_out = (const float*)d_in[6]; a.final_g = final_g;
    a.out = out; a.ws = ws;
    a.ph_lo = 0; a.ph_hi = 6;
    void* kargs[] = {(void*)&a};
    const hipError_t le = hipLaunchCooperativeKernel((const void*)mega, dim3(grid), dim3(NWAVES * 64), kargs, LDS_BYTES, stream);
    if (le != hipSuccess) fprintf(stderr, "kernel_launch: cooperative launch failed: %s (grid %d)\n", hipGetErrorString(le), grid);
}
```

```cpp
#include <hip/hip_runtime.h>
#include <cstdio>
#include <cstdint>
#include <hip/hip_cooperative_groups.h>

constexpr int BATCH = 4, SEQ = 4096, DM = 2048, NTOK = BATCH * SEQ;
constexpr int HD = 128, SBH = 8, DSH = 8, DKV = 2, IH = 16, ID = 64, TOPK = 256;
constexpr int D_IN = 7760, NP = 7936;
constexpr size_t PHS = (size_t)NTOK * 128;
constexpr size_t IQF_OFF = 52 * PHS;
constexpr size_t IKC_OFF = 60 * PHS;
constexpr int C_SBQ = 0, C_SBK = 1024, C_SBV = 2048, C_SBG = 3072, C_DQ = 4096, C_DK = 5120, C_DV = 5376, C_DG = 5632, C_IQ = 6656, C_IK = 7680, C_IW = 7744;
constexpr float EPS = 1e-6f;
constexpr float C2 = 0.08838834764831845f * 1.4426950408889634f;
constexpr float IWS = 1.0f / 32.0f;

constexpr size_t MiB = 1u << 20;
constexpr size_t WS_CTL = 0;
constexpr size_t WS_HN = 1 * MiB;
constexpr size_t WS_MIXED = WS_HN;
constexpr size_t WS_WT1 = 65 * MiB;
constexpr size_t WS_WT2 = 96 * MiB;
constexpr size_t WS_IW = 104 * MiB;
constexpr size_t WS_R128 = 105 * MiB;
constexpr size_t WS_R64 = 107 * MiB;
constexpr size_t WS_MASK = 108 * MiB;
constexpr size_t WS_PROJ = 116 * MiB;
constexpr size_t WS_SSP = 366 * MiB;
constexpr size_t WS_END = 368 * MiB;

#define WAVE_SYNC() asm volatile("s_waitcnt lgkmcnt(0)" ::: "memory")
typedef unsigned short bf16_t;
typedef float f32x4 __attribute__((ext_vector_type(4)));
typedef unsigned u32x4 __attribute__((ext_vector_type(4)));
typedef unsigned u32x2 __attribute__((ext_vector_type(2)));

__device__ __forceinline__ unsigned f2bf(float f) { unsigned u = __builtin_bit_cast(unsigned, f); return (u + 0x7fffu + ((u >> 16) & 1u)) >> 16; }
__device__ __forceinline__ float bf2f(unsigned h) { return __builtin_bit_cast(float, h << 16); }
__device__ __forceinline__ unsigned pk2(float lo, float hi) { return f2bf(lo) | (f2bf(hi) << 16); }
__device__ __forceinline__ float wave_sum(float v) {
#pragma unroll
    for (int o = 1; o < 64; o <<= 1) v += __shfl_xor(v, o);
    return v;
}
__device__ __forceinline__ float wave_max(float v) {
#pragma unroll
    for (int o = 1; o < 64; o <<= 1) v = fmaxf(v, __shfl_xor(v, o));
    return v;
}

template <int CTRL> __device__ __forceinline__ float dppf(float v) { return __builtin_bit_cast(float, __builtin_amdgcn_update_dpp(0, __builtin_bit_cast(int, v), CTRL, 0xf, 0xf, true)); }
__device__ __forceinline__ float wave_max_dpp(float v) {
    v = fmaxf(v, dppf<0xB1>(v)); v = fmaxf(v, dppf<0x4E>(v)); v = fmaxf(v, dppf<0x141>(v)); v = fmaxf(v, dppf<0x140>(v));
    const int iv = __builtin_bit_cast(int, v);
    const float a = __builtin_bit_cast(float, __builtin_amdgcn_readlane(iv, 0)), b = __builtin_bit_cast(float, __builtin_amdgcn_readlane(iv, 16)), c = __builtin_bit_cast(float, __builtin_amdgcn_readlane(iv, 32)), d = __builtin_bit_cast(float, __builtin_amdgcn_readlane(iv, 48));
    return fmaxf(fmaxf(a, b), fmaxf(c, d));
}
__device__ __forceinline__ float wave_sum_dpp(float v) {
    v += dppf<0xB1>(v); v += dppf<0x4E>(v); v += dppf<0x141>(v); v += dppf<0x140>(v);
    const int iv = __builtin_bit_cast(int, v);
    const float a = __builtin_bit_cast(float, __builtin_amdgcn_readlane(iv, 0)), b = __builtin_bit_cast(float, __builtin_amdgcn_readlane(iv, 16)), c = __builtin_bit_cast(float, __builtin_amdgcn_readlane(iv, 32)), d = __builtin_bit_cast(float, __builtin_amdgcn_readlane(iv, 48));
    return (a + b) + (c + d);
}
__device__ __forceinline__ float wave_min_dpp(float v) { return -wave_max_dpp(-v); }
__device__ __forceinline__ float relu_i(float x) { return __builtin_bit_cast(float, max(__builtin_bit_cast(int, x), 0)); }
__device__ __forceinline__ float max3_asm(float a, float b, float c) { float r; asm("v_max3_f32 %0, %1, %2, %3" : "=v"(r) : "v"(a), "v"(b), "v"(c)); return r; }
__device__ __forceinline__ unsigned fkey(float f) { unsigned u = __builtin_bit_cast(unsigned, f); return (u & 0x80000000u) ? ~u : (u | 0x80000000u); }

namespace pg8 {
#define PG8_LAS __attribute__((address_space(3)))
typedef unsigned short bf16_t;
typedef short bf16x8 __attribute__((ext_vector_type(8)));
typedef float f32x4 __attribute__((ext_vector_type(4)));
typedef unsigned u32x4 __attribute__((ext_vector_type(4)));
constexpr int BM = 256, BK = 64, HALF = 128, HTB = HALF * BK * 2  , STAGE_BYTES = 8 * HTB, NXCD = 8, WGM = 8;

__host__ __device__ __forceinline__ int lds_byte(int r, int c) { const int st = (r >> 4) * 2 + (c >> 5), rr = r & 15, cc = c & 31, ob = rr * 64 + cc * 2; return st * 1024 + (ob ^ (((ob >> 9) & 1) << 5)); }
__host__ __device__ __forceinline__ void stage_rc(int b, int& R, int& C) { const int st = b / 1024, sb = b % 1024, swz = sb ^ (((sb >> 9) & 1) << 5); R = (st >> 1) * 16 + swz / 64; C = (st & 1) * 32 + (swz % 64) / 2; }
__host__ __device__ __forceinline__ int perm32(int rho) { const int n = rho >> 4, i = rho & 15; return 8 * (i >> 2) + 4 * n + (i & 3); }

struct Unit { int pm, pn; };
struct Gemm { const bf16_t* A; const bf16_t* Bt; int M, N, K; };

struct StaticOrder {
    int nM, nN, nwg, G, c;
    __host__ __device__ void init(int M, int N, int G_, int c_) { nM = M / BM; nN = N / BM; nwg = nM * nN; G = G_; c = c_; }
    __host__ __device__ __forceinline__ bool next(int i, Unit& u) const {
        const long L = (long)i * G + c; if (L >= nwg) return false;
        int wgid = (int)L; { const int q = nwg / NXCD, r = nwg % NXCD, xcd = wgid % NXCD, off = wgid / NXCD; wgid = (xcd < r ? xcd * (q + 1) : r * (q + 1) + (xcd - r) * q) + off; }
        const int nig = WGM * nN, gid = wgid / nig, fm = gid * WGM, gsz = (nM - fm) < WGM ? (nM - fm) : WGM;
        u.pm = fm + ((wgid % nig) % gsz); u.pn = (wgid % nig) / gsz; return true;
    }
    __device__ __forceinline__ void a_ready(const Unit&) const {}
    __device__ __forceinline__ void done(const Unit&) const {}
};
}

namespace pg8 {
__device__ __forceinline__ unsigned cvt_pk_bf16(float lo, float hi) { unsigned r; asm volatile("v_cvt_pk_bf16_f32 %0, %1, %2" : "=v"(r) : "v"(lo), "v"(hi)); return r; }
struct EpiProj {
    static constexpr bool PERM = true, AFTER_DRAIN = false, LAST_FUSED = false;
    bf16_t* proj; float* iw; const float* r128; const float* r64;
    __device__ __forceinline__ void operator()(const f32x4 (&acc)[2][2][4][2], const Unit& u, int wr, int wc, int fr, int fq) const {
        const int pn = u.pn;
        const int row0 = u.pm * BM + wr * 64 + fr, col0 = pn * BM + wc * 32 + 8 * fq;
        const bool rope128 = (pn >= 16 && pn <= 20) && wc == 0;
        const bool rope64 = ((pn >= 26 && pn <= 29) && (wc & 1) == 0) || (pn == 30 && wc == 0);
        const bool iwt = (pn == 30 && wc == 2);
        const float sc = (pn < 4 || (pn >= 16 && pn < 20)) ? C2 : 1.f;
#pragma unroll
        for (int ai = 0; ai < 2; ++ai)
#pragma unroll
            for (int m = 0; m < 4; ++m) {
                const int row = row0 + ai * HALF + m * 16;
                f32x4 cs0 = {1.f, 1.f, 1.f, 1.f}, cs1 = cs0, sn0 = {0.f, 0.f, 0.f, 0.f}, sn1 = sn0;
                if (rope128) { const float* t = r128 + (size_t)row * 32 + 8 * (fq & 1); cs0 = *(const f32x4*)t; cs1 = *(const f32x4*)(t + 4); sn0 = *(const f32x4*)(t + 16); sn1 = *(const f32x4*)(t + 20);
                    if (fq < 2) { sn0 = -sn0; sn1 = -sn1; } }
                if (rope64) { const float* t = r64 + (size_t)row * 16; cs0 = *(const f32x4*)t; cs1 = *(const f32x4*)(t + 4); sn0 = *(const f32x4*)(t + 8); sn1 = *(const f32x4*)(t + 12);
                    if (fq == 0) { sn0 = -sn0; sn1 = -sn1; } if (fq >= 2) { cs0 = (f32x4){1.f, 1.f, 1.f, 1.f}; cs1 = cs0; sn0 = (f32x4){0.f, 0.f, 0.f, 0.f}; sn1 = sn0; } }
#pragma unroll
                for (int bj = 0; bj < 2; ++bj) {
                    f32x4 v0 = acc[ai][bj][m][0] * sc, v1 = acc[ai][bj][m][1] * sc;
                    if (rope128 || (rope64 && (pn != 30 || bj == 0))) {
                        const int xm = rope128 ? 32 : 16;
                        f32x4 p0, p1;
#pragma unroll
                        for (int e = 0; e < 4; ++e) { p0[e] = __shfl_xor(v0[e], xm); p1[e] = __shfl_xor(v1[e], xm); }
                        v0 = v0 * cs0 + p0 * sn0; v1 = v1 * cs1 + p1 * sn1;
                    }
                    if (iwt && bj == 0 && fq < 2) { float* ip = iw + (size_t)row * 16 + 8 * fq; *(f32x4*)ip = v0 * IWS; *(f32x4*)(ip + 4) = v1 * IWS; }
                    u32x4 w; w.x = cvt_pk_bf16(v0[0], v0[1]); w.y = cvt_pk_bf16(v0[2], v0[3]); w.z = cvt_pk_bf16(v1[0], v1[1]); w.w = cvt_pk_bf16(v1[2], v1[3]);
                    if (pn < 26) *(u32x4*)(proj + (size_t)(2 * pn + bj) * PHS + (size_t)row * 128 + wc * 32 + 8 * fq) = w;
                    else if (pn < 30) {
                        const int c = (pn - 26) * 256 + 128 * bj + 32 * wc + 8 * fq, head = c >> 6, ks = (c >> 4) & 3, hi_ = (c >> 3) & 1;
                        const int rho = (head & 3) + 4 * (row & 1) + 8 * (head >> 2);
                        *(u32x4*)(proj + IQF_OFF + ((((size_t)(row >> 3) * 4 + ((row >> 1) & 3)) * 4 + ks) * 64 + hi_ * 32 + rho) * 8) = w;
                    } else if (bj == 0 && wc < 2) {
                        const int c = 32 * wc + 8 * fq, ks = c >> 4, hi_ = (c >> 3) & 1;
                        *(u32x4*)(proj + IKC_OFF + ((((size_t)(row >> 5)) * 4 + ks) * 64 + hi_ * 32 + (row & 31)) * 8) = w;
                    }
                }
            }
    }
};
}

namespace pg8 {
struct EpiOut {
    static constexpr bool PERM = true, AFTER_DRAIN = false, LAST_FUSED = true;
    const float* x; bf16_t* yb; float* ssp;
    float* out; const float* fg; unsigned* cnt; int pn0; int fuse;
    __device__ __forceinline__ void operator()(const f32x4 (&acc)[2][2][4][2], const Unit& u, int wr, int wc, int fr, int fq) const {
        const int row0 = u.pm * BM + wr * 64 + fr, col0 = u.pn * BM + wc * 32 + 8 * fq;
#pragma unroll
        for (int ai = 0; ai < 2; ++ai)
#pragma unroll
            for (int m = 0; m < 4; ++m) {
                const int row = row0 + ai * HALF + m * 16; const size_t off = (size_t)row * DM + col0; float s = 0.f;
#pragma unroll
                for (int bj = 0; bj < 2; ++bj) {
                    const f32x4 y0 = *(const f32x4*)(x + off + bj * HALF) + acc[ai][bj][m][0], y1 = *(const f32x4*)(x + off + bj * HALF + 4) + acc[ai][bj][m][1];
                    u32x4 w; w.x = cvt_pk_bf16(y0[0], y0[1]); w.y = cvt_pk_bf16(y0[2], y0[3]); w.z = cvt_pk_bf16(y1[0], y1[1]); w.w = cvt_pk_bf16(y1[2], y1[3]);
                    *(u32x4*)(yb + off + bj * HALF) = w;
                    s += (y0[0] * y0[0] + y0[1] * y0[1]) + (y0[2] * y0[2] + y0[3] * y0[3]) + (y1[0] * y1[0] + y1[1] * y1[1]) + (y1[2] * y1[2] + y1[3] * y1[3]);
                }
                s += __shfl_xor(s, 16); s += __shfl_xor(s, 32);
                if (fq == 0) ssp[(size_t)row * 32 + u.pn * 4 + wc] = s;
            }
    }
    __device__ __forceinline__ void fused(f32x4 (&acc)[2][2][4][2], const Unit& u, int wr, int wc, int fr, int fq, PG8_LAS unsigned char* lds, int wid, int lane) const {
        if (!fuse) { (*this)(acc, u, wr, wc, fr, fq); return; }
        const int row0 = u.pm * BM + wr * 64 + fr, col0 = u.pn * BM + wc * 32 + 8 * fq;
#pragma unroll
        for (int ai = 0; ai < 2; ++ai)
#pragma unroll
            for (int m = 0; m < 4; ++m) {
                const int row = row0 + ai * HALF + m * 16; const size_t off = (size_t)row * DM + col0; float s = 0.f;
#pragma unroll
                for (int bj = 0; bj < 2; ++bj) {
                    const f32x4 y0 = *(const f32x4*)(x + off + bj * HALF) + acc[ai][bj][m][0], y1 = *(const f32x4*)(x + off + bj * HALF + 4) + acc[ai][bj][m][1];
                    acc[ai][bj][m][0] = y0; acc[ai][bj][m][1] = y1;
                    s += (y0[0] * y0[0] + y0[1] * y0[1]) + (y0[2] * y0[2] + y0[3] * y0[3]) + (y1[0] * y1[0] + y1[1] * y1[1]) + (y1[2] * y1[2] + y1[3] * y1[3]);
                }
                s += __shfl_xor(s, 16); s += __shfl_xor(s, 32);
                if (fq == 0) ssp[(size_t)row * 32 + u.pn * 4 + wc] = s;
            }
        asm volatile("s_waitcnt vmcnt(0)" ::: "memory"); __syncthreads();
        unsigned* pc = cnt + 64 * u.pm;
        if (wid == 0) {
            if (lane == 0) { __builtin_amdgcn_fence(__ATOMIC_RELEASE, "agent"); asm volatile("s_waitcnt vmcnt(0)" ::: "memory"); __hip_atomic_fetch_add(pc, 1u, __ATOMIC_RELAXED, __HIP_MEMORY_SCOPE_AGENT); }
            unsigned sp = 0u;
            while ((unsigned)__builtin_amdgcn_readfirstlane((int)__hip_atomic_load(pc, __ATOMIC_RELAXED, __HIP_MEMORY_SCOPE_AGENT)) < 4u) { __builtin_amdgcn_s_sleep(2); if (++sp > (1u << 17)) break; }
            __builtin_amdgcn_fence(__ATOMIC_ACQUIRE, "agent"); asm volatile("s_waitcnt vmcnt(0)" ::: "memory");
        }
        __syncthreads();
        PG8_LAS float* tab = (PG8_LAS float*)lds;
        { const int t = wid * 64 + lane;
          if (t < 256) { const f32x4* pp = (const f32x4*)(ssp + (size_t)(u.pm * BM + t) * 32); float q = 0.f;
#pragma unroll
              for (int i = 0; i < 8; ++i) { const f32x4 v = pp[i]; q += (v[0] + v[1]) + (v[2] + v[3]); }
              tab[t] = 1.0f / sqrtf(q * (1.0f / DM) + EPS); } }
        asm volatile("s_waitcnt lgkmcnt(0)" ::: "memory"); __syncthreads();
        f32x4 gv[2][2];
#pragma unroll
        for (int bj = 0; bj < 2; ++bj) { gv[bj][0] = *(const f32x4*)(fg + col0 + bj * HALF); gv[bj][1] = *(const f32x4*)(fg + col0 + bj * HALF + 4); }
#pragma unroll
        for (int ai = 0; ai < 2; ++ai)
#pragma unroll
            for (int m = 0; m < 4; ++m) { const float rs = tab[ai * HALF + wr * 64 + m * 16 + fr]; const size_t off = (size_t)(row0 + ai * HALF + m * 16) * DM + col0;
#pragma unroll
                for (int bj = 0; bj < 2; ++bj) { *(f32x4*)(out + off + bj * HALF) = acc[ai][bj][m][0] * rs * gv[bj][0]; *(f32x4*)(out + off + bj * HALF + 4) = acc[ai][bj][m][1] * rs * gv[bj][1]; } }
        const int colA = pn0 * BM + wc * 32 + 8 * fq;
#pragma unroll
        for (int bj = 0; bj < 2; ++bj) { gv[bj][0] = *(const f32x4*)(fg + colA + bj * HALF); gv[bj][1] = *(const f32x4*)(fg + colA + bj * HALF + 4); }
#pragma unroll
        for (int ai = 0; ai < 2; ++ai)
#pragma unroll
            for (int m = 0; m < 4; ++m) { const float rs = tab[ai * HALF + wr * 64 + m * 16 + fr]; const size_t off = (size_t)(row0 + ai * HALF + m * 16) * DM + colA;
#pragma unroll
                for (int bj = 0; bj < 2; ++bj) { const u32x4 v = *(const u32x4*)(yb + off + bj * HALF);
                    const f32x4 a0 = {__builtin_bit_cast(float, v.x << 16), __builtin_bit_cast(float, v.x & 0xffff0000u), __builtin_bit_cast(float, v.y << 16), __builtin_bit_cast(float, v.y & 0xffff0000u)};
                    const f32x4 a1 = {__builtin_bit_cast(float, v.z << 16), __builtin_bit_cast(float, v.z & 0xffff0000u), __builtin_bit_cast(float, v.w << 16), __builtin_bit_cast(float, v.w & 0xffff0000u)};
                    *(f32x4*)(out + off + bj * HALF) = a0 * rs * gv[bj][0]; *(f32x4*)(out + off + bj * HALF + 4) = a1 * rs * gv[bj][1]; } }
    }
};
}
namespace pg8 {
template <class Epi, class Sched, bool ALIGN_EPI = false, bool SP2 = false>
__device__ __forceinline__ void gemm_phase(PG8_LAS unsigned char* lds, const Gemm g, const Sched& S, const Epi& E) {
    int tid_ = threadIdx.x; asm volatile("" : "+v"(tid_)); const int tid = tid_, wid = __builtin_amdgcn_readfirstlane(tid >> 6), lane = tid & 63, wr = wid >> 2, wc = wid & 3, fr = lane & 15, fq = lane >> 4;
    const int K = g.K, nt = K / BK;
    unsigned voffA[2], voffB[2];
#pragma unroll
    for (int i = 0; i < 2; ++i) { int R, C; stage_rc(tid * 16 + i * 8192, R, C); const int Rb = Epi::PERM ? ((R & ~31) + perm32(R & 31)) : R;
        voffA[i] = (unsigned)(R * K + C) * 2u; voffB[i] = (unsigned)(Rb * K + C) * 2u; }
    const size_t kstep = (size_t)(BK * 2);
    const size_t hstep = (size_t)HALF * K * 2;
    const size_t tstep = 2 * hstep;
    const unsigned ldsw = (unsigned)wid * 1024u;
    const int aoff = lds_byte(wr * 64 + fr, fq * 8), boff = lds_byte(wc * 32 + fr, fq * 8);
#define PG8_SA(b, h) (((b) * 2 + (h)) * HTB)
#define PG8_SB(b, h) ((4 + (b) * 2 + (h)) * HTB)
#define PG8_STAGE(bufoff, gbase, voff) do { _Pragma("unroll") for (int _i = 0; _i < 2; ++_i) \
        __builtin_amdgcn_global_load_lds((const unsigned*)((const char*)(gbase) + (voff)[_i]), (PG8_LAS unsigned*)(lds + (bufoff) + ldsw + _i * 8192), 16, 0, 0); } while (0)
#define PG8_LDA(dst, b, h) do { _Pragma("unroll") for (int m = 0; m < 4; ++m) _Pragma("unroll") for (int k = 0; k < 2; ++k) dst[m][k] = *(const PG8_LAS bf16x8*)(lds + PG8_SA(b, h) + aoff + m * 2048 + k * 1024); } while (0)
#define PG8_LDB(dst, b, h) do { _Pragma("unroll") for (int n = 0; n < 2; ++n) _Pragma("unroll") for (int k = 0; k < 2; ++k) dst[n][k] = *(const PG8_LAS bf16x8*)(lds + PG8_SB(b, h) + boff + n * 2048 + k * 1024); } while (0)
#define PG8_MMA(ai, bj, At, Bt) do { __builtin_amdgcn_s_setprio(1); _Pragma("unroll") for (int m = 0; m < 4; ++m) _Pragma("unroll") for (int n = 0; n < 2; ++n) _Pragma("unroll") for (int k = 0; k < 2; ++k) \
        acc[ai][bj][m][n] = __builtin_amdgcn_mfma_f32_16x16x32_bf16(Bt[n][k], At[m][k], acc[ai][bj][m][n], 0, 0, 0); __builtin_amdgcn_s_setprio(0); } while (0)
#define PG8_WAIT_V(n) asm volatile("s_waitcnt vmcnt(" #n ")" ::: "memory")
#define PG8_WAIT_L(n) asm volatile("s_waitcnt lgkmcnt(" #n ")" ::: "memory")
#define PG8_BAR __builtin_amdgcn_s_barrier()
#define PG8_SCHED __builtin_amdgcn_sched_barrier(0)
    Unit cur, nxt; int ui = 0;
    if (!S.next(0, cur)) return;
    f32x4 acc[2][2][4][2];
#pragma unroll
    for (int a = 0; a < 2; ++a)
#pragma unroll
        for (int b = 0; b < 2; ++b)
#pragma unroll
            for (int m = 0; m < 4; ++m)
#pragma unroll
                for (int n = 0; n < 2; ++n) acc[a][b][m][n] = (f32x4){0.f, 0.f, 0.f, 0.f};
    bf16x8 At[4][2], B0[2][2], B1[2][2];
    const char* cA = (const char*)g.A + (size_t)cur.pm * tstep; const char* cB = (const char*)g.Bt + (size_t)cur.pn * tstep;
    S.a_ready(cur);
    if constexpr (SP2) {
        PG8_STAGE(PG8_SB(0, 0), cB, voffB); PG8_STAGE(PG8_SB(0, 1), cB + hstep, voffB); PG8_STAGE(PG8_SA(0, 0), cA, voffA); PG8_STAGE(PG8_SA(0, 1), cA + hstep, voffA);
        if (wr == 1) PG8_BAR;
        PG8_WAIT_V(2); PG8_BAR;
        PG8_STAGE(PG8_SB(1, 0), cB + kstep, voffB); PG8_STAGE(PG8_SA(1, 0), cA + kstep, voffA); PG8_STAGE(PG8_SB(1, 1), cB + hstep + kstep, voffB);
        PG8_WAIT_V(6); PG8_BAR;
    } else {
        PG8_STAGE(PG8_SB(0, 0), cB, voffB); PG8_STAGE(PG8_SA(0, 0), cA, voffA); PG8_STAGE(PG8_SB(0, 1), cB + hstep, voffB); PG8_STAGE(PG8_SA(0, 1), cA + hstep, voffA);
        if (wr == 1) PG8_BAR;
        PG8_WAIT_V(4); PG8_BAR;
        PG8_STAGE(PG8_SB(1, 0), cB + kstep, voffB); PG8_STAGE(PG8_SA(1, 0), cA + kstep, voffA); PG8_STAGE(PG8_SB(1, 1), cB + hstep + kstep, voffB);
        PG8_WAIT_V(6); PG8_BAR;
    }
    for (;;) {
        const bool has_next = S.next(ui + 1, nxt);
        const char* nA = has_next ? (const char*)g.A + (size_t)nxt.pm * tstep : cA; const char* nB = has_next ? (const char*)g.Bt + (size_t)nxt.pn * tstep : cB;
        for (int t = 0; t < nt; t += 2) {
            const bool last = (t == nt - 2);
            const char* a1 = cA + (size_t)(t + 1) * kstep;
            const char* a2 = last ? nA : cA + (size_t)(t + 2) * kstep; const char* b2 = last ? nB : cB + (size_t)(t + 2) * kstep;
            const char* a3 = a2 + kstep; const char* b3 = b2 + kstep;
            if (last && has_next) S.a_ready(nxt);
            if constexpr (SP2) {
            PG8_LDB(B0, 0, 0); PG8_LDB(B1, 0, 1); PG8_SCHED; PG8_LDA(At, 0, 0); PG8_STAGE(PG8_SA(1, 1), a1 + hstep, voffA);
            PG8_WAIT_V(8); PG8_WAIT_L(0); PG8_BAR; PG8_MMA(0, 0, At, B0); PG8_MMA(0, 1, At, B1); PG8_BAR; PG8_SCHED;
            PG8_LDA(At, 0, 1); PG8_STAGE(PG8_SB(0, 0), b2, voffB); PG8_STAGE(PG8_SB(0, 1), b2 + hstep, voffB); PG8_STAGE(PG8_SA(0, 0), a2, voffA);
            PG8_WAIT_V(8); PG8_WAIT_L(0); PG8_BAR; PG8_MMA(1, 0, At, B0); PG8_MMA(1, 1, At, B1); PG8_BAR; PG8_SCHED;
            PG8_LDB(B0, 1, 0); PG8_LDB(B1, 1, 1); PG8_SCHED; PG8_LDA(At, 1, 0); PG8_STAGE(PG8_SA(0, 1), a2 + hstep, voffA);
            PG8_WAIT_V(8); PG8_WAIT_L(0); PG8_BAR; PG8_MMA(0, 0, At, B0); PG8_MMA(0, 1, At, B1); PG8_BAR; PG8_SCHED;
            PG8_LDA(At, 1, 1); PG8_STAGE(PG8_SB(1, 0), b3, voffB); PG8_STAGE(PG8_SB(1, 1), b3 + hstep, voffB); PG8_STAGE(PG8_SA(1, 0), a3, voffA);
            PG8_WAIT_V(8); PG8_WAIT_L(0); PG8_BAR; PG8_MMA(1, 0, At, B0); PG8_MMA(1, 1, At, B1); PG8_BAR; PG8_SCHED;
            } else {
            PG8_LDB(B0, 0, 0); PG8_SCHED; PG8_LDA(At, 0, 0); PG8_STAGE(PG8_SA(1, 1), a1 + hstep, voffA);
            PG8_WAIT_L(8); PG8_BAR; PG8_WAIT_L(0); PG8_MMA(0, 0, At, B0); PG8_BAR; PG8_SCHED;
            PG8_LDB(B1, 0, 1); PG8_STAGE(PG8_SB(0, 0), b2, voffB);
            PG8_BAR; PG8_WAIT_L(0); PG8_MMA(0, 1, At, B1); PG8_BAR;
            PG8_LDA(At, 0, 1); PG8_STAGE(PG8_SA(0, 0), a2, voffA);
            PG8_BAR; PG8_WAIT_L(0); PG8_MMA(1, 0, At, B0); PG8_BAR; PG8_SCHED;
            PG8_STAGE(PG8_SB(0, 1), b2 + hstep, voffB);
            PG8_WAIT_V(6); PG8_BAR; PG8_MMA(1, 1, At, B1); PG8_BAR;
            PG8_LDB(B0, 1, 0); PG8_SCHED; PG8_LDA(At, 1, 0); PG8_STAGE(PG8_SA(0, 1), a2 + hstep, voffA);
            PG8_WAIT_L(8); PG8_BAR; PG8_WAIT_L(0); PG8_MMA(0, 0, At, B0); PG8_BAR; PG8_SCHED;
            PG8_LDB(B1, 1, 1); PG8_STAGE(PG8_SB(1, 0), b3, voffB);
            PG8_BAR; PG8_WAIT_L(0); PG8_MMA(0, 1, At, B1); PG8_BAR;
            PG8_LDA(At, 1, 1); PG8_STAGE(PG8_SA(1, 0), a3, voffA);
            PG8_BAR; PG8_WAIT_L(0); PG8_MMA(1, 0, At, B0); PG8_BAR; PG8_SCHED;
            PG8_STAGE(PG8_SB(1, 1), b3 + hstep, voffB);
            PG8_WAIT_V(6); PG8_BAR; PG8_MMA(1, 1, At, B1); PG8_BAR;
            }
        }
        if constexpr (ALIGN_EPI) { if (wr == 0) PG8_BAR; }
        if constexpr (!Epi::AFTER_DRAIN) { if (!(Epi::LAST_FUSED && !has_next)) { E(acc, cur, wr, wc, fr, fq); S.done(cur); } }
        if (!has_next) break;
#pragma unroll
        for (int a = 0; a < 2; ++a)
#pragma unroll
            for (int b = 0; b < 2; ++b)
#pragma unroll
                for (int m = 0; m < 4; ++m)
#pragma unroll
                    for (int n = 0; n < 2; ++n) acc[a][b][m][n] = (f32x4){0.f, 0.f, 0.f, 0.f};
        cur = nxt; cA = nA; cB = nB; ++ui;
        if constexpr (ALIGN_EPI) { if (wr == 1) PG8_BAR; }
    }
    PG8_WAIT_V(0);
    if constexpr (!ALIGN_EPI) { if (wr == 0) PG8_BAR; }
    PG8_BAR;
    if constexpr (Epi::AFTER_DRAIN || Epi::LAST_FUSED) { E.fused(acc, cur, wr, wc, fr, fq, lds, wid, lane); S.done(cur); }
#undef PG8_SA
#undef PG8_SB
#undef PG8_STAGE
#undef PG8_LDA
#undef PG8_LDB
#undef PG8_MMA
#undef PG8_WAIT_V
#undef PG8_WAIT_L
#undef PG8_BAR
#undef PG8_SCHED
}
}

namespace att {
#define ALAS __attribute__((address_space(3)))
using bf16x8 = __attribute__((ext_vector_type(8))) short;
using s16x4  = __attribute__((ext_vector_type(4))) short;
using f32x16 = __attribute__((ext_vector_type(16))) float;
constexpr int KVBLK = 64, SHM_V = KVBLK * 128 * 2, SHM_K = KVBLK * 128 * 2;
constexpr int L_V = 0, L_K = 2 * SHM_V, L_FLAG = 2 * SHM_V + 2 * SHM_K;
#define KSWZ(row, colB) ((row) * 256 + ((colB) ^ (((row) & 7) << 4)))
#define SBAR() __builtin_amdgcn_sched_barrier(0)
__device__ __forceinline__ int crow(int r, int hi) { return (r & 3) + 8 * (r >> 2) + 4 * hi; }
__device__ __forceinline__ unsigned cvtpk(float lo, float hi) { unsigned r; asm volatile("v_cvt_pk_bf16_f32 %0, %1, %2" : "=v"(r) : "v"(lo), "v"(hi)); return r; }
__device__ __forceinline__ void qkt(f32x16& p0, f32x16& p1, const ALAS unsigned char* Ks, const bf16x8* qr, int r32, int hi) {
    p0 = f32x16{}; p1 = f32x16{};
#pragma unroll
    for (int d0 = 0; d0 < 8; ++d0) { const int cb = (d0 * 16 + hi * 8) * 2;
        const bf16x8 b0 = *(const ALAS bf16x8*)(Ks + KSWZ(r32, cb));
        const bf16x8 b1 = *(const ALAS bf16x8*)(Ks + KSWZ(32 + r32, cb));
        p0 = __builtin_amdgcn_mfma_f32_32x32x16_bf16(b0, qr[d0], p0, 0, 0, 0);
        p1 = __builtin_amdgcn_mfma_f32_32x32x16_bf16(b1, qr[d0], p1, 0, 0, 0); }
}
__device__ __forceinline__ int v_st(int k, int c) { const int kk = (k & ~0xC) | ((k & 4) << 1) | ((k & 8) >> 1); return ((kk >> 3) * 4 + (c >> 5)) * 512 + ((kk & 7) * 32 + (c & 31)) * 2; }
__device__ __forceinline__ int v_rd_base(int lane) { return ((lane & 3) << 3) | (((lane >> 2) & 3) << 6) | (((lane >> 4) & 1) << 5) | (((lane >> 5) & 1) << 8); }
constexpr int v_rd_off(int d0, int ks, int half) { return d0 * 512 + ks * 4096 + half * 2048; }
template <int OFF> __device__ __forceinline__ s16x4 tr_read(int vb) { s16x4 r; asm volatile("ds_read_b64_tr_b16 %0, %1 offset:%2" : "=&v"(r) : "v"(vb), "i"(OFF) : "memory"); return r; }
template <int D0> __device__ __forceinline__ void pv_one(f32x16& od, int vb, bf16x8 pa0, bf16x8 pa1, bf16x8 pa2, bf16x8 pa3) {
    const s16x4 l0 = tr_read<v_rd_off(D0, 0, 0)>(vb), h0 = tr_read<v_rd_off(D0, 0, 1)>(vb), l1 = tr_read<v_rd_off(D0, 1, 0)>(vb), h1 = tr_read<v_rd_off(D0, 1, 1)>(vb);
    const s16x4 l2 = tr_read<v_rd_off(D0, 2, 0)>(vb), h2 = tr_read<v_rd_off(D0, 2, 1)>(vb), l3 = tr_read<v_rd_off(D0, 3, 0)>(vb), h3 = tr_read<v_rd_off(D0, 3, 1)>(vb);
    asm volatile("s_waitcnt lgkmcnt(0)" ::: "memory"); SBAR();
#define PK(L, H) (bf16x8){L[0], L[1], L[2], L[3], H[0], H[1], H[2], H[3]}
    od = __builtin_amdgcn_mfma_f32_32x32x16_bf16(pa0, PK(l0, h0), od, 0, 0, 0);
    od = __builtin_amdgcn_mfma_f32_32x32x16_bf16(pa1, PK(l1, h1), od, 0, 0, 0);
    od = __builtin_amdgcn_mfma_f32_32x32x16_bf16(pa2, PK(l2, h2), od, 0, 0, 0);
    od = __builtin_amdgcn_mfma_f32_32x32x16_bf16(pa3, PK(l3, h3), od, 0, 0, 0);
#undef PK
}
__device__ __forceinline__ void pv_d0(f32x16* o, int vb, bf16x8 pa0, bf16x8 pa1, bf16x8 pa2, bf16x8 pa3) {
    pv_one<0>(o[0], vb, pa0, pa1, pa2, pa3); pv_one<1>(o[1], vb, pa0, pa1, pa2, pa3); pv_one<2>(o[2], vb, pa0, pa1, pa2, pa3); pv_one<3>(o[3], vb, pa0, pa1, pa2, pa3);
}
__device__ __forceinline__ void pack_p(const f32x16& p0, const f32x16& p1, bf16x8& pa0, bf16x8& pa1, bf16x8& pa2, bf16x8& pa3) {
#define PK4(P, BASE, OUT) do { unsigned a0 = cvtpk(P[BASE + 0], P[BASE + 1]), a1 = cvtpk(P[BASE + 2], P[BASE + 3]);   \
    unsigned b0 = cvtpk(P[BASE + 4], P[BASE + 5]), b1 = cvtpk(P[BASE + 6], P[BASE + 7]);                              \
    auto r0 = __builtin_amdgcn_permlane32_swap(a0, b0, false, false); auto r1 = __builtin_amdgcn_permlane32_swap(a1, b1, false, false); \
    u32x4 w = {r0[0], r1[0], r0[1], r1[1]}; OUT = *reinterpret_cast<bf16x8*>(&w); } while (0)
    PK4(p0, 0, pa0); PK4(p0, 8, pa1); PK4(p1, 0, pa2); PK4(p1, 8, pa3);
#undef PK4
}
__device__ __forceinline__ float sp2(float z2) { return relu_i(z2) + __builtin_amdgcn_logf(1.0f + __builtin_amdgcn_exp2f(-fabsf(z2))); }
__device__ __forceinline__ void sb_weights(f32x16& p0, f32x16& p1, float& R, int hi) {
    float nl[32];
#pragma unroll
    for (int i = 0; i < 16; ++i) { const float z = p0[i], s = sp2(z); nl[i] = s; p0[i] = z - s; }
#pragma unroll
    for (int i = 0; i < 16; ++i) { const float z = p1[i], s = sp2(z); nl[16 + i] = s; p1[i] = z - s; }
    float S[9]; S[8] = 0.f;
#pragma unroll
    for (int g = 7; g >= 0; --g) S[g] = S[g + 1] + ((nl[4 * g] + nl[4 * g + 1]) + (nl[4 * g + 2] + nl[4 * g + 3]));
    float tot; { auto rr = __builtin_amdgcn_permlane32_swap(__float_as_uint(S[0]), __float_as_uint(S[0]), false, false); tot = __uint_as_float(rr[0]) + __uint_as_float(rr[1]); }
#pragma unroll
    for (int g = 0; g < 8; ++g) {
        const float snd = hi ? S[g] : S[g + 1];
        auto rr = __builtin_amdgcn_permlane32_swap(__float_as_uint(snd), __float_as_uint(snd), false, false);
        const float rcv = hi ? __uint_as_float(rr[0]) : __uint_as_float(rr[1]);
        const float t3 = R - S[g + 1] - rcv, t2 = t3 - nl[4 * g + 3], t1 = t2 - nl[4 * g + 2], t0 = t1 - nl[4 * g + 1];
        if (g < 4) { p0[4 * g + 3] = __builtin_amdgcn_exp2f(p0[4 * g + 3] + t3); p0[4 * g + 2] = __builtin_amdgcn_exp2f(p0[4 * g + 2] + t2); p0[4 * g + 1] = __builtin_amdgcn_exp2f(p0[4 * g + 1] + t1); p0[4 * g] = __builtin_amdgcn_exp2f(p0[4 * g] + t0); }
        else { const int q = 4 * (g - 4); p1[q + 3] = __builtin_amdgcn_exp2f(p1[q + 3] + t3); p1[q + 2] = __builtin_amdgcn_exp2f(p1[q + 2] + t2); p1[q + 1] = __builtin_amdgcn_exp2f(p1[q + 1] + t1); p1[q] = __builtin_amdgcn_exp2f(p1[q] + t0); }
    }
    R -= tot;
}
constexpr int L_STG = 69632;
__device__ __forceinline__ void epi_rows(ALAS unsigned char* lds, const f32x16* o, const float* rn, const bf16_t* __restrict__ gate0, const float* __restrict__ gain, bf16_t* __restrict__ out0, int wid, int lane) {
    const int r32 = lane & 31, hi = lane >> 5;
    ALAS bf16_t* stg = (ALAS bf16_t*)(lds + L_STG + wid * 8192);
#pragma unroll
    for (int r = 0; r < 16; ++r)
#pragma unroll
        for (int d0 = 0; d0 < 4; ++d0) stg[crow(r, hi) * 128 + 32 * d0 + r32] = (bf16_t)cvtpk(o[d0][r] * rn[r], 0.f);
    asm volatile("s_waitcnt lgkmcnt(0)" ::: "memory");
    const int cc = lane & 15, rr0 = lane >> 4;
    const f32x4 g0 = *(const f32x4*)(gain + 8 * cc), g1 = *(const f32x4*)(gain + 8 * cc + 4);
    u32x4 gt[8];
#pragma unroll
    for (int i = 0; i < 8; ++i) gt[i] = *(const u32x4*)(gate0 + (size_t)(4 * i + rr0) * 128 + 8 * cc);
#pragma unroll
    for (int i = 0; i < 8; ++i) { const int row = 4 * i + rr0;
        const u32x4 v = *(const ALAS u32x4*)(stg + row * 128 + 8 * cc); const u32x4 g = gt[i];
        float y[8], q[8];
        y[0] = bf2f(v.x & 0xffffu); y[1] = bf2f(v.x >> 16); y[2] = bf2f(v.y & 0xffffu); y[3] = bf2f(v.y >> 16); y[4] = bf2f(v.z & 0xffffu); y[5] = bf2f(v.z >> 16); y[6] = bf2f(v.w & 0xffffu); y[7] = bf2f(v.w >> 16);
        q[0] = bf2f(g.x & 0xffffu); q[1] = bf2f(g.x >> 16); q[2] = bf2f(g.y & 0xffffu); q[3] = bf2f(g.y >> 16); q[4] = bf2f(g.z & 0xffffu); q[5] = bf2f(g.z >> 16); q[6] = bf2f(g.w & 0xffffu); q[7] = bf2f(g.w >> 16);
#pragma unroll
        for (int e = 0; e < 8; ++e) y[e] = y[e] * (e < 4 ? g0[e & 3] : g1[e & 3]) * (q[e] / (1.0f + __expf(-q[e])));
        u32x4 w; w.x = cvtpk(y[0], y[1]); w.y = cvtpk(y[2], y[3]); w.z = cvtpk(y[4], y[5]); w.w = cvtpk(y[6], y[7]);
        *(u32x4*)(out0 + (size_t)row * DM + 8 * cc) = w; }
    asm volatile("s_waitcnt lgkmcnt(0)" ::: "memory");
}
constexpr float SB_EXIT = -160.0f;
template <bool EARLY>
__device__ __forceinline__ void sb_unit(ALAS unsigned char* lds, const bf16_t* __restrict__ proj, const float* __restrict__ gain, bf16_t* __restrict__ mixed, int b, int h, int qb) {
    int tid_ = threadIdx.x; asm volatile("" : "+v"(tid_)); const int tid = tid_, wid = __builtin_amdgcn_readfirstlane(tid >> 6), lane = tid & 63, r32 = lane & 31, hi = lane >> 5;
    const size_t tok0 = (size_t)b * SEQ; const int q0 = qb * 256, tw0 = q0 + 32 * wid;
    const bf16_t* Kg = proj + (size_t)(8 + h) * PHS + tok0 * 128; const bf16_t* Vg = proj + (size_t)(16 + h) * PHS + tok0 * 128;
    bf16x8 qr[8];
    { const bf16_t* Qw = proj + (size_t)h * PHS + (tok0 + tw0 + r32) * 128 + hi * 8;
#pragma unroll
      for (int d0 = 0; d0 < 8; ++d0) qr[d0] = *(const bf16x8*)(Qw + d0 * 16); }
    const int sr = tid >> 4, sc = (tid & 15) * 8;
    const int vst0 = v_st(sr, sc), vst1 = v_st(32 + sr, sc), kst0 = KSWZ(sr, sc * 2), kst1 = KSWZ(32 + sr, sc * 2);
    const int vb0 = (int)(unsigned)(size_t)(lds + L_V) + v_rd_base(lane);
    ALAS unsigned* flags = (ALAS unsigned*)(lds + L_FLAG);
    bf16x8 ks0, ks1, vs0, vs1;
#define SLOAD(k0) do { const size_t o0 = (size_t)((k0) + sr) * 128 + sc, o1 = (size_t)((k0) + 32 + sr) * 128 + sc; \
    vs0 = *(const bf16x8*)(Vg + o0); vs1 = *(const bf16x8*)(Vg + o1); ks0 = *(const bf16x8*)(Kg + o0); ks1 = *(const bf16x8*)(Kg + o1); } while (0)
#define SWRITE(bf) do { *(ALAS bf16x8*)(lds + L_V + (bf) * SHM_V + vst0) = vs0; *(ALAS bf16x8*)(lds + L_V + (bf) * SHM_V + vst1) = vs1; \
    *(ALAS bf16x8*)(lds + L_K + (bf) * SHM_K + kst0) = ks0; *(ALAS bf16x8*)(lds + L_K + (bf) * SHM_K + kst1) = ks1; } while (0)
    const int jmax = 4 * qb + 3;
    SLOAD(jmax * KVBLK); SWRITE(0); __syncthreads();
    float R = 0.f; f32x16 o[4] = {};
    for (int it = 0, j = jmax;; ++it, --j) {
        const int cur = it & 1, key0 = j * KVBLK;
        const bool act = (key0 < tw0 + 31) && !(EARLY && __all(R < SB_EXIT));
        if (!act && j > 0) SLOAD((j - 1) * KVBLK);
        if (act) {
            f32x16 p0, p1;
            qkt(p0, p1, lds + L_K + cur * SHM_K, qr, r32, hi);
            if (key0 + 63 >= tw0) {
                const int lim = tw0 + r32 - key0 - 4 * hi;
#pragma unroll
                for (int i = 0; i < 16; ++i) { const int kk = 8 * (i >> 2) + (i & 3); if (kk >= lim) p0[i] = -INFINITY; if (kk + 32 >= lim) p1[i] = -INFINITY; }
            }
            sb_weights(p0, p1, R, hi);
            SBAR(); if (j > 0) SLOAD((j - 1) * KVBLK); SBAR();
            bf16x8 pa0, pa1, pa2, pa3;
            pack_p(p0, p1, pa0, pa1, pa2, pa3);
            pv_d0(o, vb0 + cur * SHM_V, pa0, pa1, pa2, pa3);
        }
        if (EARLY) { const bool dn = __all(R < SB_EXIT); if (lane == 0) flags[cur * 8 + wid] = dn ? 1u : 0u; }
        if (j > 0) SWRITE(cur ^ 1);
        __syncthreads();
        if (j == 0) break;
        if (EARLY) { const u32x4 f0 = *(const ALAS u32x4*)(flags + cur * 8), f1 = *(const ALAS u32x4*)(flags + cur * 8 + 4);
            if ((f0.x & f0.y & f0.z & f0.w & f1.x & f1.y & f1.z & f1.w) != 0u) break; }
    }
#undef SLOAD
#undef SWRITE
    float rn[16];
#pragma unroll
    for (int r = 0; r < 16; ++r) { float ss = (o[0][r] * o[0][r] + o[1][r] * o[1][r]) + (o[2][r] * o[2][r] + o[3][r] * o[3][r]);
#pragma unroll
        for (int x = 1; x < 32; x <<= 1) ss += __shfl_xor(ss, x);
        rn[r] = 1.0f / sqrtf(ss * (1.0f / HD) + EPS); }
    epi_rows(lds, o, rn, proj + (size_t)(24 + h) * PHS + (tok0 + tw0) * 128, gain + h * HD, mixed + (tok0 + tw0) * DM + h * HD, wid, lane);
}
constexpr int L_WS = L_FLAG + 64;
constexpr float DSA_THR = 11.5f;
__device__ __forceinline__ void dsa_partial(f32x16& p0, f32x16& p1, unsigned long long mw, int hi, float& m_reg, float& mn, float& alpha) {
    const int mlo = (int)((unsigned)mw >> (4 * hi)), mhi = (int)((unsigned)(mw >> 32) >> (4 * hi));
    const unsigned NINF = 0xff800000u;
#pragma unroll
    for (int i = 0; i < 16; ++i) { const int kk = 8 * (i >> 2) + (i & 3);
        const unsigned t0 = (unsigned)__builtin_amdgcn_sbfe(mlo, kk, 1), t1 = (unsigned)__builtin_amdgcn_sbfe(mhi, kk, 1);
        p0[i] = __uint_as_float((__float_as_uint(p0[i]) & t0) | (NINF & ~t0)); p1[i] = __uint_as_float((__float_as_uint(p1[i]) & t1) | (NINF & ~t1)); }
    float pmax, pmb;
    pmax = max3_asm(p0[0], p0[1], p0[2]); pmb = max3_asm(p1[0], p1[1], p1[2]);
#pragma unroll
    for (int r = 3; r < 15; r += 2) { pmax = max3_asm(pmax, p0[r], p0[r + 1]); pmb = max3_asm(pmb, p1[r], p1[r + 1]); }
    pmax = max3_asm(pmax, p0[15], p1[15]); pmax = max3_asm(pmax, pmb, pmb);
    { auto rr = __builtin_amdgcn_permlane32_swap(__float_as_uint(pmax), __float_as_uint(pmax), false, false); pmax = max3_asm(__uint_as_float(rr[0]), __uint_as_float(rr[1]), __uint_as_float(rr[1])); }
    if (__builtin_expect(__all(pmax - m_reg <= DSA_THR), 1)) { mn = m_reg; alpha = 1.f; }
    else { mn = fmaxf(m_reg, pmax); alpha = __builtin_amdgcn_exp2f(m_reg - mn); m_reg = mn; }
#pragma unroll
    for (int r = 0; r < 16; ++r) { p0[r] -= mn; p1[r] -= mn; }
#pragma unroll
    for (int r = 0; r < 16; ++r) p0[r] = __builtin_amdgcn_exp2f(p0[r]);
}
__device__ __forceinline__ void dsa_finish(f32x16& p0, f32x16& p1, float alpha, float& l_reg, bf16x8& pa0, bf16x8& pa1, bf16x8& pa2, bf16x8& pa3) {
#pragma unroll
    for (int r = 0; r < 16; ++r) p1[r] = __builtin_amdgcn_exp2f(p1[r]);
    float ps = 0.f;
#pragma unroll
    for (int r = 0; r < 16; ++r) ps += p0[r];
#pragma unroll
    for (int r = 0; r < 16; ++r) ps += p1[r];
    { auto rr = __builtin_amdgcn_permlane32_swap(__float_as_uint(ps), __float_as_uint(ps), false, false); ps = __uint_as_float(rr[0]) + __uint_as_float(rr[1]); }
    l_reg = l_reg * alpha + ps;
    pack_p(p0, p1, pa0, pa1, pa2, pa3);
}
__device__ __forceinline__ void dsa_unit(ALAS unsigned char* lds, const bf16_t* __restrict__ proj, const unsigned long long* __restrict__ mask, const float* __restrict__ gain,
                                         bf16_t* __restrict__ mixed, int b, int h, int qb) {
    int tid_ = threadIdx.x; asm volatile("" : "+v"(tid_)); const int tid = tid_, wid = __builtin_amdgcn_readfirstlane(tid >> 6), lane = tid & 63, r32 = lane & 31, hi = lane >> 5, g = h >> 2;
    const size_t tok0 = (size_t)b * SEQ; const int q0 = qb * 256, tw0 = q0 + 32 * wid;
    const bf16_t* Kg = proj + (size_t)(40 + g) * PHS + tok0 * 128; const bf16_t* Vg = proj + (size_t)(42 + g) * PHS + tok0 * 128;
    bf16x8 qr[8];
    { const bf16_t* Qw = proj + (size_t)(32 + h) * PHS + (tok0 + tw0 + r32) * 128 + hi * 8;
#pragma unroll
      for (int d0 = 0; d0 < 8; ++d0) qr[d0] = *(const bf16x8*)(Qw + d0 * 16); }
    const unsigned long long* mrow = mask + (tok0 + tw0 + r32) * 64;
    const int sr = tid >> 4, sc = (tid & 15) * 8;
    const int vst0 = v_st(sr, sc), vst1 = v_st(32 + sr, sc), kst0 = KSWZ(sr, sc * 2), kst1 = KSWZ(32 + sr, sc * 2);
    const int vb0 = (int)(unsigned)(size_t)(lds + L_V) + v_rd_base(lane);
    ALAS float* wsl = (ALAS float*)(lds + L_WS) + wid * 64;
    bf16x8 eV0, eV1, eK0, eK1, oV0, oV1, oK0, oK1;
#define SLOAD_E(k0) do { const size_t o0 = (size_t)((k0) + sr) * 128 + sc, o1 = (size_t)((k0) + 32 + sr) * 128 + sc; eV0 = *(const bf16x8*)(Vg + o0); eV1 = *(const bf16x8*)(Vg + o1); eK0 = *(const bf16x8*)(Kg + o0); eK1 = *(const bf16x8*)(Kg + o1); } while (0)
#define SLOAD_O(k0) do { const size_t o0 = (size_t)((k0) + sr) * 128 + sc, o1 = (size_t)((k0) + 32 + sr) * 128 + sc; oV0 = *(const bf16x8*)(Vg + o0); oV1 = *(const bf16x8*)(Vg + o1); oK0 = *(const bf16x8*)(Kg + o0); oK1 = *(const bf16x8*)(Kg + o1); } while (0)
#define SWRITE_E() do { *(ALAS bf16x8*)(lds + L_V + vst0) = eV0; *(ALAS bf16x8*)(lds + L_V + vst1) = eV1; *(ALAS bf16x8*)(lds + L_K + kst0) = eK0; *(ALAS bf16x8*)(lds + L_K + kst1) = eK1; } while (0)
#define SWRITE_O() do { *(ALAS bf16x8*)(lds + L_V + SHM_V + vst0) = oV0; *(ALAS bf16x8*)(lds + L_V + SHM_V + vst1) = oV1; *(ALAS bf16x8*)(lds + L_K + SHM_K + kst0) = oK0; *(ALAS bf16x8*)(lds + L_K + SHM_K + kst1) = oK1; } while (0)
#define SWAIT() asm volatile("s_waitcnt vmcnt(4)" ::: "memory")
#define RESC(a) do { if (__any((a) < 1.f)) { if (hi == 0) wsl[r32] = (a); asm volatile("s_waitcnt lgkmcnt(0)" ::: "memory"); \
    _Pragma("unroll") for (int r = 0; r < 16; ++r) { const float al_ = wsl[crow(r, hi)]; _Pragma("unroll") for (int d = 0; d < 4; ++d) o[d][r] *= al_; } } } while (0)
    const int NT = 4 * qb + 4;
    float m_reg = -1e30f, l_reg = 0.f; f32x16 o[4] = {};
    f32x16 pA0, pA1, pB0, pB1; float mnA, mnB, alA, alB; bf16x8 pa0, pa1, pa2, pa3;
    SLOAD_E(0); unsigned long long mwA = mrow[0], mwB; asm volatile("s_waitcnt vmcnt(0)" ::: "memory"); SWRITE_E(); __syncthreads();
    qkt(pA0, pA1, lds + L_K, qr, r32, hi); dsa_partial(pA0, pA1, mwA, hi, m_reg, mnA, alA);
    SLOAD_O(KVBLK); SLOAD_E(2 * KVBLK);
    SWAIT(); SWRITE_O(); __syncthreads();
    for (int j = 1; j + 1 < NT; j += 2) {
        mwB = mrow[j];
        SBAR(); qkt(pB0, pB1, lds + L_K + SHM_K, qr, r32, hi);
        dsa_finish(pA0, pA1, alA, l_reg, pa0, pa1, pa2, pa3); SBAR();
        SLOAD_O((j + 2) * KVBLK); SBAR();
        pv_d0(o, vb0, pa0, pa1, pa2, pa3); dsa_partial(pB0, pB1, mwB, hi, m_reg, mnB, alB);
        __syncthreads(); SWAIT(); SWRITE_E();
        RESC(alB); __syncthreads();
        mwA = mrow[j + 1];
        SBAR(); qkt(pA0, pA1, lds + L_K, qr, r32, hi);
        dsa_finish(pB0, pB1, alB, l_reg, pa0, pa1, pa2, pa3); SBAR();
        if (j + 3 < NT) SLOAD_E((j + 3) * KVBLK); SBAR();
        pv_d0(o, vb0 + SHM_V, pa0, pa1, pa2, pa3); dsa_partial(pA0, pA1, mwA, hi, m_reg, mnA, alA);
        __syncthreads(); SWAIT(); SWRITE_O();
        RESC(alA); __syncthreads();
    }
    mwB = mrow[NT - 1];
    SBAR(); qkt(pB0, pB1, lds + L_K + SHM_K, qr, r32, hi);
    dsa_finish(pA0, pA1, alA, l_reg, pa0, pa1, pa2, pa3); SBAR();
    pv_d0(o, vb0, pa0, pa1, pa2, pa3); dsa_partial(pB0, pB1, mwB, hi, m_reg, mnB, alB);
    RESC(alB);
    dsa_finish(pB0, pB1, alB, l_reg, pa0, pa1, pa2, pa3); SBAR();
    pv_d0(o, vb0 + SHM_V, pa0, pa1, pa2, pa3);
    __syncthreads();
#undef SLOAD_E
#undef SLOAD_O
#undef SWRITE_E
#undef SWRITE_O
#undef SWAIT
#undef RESC
    if (hi == 0) wsl[32 + r32] = l_reg; asm volatile("s_waitcnt lgkmcnt(0)" ::: "memory");
    float rn[16];
#pragma unroll
    for (int r = 0; r < 16; ++r) { const float il = 1.0f / wsl[32 + crow(r, hi)];
#pragma unroll
        for (int d = 0; d < 4; ++d) o[d][r] *= il;
        float ss = (o[0][r] * o[0][r] + o[1][r] * o[1][r]) + (o[2][r] * o[2][r] + o[3][r] * o[3][r]);
#pragma unroll
        for (int x = 1; x < 32; x <<= 1) ss += __shfl_xor(ss, x);
        rn[r] = 1.0f / sqrtf(ss * (1.0f / HD) + EPS); }
    epi_rows(lds, o, rn, proj + (size_t)(44 + h) * PHS + (tok0 + tw0) * 128, gain + h * HD, mixed + (tok0 + tw0) * DM + 1024 + h * HD, wid, lane);
    asm volatile("s_waitcnt lgkmcnt(0)" ::: "memory");
}
}

namespace idx {
#define ILAS __attribute__((address_space(3)))
using bf16x8 = __attribute__((ext_vector_type(8))) short;
using f32x16 = __attribute__((ext_vector_type(16))) float;
constexpr int L_SC = 0, L_HIST = 131072, L_CAND = 131072 + 8192, L_TCTR = 131072 + 16384, CAND_CAP = 256;
__device__ __forceinline__ int lbin(float v, float mn, float scale) { return (int)fminf(fmaxf((v - mn) * scale, 0.f), 255.f); }
__device__ __forceinline__ void index_unit(ILAS unsigned char* lds, const bf16_t* __restrict__ proj, const float* __restrict__ iw, unsigned long long* __restrict__ mask, int b, int t0, int uidx) {
    int tid_ = threadIdx.x; asm volatile("" : "+v"(tid_)); const int tid = tid_, wid = __builtin_amdgcn_readfirstlane(tid >> 6), lane = tid & 63, r = lane & 31, hi = lane >> 5;
    const size_t tok0 = (size_t)b * SEQ;
    ILAS unsigned* sc = (ILAS unsigned*)(lds + L_SC);
    ILAS unsigned* tctr = (ILAS unsigned*)(lds + L_TCTR);
    {
        bf16x8 af[4][4]; float wv[4][16];
#pragma unroll
        for (int T = 0; T < 4; ++T) {
            const bf16_t* qb = proj + IQF_OFF + ((((tok0 + t0) >> 3) * 4 + T) * 4 * 64 + lane) * 8;
#pragma unroll
            for (int ks = 0; ks < 4; ++ks) af[T][ks] = *(const bf16x8*)(qb + ks * 512);
            const float* wp = iw + (tok0 + t0 + 2 * T + hi) * 16;
#pragma unroll
            for (int i = 0; i < 4; ++i) { const f32x4 w4 = *(const f32x4*)(wp + 4 * i); wv[T][4 * i] = w4.x; wv[T][4 * i + 1] = w4.y; wv[T][4 * i + 2] = w4.z; wv[T][4 * i + 3] = w4.w; }
        }
        const int nt32 = 2 * ((t0 + 8 + 63) >> 6), nt32p = (nt32 + 15) & ~15;
        const bf16_t* kb = proj + IKC_OFF + (tok0 >> 5) * (4 * 64 * 8) + lane * 8;
        bf16x8 b0[4], b1[4], b2[4];
#define KLOAD(dst, j) do { _Pragma("unroll") for (int ks = 0; ks < 4; ++ks) dst[ks] = *(const bf16x8*)(kb + (size_t)(j) * (4 * 64 * 8) + ks * 512); } while (0)
#define CLAIM(dst) do { unsigned c_ = 0u; if (lane == 0) c_ = __hip_atomic_fetch_add(tctr + (uidx & 1), 1u, __ATOMIC_RELAXED, __HIP_MEMORY_SCOPE_WORKGROUP); dst = __builtin_amdgcn_readfirstlane((int)c_); } while (0)
        int j0, j1, j2;
        CLAIM(j0); CLAIM(j1);
        if (j0 < nt32) KLOAD(b0, j0);
        if (j1 < nt32) KLOAD(b1, j1);
        while (j0 < nt32p) {
            CLAIM(j2);
            if (j2 < nt32) KLOAD(b2, j2);
            const int key0 = 32 * j0;
            if (j0 < nt32) {
#pragma unroll
                for (int T = 0; T < 4; ++T) {
                    f32x16 acc = {};
#pragma unroll
                    for (int ks = 0; ks < 4; ++ks) acc = __builtin_amdgcn_mfma_f32_32x32x16_bf16(af[T][ks], b0[ks], acc, 0, 0, 0);
                    float sv = 0.f;
#pragma unroll
                    for (int rr = 0; rr < 16; ++rr) sv = fmaf(wv[T][rr], relu_i(acc[rr]), sv);
                    const int q = 2 * T + hi, key = key0 + r;
                    sc[q * SEQ + key] = (key <= t0 + q) ? __float_as_uint(sv) : 0xff800000u;
                }
            } else {
#pragma unroll
                for (int T = 0; T < 4; ++T) sc[(2 * T + hi) * SEQ + key0 + r] = 0xff800000u;
            }
#pragma unroll
            for (int ks = 0; ks < 4; ++ks) { b0[ks] = b1[ks]; b1[ks] = b2[ks]; }
            j0 = j1; j1 = j2;
        }
#undef KLOAD
#undef CLAIM
    }
    asm volatile("s_waitcnt lgkmcnt(0)" ::: "memory");
    __syncthreads();
    if (tid == 0) tctr[(uidx + 1) & 1] = 0u;
    const int t = t0 + wid, N = t + 1, NE = (N + 63) >> 6, NE8 = (NE + 7) & ~7;
    const ILAS unsigned* myrow = sc + wid * SEQ + lane;
    float v[64];
#pragma unroll
    for (int c = 0; c < 8; ++c) {
        if (8 * c < NE8) {
#pragma unroll
            for (int i = 0; i < 8; ++i) v[8 * c + i] = __uint_as_float(myrow[64 * (8 * c + i)]);
        } else {
#pragma unroll
            for (int i = 0; i < 8; ++i) v[8 * c + i] = -INFINITY;
        }
    }
    asm volatile("s_waitcnt lgkmcnt(0)" ::: "memory");
    __syncthreads();
    unsigned long long myw = 0ull;
    if (N <= TOPK) {
        for (int e = 0; e < NE; ++e) { const unsigned long long bm = __ballot(64 * e + lane <= t); if (lane == e) myw = bm; }
    } else {
        ILAS unsigned* hist = (ILAS unsigned*)(lds + L_HIST) + wid * 256;
        ILAS unsigned* cand = (ILAS unsigned*)(lds + L_CAND) + wid * CAND_CAP;
        float mx = -INFINITY, mn = INFINITY;
#pragma unroll
        for (int c = 0; c < 8; ++c) if (8 * c < NE8) {
            if (64 * (8 * c + 8) <= N) {
#pragma unroll
                for (int i = 0; i < 8; ++i) { mx = fmaxf(mx, v[8 * c + i]); mn = fminf(mn, v[8 * c + i]); }
            } else {
#pragma unroll
                for (int i = 0; i < 8; ++i) { mx = fmaxf(mx, v[8 * c + i]); mn = fminf(mn, (64 * (8 * c + i) + lane <= t) ? v[8 * c + i] : INFINITY); }
            }
        }
        mx = wave_max_dpp(mx); mn = wave_min_dpp(mn);
        const float scale = (mx > mn) ? 256.0f / (mx - mn) : 0.f;
        *(ILAS u32x4*)(hist + 4 * lane) = (u32x4){0u, 0u, 0u, 0u};
        asm volatile("s_waitcnt lgkmcnt(0)" ::: "memory");
#pragma unroll
        for (int c = 0; c < 8; ++c) if (8 * c < NE8) {
#pragma unroll
            for (int i = 0; i < 8; ++i) __hip_atomic_fetch_add(hist + lbin(v[8 * c + i], mn, scale), 1u, __ATOMIC_RELAXED, __HIP_MEMORY_SCOPE_WORKGROUP);
        }
        asm volatile("s_waitcnt lgkmcnt(0)" ::: "memory");
        int bstar, need; unsigned cb;
        {
            const u32x4 c4 = *(const ILAS u32x4*)(hist + 4 * lane);
            const unsigned s4 = (c4.x + c4.y) + (c4.z + c4.w);
            unsigned sl = s4;
#pragma unroll
            for (int off = 1; off < 64; off <<= 1) { const unsigned tt = __shfl_down(sl, off); if (lane + off < 64) sl += tt; }
            const unsigned long long bal = __ballot(sl >= (unsigned)TOPK);
            const int ls = 63 - __clzll((long long)bal);
            const unsigned above = (unsigned)__builtin_amdgcn_readlane((int)sl, ls) - (unsigned)__builtin_amdgcn_readlane((int)s4, ls);
            const unsigned cx = (unsigned)__builtin_amdgcn_readlane((int)c4.x, ls), cy = (unsigned)__builtin_amdgcn_readlane((int)c4.y, ls);
            const unsigned cz = (unsigned)__builtin_amdgcn_readlane((int)c4.z, ls), cw = (unsigned)__builtin_amdgcn_readlane((int)c4.w, ls);
            unsigned ab = above; int d;
            if (ab + cw >= (unsigned)TOPK) { d = 3; cb = cw; } else { ab += cw;
                if (ab + cz >= (unsigned)TOPK) { d = 2; cb = cz; } else { ab += cz;
                    if (ab + cy >= (unsigned)TOPK) { d = 1; cb = cy; } else { ab += cy; d = 0; cb = cx; } } }
            bstar = 4 * ls + d; need = TOPK - (int)ab;
        }
        unsigned tau; int req;
        if (cb <= (unsigned)CAND_CAP) {
            int base = 0;
#pragma unroll
            for (int c = 0; c < 8; ++c) if (8 * c < NE8) {
#pragma unroll
                for (int i = 0; i < 8; ++i) { const float vv = v[8 * c + i]; const bool in = lbin(vv, mn, scale) == bstar; const unsigned long long m = __ballot(in);
                    if (m != 0ull) { if (in) cand[base + __builtin_amdgcn_mbcnt_hi((unsigned)(m >> 32), __builtin_amdgcn_mbcnt_lo((unsigned)m, 0u))] = fkey(vv); base += __popcll(m); } }
            }
            asm volatile("s_waitcnt lgkmcnt(0)" ::: "memory");
            unsigned k0 = 0u, k1 = 0u, k2 = 0u, k3 = 0u; int c0 = 0, c1 = 0, c2 = 0, c3 = 0;
            const int ncb = (int)cb;
            if (lane < ncb) k0 = cand[lane]; if (64 + lane < ncb) k1 = cand[64 + lane]; if (128 + lane < ncb) k2 = cand[128 + lane]; if (192 + lane < ncb) k3 = cand[192 + lane];
            asm volatile("s_waitcnt lgkmcnt(0)" ::: "memory");
#define RANK_FROM(KV, OFS) do { const int nj_ = min(64, ncb - (OFS)); for (int jj = 0; jj < nj_; ++jj) { const unsigned kj = (unsigned)__builtin_amdgcn_readlane((int)(KV), jj); const int j = (OFS) + jj; \
                c0 += (kj > k0 || (kj == k0 && j < lane)) ? 1 : 0; \
                if (ncb > 64) { c1 += (kj > k1 || (kj == k1 && j < 64 + lane)) ? 1 : 0; c2 += (kj > k2 || (kj == k2 && j < 128 + lane)) ? 1 : 0; c3 += (kj > k3 || (kj == k3 && j < 192 + lane)) ? 1 : 0; } } } while (0)
            RANK_FROM(k0, 0); if (ncb > 64) RANK_FROM(k1, 64); if (ncb > 128) RANK_FROM(k2, 128); if (ncb > 192) RANK_FROM(k3, 192);
#undef RANK_FROM
            const unsigned long long h0 = __ballot(lane < ncb && c0 == need - 1), h1 = __ballot(64 + lane < ncb && c1 == need - 1), h2 = __ballot(128 + lane < ncb && c2 == need - 1), h3 = __ballot(192 + lane < ncb && c3 == need - 1);
            if (h0) tau = (unsigned)__builtin_amdgcn_readlane((int)k0, __builtin_ctzll(h0)); else if (h1) tau = (unsigned)__builtin_amdgcn_readlane((int)k1, __builtin_ctzll(h1));
            else if (h2) tau = (unsigned)__builtin_amdgcn_readlane((int)k2, __builtin_ctzll(h2)); else tau = (unsigned)__builtin_amdgcn_readlane((int)k3, __builtin_ctzll(h3));
            req = __popcll(__ballot(lane < ncb && c0 < need && k0 == tau)) + __popcll(__ballot(64 + lane < ncb && c1 < need && k1 == tau))
                + __popcll(__ballot(128 + lane < ncb && c2 < need && k2 == tau)) + __popcll(__ballot(192 + lane < ncb && c3 < need && k3 == tau));
        } else {
            unsigned pref = 0u; int krem = TOPK;
            for (int pass = 0; pass < 4; ++pass) {
                const int shift = 24 - 8 * pass;
                *(ILAS u32x4*)(hist + 4 * lane) = (u32x4){0u, 0u, 0u, 0u};
                asm volatile("s_waitcnt lgkmcnt(0)" ::: "memory");
#pragma unroll
                for (int c = 0; c < 8; ++c) if (8 * c < NE8) {
#pragma unroll
                    for (int i = 0; i < 8; ++i) { const unsigned k = fkey(v[8 * c + i]);
                        const bool mt = (pass == 0) ? true : ((k >> ((shift + 8) & 31)) == pref);
                        if (mt) __hip_atomic_fetch_add(hist + ((k >> shift) & 255u), 1u, __ATOMIC_RELAXED, __HIP_MEMORY_SCOPE_WORKGROUP); }
                }
                asm volatile("s_waitcnt lgkmcnt(0)" ::: "memory");
                const u32x4 c4 = *(const ILAS u32x4*)(hist + 4 * lane);
                const unsigned s4 = (c4.x + c4.y) + (c4.z + c4.w);
                unsigned sl = s4;
#pragma unroll
                for (int off = 1; off < 64; off <<= 1) { const unsigned tt = __shfl_down(sl, off); if (lane + off < 64) sl += tt; }
                const unsigned long long bal = __ballot(sl >= (unsigned)krem);
                const int ls = 63 - __clzll((long long)bal);
                const unsigned above = (unsigned)__builtin_amdgcn_readlane((int)sl, ls) - (unsigned)__builtin_amdgcn_readlane((int)s4, ls);
                const unsigned cx = (unsigned)__builtin_amdgcn_readlane((int)c4.x, ls), cy = (unsigned)__builtin_amdgcn_readlane((int)c4.y, ls);
                const unsigned cz = (unsigned)__builtin_amdgcn_readlane((int)c4.z, ls), cw = (unsigned)__builtin_amdgcn_readlane((int)c4.w, ls);
                unsigned ab = above; int d;
                if (ab + cw >= (unsigned)krem) d = 3; else { ab += cw;
                    if (ab + cz >= (unsigned)krem) d = 2; else { ab += cz;
                        if (ab + cy >= (unsigned)krem) d = 1; else { ab += cy; d = 0; } } }
                pref = (pref << 8) | (unsigned)(4 * ls + d); krem -= (int)ab;
            }
            tau = pref; req = krem;
        }
        int rleft = req; int wlo = 0, whi = 0;
        const float tauf = __uint_as_float((tau & 0x80000000u) ? (tau & 0x7fffffffu) : ~tau);
#pragma unroll
        for (int c = 0; c < 8; ++c) if (8 * c < NE8) {
#pragma unroll
            for (int i = 0; i < 8; ++i) { const float vv = v[8 * c + i];
                const unsigned long long gt = __ballot(vv > tauf); unsigned long long em = __ballot(vv == tauf), take = 0ull;
                if (em != 0ull) { const int cnt = __popcll(em);
                    if (cnt <= rleft) { take = em; rleft -= cnt; }
                    else { while (rleft > 0) { const unsigned long long bb = em & (~em + 1ull); take |= bb; em ^= bb; --rleft; } } }
                const unsigned long long bm = gt | take;
                if (lane == 8 * c + i) { wlo = (int)(unsigned)bm; whi = (int)(unsigned)(bm >> 32); }
            }
        }
        myw = ((unsigned long long)(unsigned)whi << 32) | (unsigned long long)(unsigned)wlo;
    }
    mask[(tok0 + t) * 64 + lane] = myw;
}
}

#define LAS __attribute__((address_space(3)))
#define RLX_AGENT __ATOMIC_RELAXED, __HIP_MEMORY_SCOPE_AGENT
#define XB_TMO      128
#define XB_XCNT(j)  (256  + 64 * (j))
#define XB_XSUB(j)  (1280 + 64 * (j))
#define XB_XGEN(j)  (2304 + 64 * (j))
#define XB_TOP      3328
#define XB_TOPGEN   3392
#define XCD_BAR_WORDS 3456
#define XB_SPIN_CAP (1u << 18)

__device__ __forceinline__ unsigned xb_ld(unsigned* p)              { return __hip_atomic_load(p, __ATOMIC_RELAXED, __HIP_MEMORY_SCOPE_AGENT); }
__device__ __forceinline__ unsigned xb_add(unsigned* p, unsigned v) { return __hip_atomic_fetch_add(p, v, __ATOMIC_RELAXED, __HIP_MEMORY_SCOPE_AGENT); }
__device__ __forceinline__ unsigned xb_xcc_id() { return (unsigned)__builtin_amdgcn_s_getreg((3 << 11) | 20) & 0xFu; }
#define XB_SPIN(cond, bar) do { unsigned _sp = 0; while (cond) { __builtin_amdgcn_s_sleep(1); \
    if ((++_sp & 255u) == 0u) { if (xb_ld(&(bar)[XB_TMO])) break; if (_sp > XB_SPIN_CAP) { atomicAdd(&(bar)[XB_TMO], 1u); break; } } } } while (0)

struct XcdBarrier {
    unsigned* bar; unsigned x;
    volatile LAS unsigned* st;
};

__device__ __forceinline__ XcdBarrier xcd_barrier_post(unsigned* bar, volatile LAS unsigned* st) {
    XcdBarrier b; b.bar = bar; b.x = xb_xcc_id(); b.st = st;
    if (threadIdx.x == 0) (void)xb_add(&bar[XB_XCNT(b.x)], 1u);
    return b;
}
__device__ __forceinline__ void xcd_barrier_complete(unsigned* bar, unsigned x, unsigned& nloc, unsigned& nx) {
    const unsigned G = gridDim.x * gridDim.y * gridDim.z;
    unsigned sum, cnt, mine, sp = 0u;
    for (;;) {
        sum = 0u; cnt = 0u; mine = 0u;
#pragma unroll
        for (unsigned j = 0; j < 16; ++j) { const unsigned c = xb_ld(&bar[XB_XCNT(j)]); sum += c; cnt += (c > 0u) ? 1u : 0u; mine = (j == x) ? c : mine; }
        if (sum == G) break;
        __builtin_amdgcn_s_sleep(1);
        if ((++sp & 255u) == 0u) { if (xb_ld(&bar[XB_TMO])) break; if (sp > XB_SPIN_CAP) { atomicAdd(&bar[XB_TMO], 1u); break; } }
    }
    nloc = mine > 0u ? mine : 1u; nx = cnt > 0u ? cnt : 1u;
}

__device__ __forceinline__ void xcd_barrier(const XcdBarrier& b) {
    asm volatile("s_waitcnt vmcnt(0)" ::: "memory");
    __syncthreads();
    if (threadIdx.x == 0) {
        unsigned* bar = b.bar;
        __builtin_amdgcn_s_waitcnt(0);
        unsigned nloc = b.st[0], nx = b.st[1];
        if (nloc == 0u) { xcd_barrier_complete(bar, b.x, nloc, nx); b.st[0] = nloc; b.st[1] = nx; }
        const unsigned old = xb_add(&bar[XB_XSUB(b.x)], 1u);
        const unsigned gen = old / nloc;
        if (old + 1u == (gen + 1u) * nloc) {
            __builtin_amdgcn_fence(__ATOMIC_RELEASE, "agent");
            asm volatile("s_waitcnt vmcnt(0)" ::: "memory");
            const unsigned og = xb_add(&bar[XB_TOP], 1u);
            const unsigned tg = og / nx;
            if (og + 1u == (tg + 1u) * nx) xb_add(&bar[XB_TOPGEN], 1u);
            else XB_SPIN(xb_ld(&bar[XB_TOPGEN]) == tg, bar);
            __builtin_amdgcn_fence(__ATOMIC_ACQUIRE, "agent");
            xb_add(&bar[XB_XGEN(b.x)], 1u);
            asm volatile("s_waitcnt vmcnt(0)" ::: "memory");
        } else {
            XB_SPIN(xb_ld(&bar[XB_XGEN(b.x)]) == gen, bar);
            __builtin_amdgcn_fence(__ATOMIC_ACQUIRE, "agent");
            asm volatile("s_waitcnt vmcnt(0)" ::: "memory");
        }
    }
    __syncthreads();
}

#define GAS __attribute__((address_space(1)))
#define LDS_WAIT() asm volatile("s_waitcnt lgkmcnt(0)" ::: "memory")
constexpr int NWAVES = 8, LDS_BYTES = 149504;

struct Args { const float* x; const int* pos; const float* norm_g; const float* w_in; const float* sb_g; const float* dsa_g; const float* w_out; const float* final_g; float* out; unsigned char* ws; int ph_lo, ph_hi; };

__device__ __forceinline__ void transpose_item(const float* __restrict__ W, int K, int N, int NPAD, bf16_t* __restrict__ WT, LAS float* scr, int item, int lane) {
    const int nblk = NPAD / 32, kb = item / nblk, nb = item % nblk, k0 = 64 * kb, n0 = 32 * nb;
    const int n = n0 + (lane & 31); const bool ok = n < N;
    float tv[32];
#pragma unroll
    for (int i = 0; i < 32; ++i) tv[i] = ok ? W[(size_t)(k0 + 2 * i + (lane >> 5)) * N + n] : 0.f;
#pragma unroll
    for (int i = 0; i < 32; ++i) scr[(2 * i + (lane >> 5)) * 33 + (lane & 31)] = tv[i];
    LDS_WAIT();
    const int c = lane & 7;
#pragma unroll
    for (int j = 0; j < 4; ++j) { const int nn = (lane >> 3) + 8 * j; const LAS float* s = scr + (8 * c) * 33 + nn;
        u32x4 o; o.x = pk2(s[0 * 33], s[1 * 33]); o.y = pk2(s[2 * 33], s[3 * 33]); o.z = pk2(s[4 * 33], s[5 * 33]); o.w = pk2(s[6 * 33], s[7 * 33]);
        *(u32x4*)(WT + (size_t)(n0 + nn) * K + k0 + 8 * c) = o; }
    LDS_WAIT();
}
__device__ __forceinline__ void rmsnorm_4rows_bf16(const float* __restrict__ x, const float* __restrict__ g, bf16_t* __restrict__ hn, int m0, int mstep, int lane) {
    f32x4 v[4][8]; float ss[4];
#pragma unroll
    for (int q = 0; q < 4; ++q) { const int m = min(m0 + q * mstep, NTOK - 1); const f32x4* xr = (const f32x4*)(x + (size_t)m * DM) + lane;
#pragma unroll
        for (int j = 0; j < 8; ++j) v[q][j] = xr[64 * j]; }
#pragma unroll
    for (int q = 0; q < 4; ++q) { float s = 0.f;
#pragma unroll
        for (int j = 0; j < 8; ++j) s += (v[q][j].x * v[q][j].x + v[q][j].y * v[q][j].y) + (v[q][j].z * v[q][j].z + v[q][j].w * v[q][j].w);
        ss[q] = 1.0f / sqrtf(wave_sum_dpp(s) * (1.0f / DM) + EPS); }
    const f32x4* gr = (const f32x4*)g + lane;
#pragma unroll
    for (int j = 0; j < 8; ++j) { const f32x4 gg = gr[64 * j];
#pragma unroll
        for (int q = 0; q < 4; ++q) { const int m = m0 + q * mstep; if (m < NTOK) { const float r = ss[q]; u32x2 w;
            w.x = pk2(v[q][j].x * r * gg.x, v[q][j].y * r * gg.y); w.y = pk2(v[q][j].z * r * gg.z, v[q][j].w * r * gg.w);
            ((u32x2*)(hn + (size_t)m * DM) + lane)[64 * j] = w; } } }
}

__global__ void __launch_bounds__(NWAVES * 64, 2) mega(Args a) {
    extern __shared__ __attribute__((aligned(16))) unsigned char lds_raw[];
    LAS unsigned char* lds = (LAS unsigned char*)lds_raw;
    int tid_ = threadIdx.x; asm volatile("" : "+v"(tid_)); const int tid = tid_, lane = tid & 63, wave = __builtin_amdgcn_readfirstlane(tid >> 6);
    const int G = gridDim.x, bx = blockIdx.x;
    unsigned char* ws = a.ws;
    bf16_t* HN = (bf16_t*)(ws + WS_HN); bf16_t* WT1 = (bf16_t*)(ws + WS_WT1); bf16_t* WT2 = (bf16_t*)(ws + WS_WT2);
    float* IW = (float*)(ws + WS_IW); float* R128 = (float*)(ws + WS_R128); float* R64 = (float*)(ws + WS_R64); bf16_t* PROJ = (bf16_t*)(ws + WS_PROJ);
    bf16_t* MIXED = (bf16_t*)(ws + WS_MIXED); bf16_t* YB = (bf16_t*)(ws + WS_PROJ); float* SSP = (float*)(ws + WS_SSP); unsigned long long* MASKW = (unsigned long long*)(ws + WS_MASK); const unsigned long long* MASK = MASKW;
    const int lo = a.ph_lo, hi = a.ph_hi;
#define IN(k) (lo <= (k) && (k) < hi)
    if (tid < 2) ((volatile LAS unsigned*)(lds + LDS_BYTES - 64))[tid] = 0u;
    __syncthreads();
    unsigned* const xbw = (unsigned*)(ws + WS_CTL) + 4096;
    unsigned* const pcnt = (unsigned*)(ws + WS_CTL) + 16384;
    if (bx == 0) for (int i = tid; i < XCD_BAR_WORDS; i += NWAVES * 64) __hip_atomic_store(xbw + i, 0u, __ATOMIC_RELAXED, __HIP_MEMORY_SCOPE_AGENT);
    if (bx == 0) for (int i = tid; i < 64 * 64; i += NWAVES * 64) __hip_atomic_store(pcnt + i, 0u, __ATOMIC_RELAXED, __HIP_MEMORY_SCOPE_AGENT);
    XcdBarrier xbar; xbar.bar = xbw; xbar.x = 0u; xbar.st = (volatile LAS unsigned*)(lds + LDS_BYTES - 64);
#define SEAM(k) do { if (IN(k) && IN((k) + 1)) { if ((k) == 0) { cooperative_groups::this_grid().sync(); xbar = xcd_barrier_post(xbw, (volatile LAS unsigned*)(lds + LDS_BYTES - 64)); } else xcd_barrier(xbar); } } while (0)

    if (IN(0)) {
        const int gw = bx * NWAVES + wave, NGW = G * NWAVES;
        LAS float* scr = (LAS float*)(lds + wave * 16384);
        constexpr int I1 = (DM / 64) * (NP / 32), I2 = (DM / 64) * (DM / 32);
        {
            static const double IRV[16] = {0.15915494309189535, 0.070086521587798503, 0.03086376340470123, 0.013591370636193905, 0.0059851857127137054, 0.002635675898667414, 0.001160663641240061, 0.00051111750453754386,
                                           0.00022507907903927653, 9.9117309369019355e-05, 4.3647952792802891e-05, 1.9221100684944863e-05, 8.4643308082414014e-06, 3.7274086019153519e-06, 1.6414262627950345e-06, 7.2282930688328648e-07};
            for (int i = bx * (NWAVES * 64) + tid; i < NTOK * 24; i += G * NWAVES * 64) {
                const int tok = i / 24, j = i % 24; const double rev = (double)a.pos[tok] * IRV[j < 16 ? j : 2 * (j - 16)];
                const float rr = (float)(rev - floor(rev)); const float sn = __builtin_amdgcn_sinf(rr), cs = __builtin_amdgcn_cosf(rr);
                if (j < 16) { R128[tok * 32 + j] = cs; R128[tok * 32 + 16 + j] = sn; } else { R64[tok * 16 + (j - 16)] = cs; R64[tok * 16 + 8 + (j - 16)] = sn; }
            }
        }

        for (int it = gw; it < I1 + I2; it += NGW) {
            if (it < I1) transpose_item(a.w_in, DM, D_IN, NP, WT1, scr, it, lane);
            else transpose_item(a.w_out, DM, DM, DM, WT2, scr, it - I1, lane);
        }

        for (int m = gw; m < NTOK; m += 4 * NGW) rmsnorm_4rows_bf16(a.x, a.norm_g, HN, m, NGW, lane);

    }
    SEAM(0);
    if (IN(1)) {
        pg8::Gemm g{HN, WT1, NTOK, NP, DM}; pg8::StaticOrder S; S.init(NTOK, NP, G, bx);
        pg8::EpiProj E{PROJ, IW, R128, R64};
        pg8::gemm_phase<pg8::EpiProj, pg8::StaticOrder, true, true>(lds, g, S, E);
    }
    SEAM(1);
    if (IN(2)) {
        const int vcu = (G % 8 == 0) ? (bx % 8) * (G / 8) + bx / 8 : bx;
        if (tid < 2) ((LAS unsigned*)(lds + idx::L_TCTR))[tid] = 0u;
        __syncthreads();
        for (int k = 0;; ++k) {
            const int sI = k * G + ((k & 1) ? (G - 1 - vcu) : vcu);
            if (sI >= NTOK / 8) break;
            idx::index_unit(lds, PROJ, IW, MASKW, sI & 3, 8 * (511 - (sI >> 2)), k);
        }
        __syncthreads();
    }

    SEAM(2);
    if (IN(3)) {
        const int vcu = (G % 8 == 0) ? (bx % 8) * (G / 8) + bx / 8 : bx;
        for (int p = vcu; p < BATCH * SBH * 8; p += G) {
            const int bh = p >> 3, sI = p & 7, b = bh / SBH, h = bh % SBH;
            for (int k = 0; k < 2; ++k) att::sb_unit<true>(lds, PROJ, a.sb_g, MIXED, b, h, k == 0 ? 15 - sI : sI);
        }
    }

    if (IN(3)) {
        const int vcu = (G % 8 == 0) ? (bx % 8) * (G / 8) + bx / 8 : bx;
        for (int p = vcu; p < BATCH * DSH * 8; p += G) {
            const int bh = p >> 3, sI = p & 7, b = bh / DSH, h = bh % DSH;
            for (int k = 0; k < 2; ++k) att::dsa_unit(lds, PROJ, MASK, a.dsa_g, MIXED, b, h, k == 0 ? 15 - sI : sI);
        }
    }

    SEAM(3);
    if (IN(4)) {
        pg8::Gemm g{MIXED, WT2, NTOK, DM, DM}; pg8::StaticOrder S; S.init(NTOK, DM, G, bx);
        pg8::Unit u0_; S.next(0, u0_);
        pg8::EpiOut E{a.x, YB, SSP, a.out, a.final_g, pcnt, u0_.pn, (G == 256) ? 1 : 0};
        pg8::gemm_phase<pg8::EpiOut, pg8::StaticOrder, true, true>(lds, g, S, E);
    }
    if (G != 256) { SEAM(4); }
    if (IN(5) && G != 256) {
        const int gw = bx * NWAVES + wave, NGW = G * NWAVES;
        for (int m = gw; m < NTOK; m += NGW) {
            const float sp = (lane < 32) ? SSP[(size_t)m * 32 + lane] : 0.f;
            const float r = 1.0f / sqrtf(wave_sum(sp) * (1.0f / DM) + EPS);
            const u32x4* yr = (const u32x4*)(YB + (size_t)m * DM) + lane; const f32x4* gr = (const f32x4*)a.final_g + 2 * lane; f32x4* orow = (f32x4*)(a.out + (size_t)m * DM) + 2 * lane;
#pragma unroll
            for (int j = 0; j < 4; ++j) { const u32x4 v = yr[64 * j]; const f32x4 g0 = gr[128 * j], g1 = gr[128 * j + 1];
                orow[128 * j] = (f32x4){bf2f(v.x & 0xffffu) * r * g0.x, bf2f(v.x >> 16) * r * g0.y, bf2f(v.y & 0xffffu) * r * g0.z, bf2f(v.y >> 16) * r * g0.w};
                orow[128 * j + 1] = (f32x4){bf2f(v.z & 0xffffu) * r * g1.x, bf2f(v.z >> 16) * r * g1.y, bf2f(v.w & 0xffffu) * r * g1.z, bf2f(v.w >> 16) * r * g1.w}; }
        }
    }

#undef IN
#undef SEAM
}

extern "C" void kernel_launch(void* const* d_in, const int* in_sizes, int n_in, void* d_out, int out_size, void* d_ws, size_t ws_size, hipStream_t stream) {
    static int grid = 0;
    if (grid == 0) {
        if (n_in != 8 || in_sizes[0] != NTOK * DM || out_size != NTOK * DM || ws_size < WS_END) {
            fprintf(stderr, "kernel_launch: shape mismatch n_in %d in0 %d out %d ws %zu (need %zu)\n", n_in, n_in > 0 ? in_sizes[0] : -1, out_size, ws_size, (size_t)WS_END); grid = -1; return; }
        int dev = 0, cus = 0;
        if (hipGetDevice(&dev) != hipSuccess || hipDeviceGetAttribute(&cus, hipDeviceAttributeMultiprocessorCount, dev) != hipSuccess) { grid = -1; return; }
        if (hipFuncSetAttribute((const void*)mega, hipFuncAttributeMaxDynamicSharedMemorySize, LDS_BYTES) != hipSuccess) { fprintf(stderr, "kernel_launch: hipFuncSetAttribute failed\n"); grid = -1; return; }
        int per_cu = 0;
        if (hipOccupancyMaxActiveBlocksPerMultiprocessor(&per_cu, (const void*)mega, NWAVES * 64, LDS_BYTES) != hipSuccess || per_cu < 1) { fprintf(stderr, "kernel_launch: occupancy query says %d blocks per CU\n", per_cu); grid = -1; return; }
        grid = cus;
    }
    if (grid < 0) return;
    const float* x = (const float*)d_in[0]; const float* sb_g = (const float*)d_in[4]; const float* dsa_g = (const float*)d_in[5]; const float* final_g = (const float*)d_in[7];
    unsigned char* ws = (unsigned char*)d_ws; float* out = (float*)d_out;
    bf16_t* MIXED = (bf16_t*)(ws + WS_MIXED); bf16_t* WT2 = (bf16_t*)(ws + WS_WT2);
    float* IW = (float*)(ws + WS_IW);
    unsigned long long* MASK = (unsigned long long*)(ws + WS_MASK); bf16_t* PROJ = (bf16_t*)(ws + WS_PROJ);
    Args a{};
    a.x = x; a.pos = (const int*)d_in[1]; a.norm_g = (const float*)d_in[2]; a.w_in = (const float*)d_in[3]; a.sb_g = sb_g; a.dsa_g = dsa_g; a.w_out = (const float*)d_in[6]; a.final_g = final_g;
    a.out = out; a.ws = ws;
    a.ph_lo = 0; a.ph_hi = 6;
    void* kargs[] = {(void*)&a};
    const hipError_t le = hipLaunchCooperativeKernel((const void*)mega, dim3(grid), dim3(NWAVES * 64), kargs, LDS_BYTES, stream);
    if (le != hipSuccess) fprintf(stderr, "kernel_launch: cooperative launch failed: %s (grid %d)\n", hipGetErrorString(le), grid);
}
```

```cpp
#include <hip/hip_runtime.h>
#include <cstdio>
#include <cstdint>
#include <hip/hip_cooperative_groups.h>

constexpr int BATCH = 4, SEQ = 4096, DM = 2048, NTOK = BATCH * SEQ;
constexpr int HD = 128, SBH = 8, DSH = 8, DKV = 2, IH = 16, ID = 64, TOPK = 256;
constexpr int D_IN = 7760, NP = 7936;
constexpr size_t PHS = (size_t)NTOK * 128;
constexpr size_t IQF_OFF = 52 * PHS;
constexpr size_t IKC_OFF = 60 * PHS;
constexpr int C_SBQ = 0, C_SBK = 1024, C_SBV = 2048, C_SBG = 3072, C_DQ = 4096, C_DK = 5120, C_DV = 5376, C_DG = 5632, C_IQ = 6656, C_IK = 7680, C_IW = 7744;
constexpr float EPS = 1e-6f;
constexpr float C2 = 0.08838834764831845f * 1.4426950408889634f;
constexpr float IWS = 1.0f / 32.0f;

constexpr size_t MiB = 1u << 20;
constexpr size_t WS_CTL = 0;
constexpr size_t WS_HN = 1 * MiB;
constexpr size_t WS_MIXED = WS_HN;
constexpr size_t WS_WT1 = 65 * MiB;
constexpr size_t WS_WT2 = 96 * MiB;
constexpr size_t WS_IW = 104 * MiB;
constexpr size_t WS_R128 = 105 * MiB;
constexpr size_t WS_R64 = 107 * MiB;
constexpr size_t WS_MASK = 108 * MiB;
constexpr size_t WS_PROJ = 116 * MiB;
constexpr size_t WS_SSP = 366 * MiB;
constexpr size_t WS_END = 368 * MiB;

#define WAVE_SYNC() asm volatile("s_waitcnt lgkmcnt(0)" ::: "memory")
typedef unsigned short bf16_t;
typedef float f32x4 __attribute__((ext_vector_type(4)));
typedef unsigned u32x4 __attribute__((ext_vector_type(4)));
typedef unsigned u32x2 __attribute__((ext_vector_type(2)));

__device__ __forceinline__ unsigned f2bf(float f) { unsigned u = __builtin_bit_cast(unsigned, f); return (u + 0x7fffu + ((u >> 16) & 1u)) >> 16; }
__device__ __forceinline__ float bf2f(unsigned h) { return __builtin_bit_cast(float, h << 16); }
__device__ __forceinline__ unsigned pk2(float lo, float hi) { return f2bf(lo) | (f2bf(hi) << 16); }
__device__ __forceinline__ float wave_sum(float v) {
#pragma unroll
    for (int o = 1; o < 64; o <<= 1) v += __shfl_xor(v, o);
    return v;
}
__device__ __forceinline__ float wave_max(float v) {
#pragma unroll
    for (int o = 1; o < 64; o <<= 1) v = fmaxf(v, __shfl_xor(v, o));
    return v;
}

template <int CTRL> __device__ __forceinline__ float dppf(float v) { return __builtin_bit_cast(float, __builtin_amdgcn_update_dpp(0, __builtin_bit_cast(int, v), CTRL, 0xf, 0xf, true)); }
__device__ __forceinline__ float wave_max_dpp(float v) {
    v = fmaxf(v, dppf<0xB1>(v)); v = fmaxf(v, dppf<0x4E>(v)); v = fmaxf(v, dppf<0x141>(v)); v = fmaxf(v, dppf<0x140>(v));
    const int iv = __builtin_bit_cast(int, v);
    const float a = __builtin_bit_cast(float, __builtin_amdgcn_readlane(iv, 0)), b = __builtin_bit_cast(float, __builtin_amdgcn_readlane(iv, 16)), c = __builtin_bit_cast(float, __builtin_amdgcn_readlane(iv, 32)), d = __builtin_bit_cast(float, __builtin_amdgcn_readlane(iv, 48));
    return fmaxf(fmaxf(a, b), fmaxf(c, d));
}
__device__ __forceinline__ float wave_sum_dpp(float v) {
    v += dppf<0xB1>(v); v += dppf<0x4E>(v); v += dppf<0x141>(v); v += dppf<0x140>(v);
    const int iv = __builtin_bit_cast(int, v);
    const float a = __builtin_bit_cast(float, __builtin_amdgcn_readlane(iv, 0)), b = __builtin_bit_cast(float, __builtin_amdgcn_readlane(iv, 16)), c = __builtin_bit_cast(float, __builtin_amdgcn_readlane(iv, 32)), d = __builtin_bit_cast(float, __builtin_amdgcn_readlane(iv, 48));
    return (a + b) + (c + d);
}
__device__ __forceinline__ float wave_min_dpp(float v) { return -wave_max_dpp(-v); }
__device__ __forceinline__ float relu_i(float x) { return __builtin_bit_cast(float, max(__builtin_bit_cast(int, x), 0)); }
__device__ __forceinline__ float max3_asm(float a, float b, float c) { float r; asm("v_max3_f32 %0, %1, %2, %3" : "=v"(r) : "v"(a), "v"(b), "v"(c)); return r; }
__device__ __forceinline__ unsigned fkey(float f) { unsigned u = __builtin_bit_cast(unsigned, f); return (u & 0x80000000u) ? ~u : (u | 0x80000000u); }

namespace pg8 {
#define PG8_LAS __attribute__((address_space(3)))
typedef unsigned short bf16_t;
typedef short bf16x8 __attribute__((ext_vector_type(8)));
typedef float f32x4 __attribute__((ext_vector_type(4)));
typedef unsigned u32x4 __attribute__((ext_vector_type(4)));
constexpr int BM = 256, BK = 64, HALF = 128, HTB = HALF * BK * 2  , STAGE_BYTES = 8 * HTB, NXCD = 8, WGM = 8;

__host__ __device__ __forceinline__ int lds_byte(int r, int c) { const int st = (r >> 4) * 2 + (c >> 5), rr = r & 15, cc = c & 31, ob = rr * 64 + cc * 2; return st * 1024 + (ob ^ (((ob >> 9) & 1) << 5)); }
__host__ __device__ __forceinline__ void stage_rc(int b, int& R, int& C) { const int st = b / 1024, sb = b % 1024, swz = sb ^ (((sb >> 9) & 1) << 5); R = (st >> 1) * 16 + swz / 64; C = (st & 1) * 32 + (swz % 64) / 2; }
__host__ __device__ __forceinline__ int perm32(int rho) { const int n = rho >> 4, i = rho & 15; return 8 * (i >> 2) + 4 * n + (i & 3); }

struct Unit { int pm, pn; };
struct Gemm { const bf16_t* A; const bf16_t* Bt; int M, N, K; };

struct StaticOrder {
    int nM, nN, nwg, G, c;
    __host__ __device__ void init(int M, int N, int G_, int c_) { nM = M / BM; nN = N / BM; nwg = nM * nN; G = G_; c = c_; }
    __host__ __device__ __forceinline__ bool next(int i, Unit& u) const {
        const long L = (long)i * G + c; if (L >= nwg) return false;
        int wgid = (int)L; { const int q = nwg / NXCD, r = nwg % NXCD, xcd = wgid % NXCD, off = wgid / NXCD; wgid = (xcd < r ? xcd * (q + 1) : r * (q + 1) + (xcd - r) * q) + off; }
        const int nig = WGM * nN, gid = wgid / nig, fm = gid * WGM, gsz = (nM - fm) < WGM ? (nM - fm) : WGM;
        u.pm = fm + ((wgid % nig) % gsz); u.pn = (wgid % nig) / gsz; return true;
    }
    __device__ __forceinline__ void a_ready(const Unit&) const {}
    __device__ __forceinline__ void done(const Unit&) const {}
};
}

namespace pg8 {
__device__ __forceinline__ unsigned cvt_pk_bf16(float lo, float hi) { unsigned r; asm volatile("v_cvt_pk_bf16_f32 %0, %1, %2" : "=v"(r) : "v"(lo), "v"(hi)); return r; }
struct EpiProj {
    static constexpr bool PERM = true, AFTER_DRAIN = false, LAST_FUSED = false;
    bf16_t* proj; float* iw; const float* r128; const float* r64;
    __device__ __forceinline__ void operator()(const f32x4 (&acc)[2][2][4][2], const Unit& u, int wr, int wc, int fr, int fq) const {
        const int pn = u.pn;
        const int row0 = u.pm * BM + wr * 64 + fr, col0 = pn * BM + wc * 32 + 8 * fq;
        const bool rope128 = (pn >= 16 && pn <= 20) && wc == 0;
        const bool rope64 = ((pn >= 26 && pn <= 29) && (wc & 1) == 0) || (pn == 30 && wc == 0);
        const bool iwt = (pn == 30 && wc == 2);
        const float sc = (pn < 4 || (pn >= 16 && pn < 20)) ? C2 : 1.f;
#pragma unroll
        for (int ai = 0; ai < 2; ++ai)
#pragma unroll
            for (int m = 0; m < 4; ++m) {
                const int row = row0 + ai * HALF + m * 16;
                f32x4 cs0 = {1.f, 1.f, 1.f, 1.f}, cs1 = cs0, sn0 = {0.f, 0.f, 0.f, 0.f}, sn1 = sn0;
                if (rope128) { const float* t = r128 + (size_t)row * 32 + 8 * (fq & 1); cs0 = *(const f32x4*)t; cs1 = *(const f32x4*)(t + 4); sn0 = *(const f32x4*)(t + 16); sn1 = *(const f32x4*)(t + 20);
                    if (fq < 2) { sn0 = -sn0; sn1 = -sn1; } }
                if (rope64) { const float* t = r64 + (size_t)row * 16; cs0 = *(const f32x4*)t; cs1 = *(const f32x4*)(t + 4); sn0 = *(const f32x4*)(t + 8); sn1 = *(const f32x4*)(t + 12);
                    if (fq == 0) { sn0 = -sn0; sn1 = -sn1; } if (fq >= 2) { cs0 = (f32x4){1.f, 1.f, 1.f, 1.f}; cs1 = cs0; sn0 = (f32x4){0.f, 0.f, 0.f, 0.f}; sn1 = sn0; } }
#pragma unroll
                for (int bj = 0; bj < 2; ++bj) {
                    f32x4 v0 = acc[ai][bj][m][0] * sc, v1 = acc[ai][bj][m][1] * sc;
                    if (rope128 || (rope64 && (pn != 30 || bj == 0))) {
                        const int xm = rope128 ? 32 : 16;
                        f32x4 p0, p1;
#pragma unroll
                        for (int e = 0; e < 4; ++e) { p0[e] = __shfl_xor(v0[e], xm); p1[e] = __shfl_xor(v1[e], xm); }
                        v0 = v0 * cs0 + p0 * sn0; v1 = v1 * cs1 + p1 * sn1;
                    }
                    if (iwt && bj == 0 && fq < 2) { float* ip = iw + (size_t)row * 16 + 8 * fq; *(f32x4*)ip = v0 * IWS; *(f32x4*)(ip + 4) = v1 * IWS; }
                    u32x4 w; w.x = cvt_pk_bf16(v0[0], v0[1]); w.y = cvt_pk_bf16(v0[2], v0[3]); w.z = cvt_pk_bf16(v1[0], v1[1]); w.w = cvt_pk_bf16(v1[2], v1[3]);
                    if (pn < 26) *(u32x4*)(proj + (size_t)(2 * pn + bj) * PHS + (size_t)row * 128 + wc * 32 + 8 * fq) = w;
                    else if (pn < 30) {
                        const int c = (pn - 26) * 256 + 128 * bj + 32 * wc + 8 * fq, head = c >> 6, ks = (c >> 4) & 3, hi_ = (c >> 3) & 1;
                        const int rho = (head & 3) + 4 * (row & 1) + 8 * (head >> 2);
                        *(u32x4*)(proj + IQF_OFF + ((((size_t)(row >> 3) * 4 + ((row >> 1) & 3)) * 4 + ks) * 64 + hi_ * 32 + rho) * 8) = w;
                    } else if (bj == 0 && wc < 2) {
                        const int c = 32 * wc + 8 * fq, ks = c >> 4, hi_ = (c >> 3) & 1;
                        *(u32x4*)(proj + IKC_OFF + ((((size_t)(row >> 5)) * 4 + ks) * 64 + hi_ * 32 + (row & 31)) * 8) = w;
                    }
                }
            }
    }
};
}

namespace pg8 {
struct EpiOut {
    static constexpr bool PERM = true, AFTER_DRAIN = false, LAST_FUSED = true;
    const float* x; bf16_t* yb; float* ssp;
    float* out; const float* fg; unsigned* cnt; int pn0; int fuse;
    __device__ __forceinline__ void operator()(const f32x4 (&acc)[2][2][4][2], const Unit& u, int wr, int wc, int fr, int fq) const {
        const int row0 = u.pm * BM + wr * 64 + fr, col0 = u.pn * BM + wc * 32 + 8 * fq;
#pragma unroll
        for (int ai = 0; ai < 2; ++ai)
#pragma unroll
            for (int m = 0; m < 4; ++m) {
                const int row = row0 + ai * HALF + m * 16; const size_t off = (size_t)row * DM + col0; float s = 0.f;
#pragma unroll
                for (int bj = 0; bj < 2; ++bj) {
                    const f32x4 y0 = *(const f32x4*)(x + off + bj * HALF) + acc[ai][bj][m][0], y1 = *(const f32x4*)(x + off + bj * HALF + 4) + acc[ai][bj][m][1];
                    u32x4 w; w.x = cvt_pk_bf16(y0[0], y0[1]); w.y = cvt_pk_bf16(y0[2], y0[3]); w.z = cvt_pk_bf16(y1[0], y1[1]); w.w = cvt_pk_bf16(y1[2], y1[3]);
                    *(u32x4*)(yb + off + bj * HALF) = w;
                    s += (y0[0] * y0[0] + y0[1] * y0[1]) + (y0[2] * y0[2] + y0[3] * y0[3]) + (y1[0] * y1[0] + y1[1] * y1[1]) + (y1[2] * y1[2] + y1[3] * y1[3]);
                }
                s += __shfl_xor(s, 16); s += __shfl_xor(s, 32);
                if (fq == 0) ssp[(size_t)row * 32 + u.pn * 4 + wc] = s;
            }
    }
    __device__ __forceinline__ void fused(f32x4 (&acc)[2][2][4][2], const Unit& u, int wr, int wc, int fr, int fq, PG8_LAS unsigned char* lds, int wid, int lane) const {
        if (!fuse) { (*this)(acc, u, wr, wc, fr, fq); return; }
        const int row0 = u.pm * BM + wr * 64 + fr, col0 = u.pn * BM + wc * 32 + 8 * fq;
#pragma unroll
        for (int ai = 0; ai < 2; ++ai)
#pragma unroll
            for (int m = 0; m < 4; ++m) {
                const int row = row0 + ai * HALF + m * 16; const size_t off = (size_t)row * DM + col0; float s = 0.f;
#pragma unroll
                for (int bj = 0; bj < 2; ++bj) {
                    const f32x4 y0 = *(const f32x4*)(x + off + bj * HALF) + acc[ai][bj][m][0], y1 = *(const f32x4*)(x + off + bj * HALF + 4) + acc[ai][bj][m][1];
                    acc[ai][bj][m][0] = y0; acc[ai][bj][m][1] = y1;
                    s += (y0[0] * y0[0] + y0[1] * y0[1]) + (y0[2] * y0[2] + y0[3] * y0[3]) + (y1[0] * y1[0] + y1[1] * y1[1]) + (y1[2] * y1[2] + y1[3] * y1[3]);
                }
                s += __shfl_xor(s, 16); s += __shfl_xor(s, 32);
                if (fq == 0) ssp[(size_t)row * 32 + u.pn * 4 + wc] = s;
            }
        asm volatile("s_waitcnt vmcnt(0)" ::: "memory"); __syncthreads();
        unsigned* pc = cnt + 64 * u.pm;
        if (wid == 0) {
            if (lane == 0) { __builtin_amdgcn_fence(__ATOMIC_RELEASE, "agent"); asm volatile("s_waitcnt vmcnt(0)" ::: "memory"); __hip_atomic_fetch_add(pc, 1u, __ATOMIC_RELAXED, __HIP_MEMORY_SCOPE_AGENT); }
            unsigned sp = 0u;
            while ((unsigned)__builtin_amdgcn_readfirstlane((int)__hip_atomic_load(pc, __ATOMIC_RELAXED, __HIP_MEMORY_SCOPE_AGENT)) < 4u) { __builtin_amdgcn_s_sleep(2); if (++sp > (1u << 17)) break; }
            __builtin_amdgcn_fence(__ATOMIC_ACQUIRE, "agent"); asm volatile("s_waitcnt vmcnt(0)" ::: "memory");
        }
        __syncthreads();
        PG8_LAS float* tab = (PG8_LAS float*)lds;
        { const int t = wid * 64 + lane;
          if (t < 256) { const f32x4* pp = (const f32x4*)(ssp + (size_t)(u.pm * BM + t) * 32); float q = 0.f;
#pragma unroll
              for (int i = 0; i < 8; ++i) { const f32x4 v = pp[i]; q += (v[0] + v[1]) + (v[2] + v[3]); }
              tab[t] = 1.0f / sqrtf(q * (1.0f / DM) + EPS); } }
        asm volatile("s_waitcnt lgkmcnt(0)" ::: "memory"); __syncthreads();
        f32x4 gv[2][2];
#pragma unroll
        for (int bj = 0; bj < 2; ++bj) { gv[bj][0] = *(const f32x4*)(fg + col0 + bj * HALF); gv[bj][1] = *(const f32x4*)(fg + col0 + bj * HALF + 4); }
#pragma unroll
        for (int ai = 0; ai < 2; ++ai)
#pragma unroll
            for (int m = 0; m < 4; ++m) { const float rs = tab[ai * HALF + wr * 64 + m * 16 + fr]; const size_t off = (size_t)(row0 + ai * HALF + m * 16) * DM + col0;
#pragma unroll
                for (int bj = 0; bj < 2; ++bj) { *(f32x4*)(out + off + bj * HALF) = acc[ai][bj][m][0] * rs * gv[bj][0]; *(f32x4*)(out + off + bj * HALF + 4) = acc[ai][bj][m][1] * rs * gv[bj][1]; } }
        const int colA = pn0 * BM + wc * 32 + 8 * fq;
#pragma unroll
        for (int bj = 0; bj < 2; ++bj) { gv[bj][0] = *(const f32x4*)(fg + colA + bj * HALF); gv[bj][1] = *(const f32x4*)(fg + colA + bj * HALF + 4); }
#pragma unroll
        for (int ai = 0; ai < 2; ++ai)
#pragma unroll
            for (int m = 0; m < 4; ++m) { const float rs = tab[ai * HALF + wr * 64 + m * 16 + fr]; const size_t off = (size_t)(row0 + ai * HALF + m * 16) * DM + colA;
#pragma unroll
                for (int bj = 0; bj < 2; ++bj) { const u32x4 v = *(const u32x4*)(yb + off + bj * HALF);
                    const f32x4 a0 = {__builtin_bit_cast(float, v.x << 16), __builtin_bit_cast(float, v.x & 0xffff0000u), __builtin_bit_cast(float, v.y << 16), __builtin_bit_cast(float, v.y & 0xffff0000u)};
                    const f32x4 a1 = {__builtin_bit_cast(float, v.z << 16), __builtin_bit_cast(float, v.z & 0xffff0000u), __builtin_bit_cast(float, v.w << 16), __builtin_bit_cast(float, v.w & 0xffff0000u)};
                    *(f32x4*)(out + off + bj * HALF) = a0 * rs * gv[bj][0]; *(f32x4*)(out + off + bj * HALF + 4) = a1 * rs * gv[bj][1]; } }
    }
};
}
namespace pg8 {
template <class Epi, class Sched, bool ALIGN_EPI = false, bool SP2 = false>
__device__ __forceinline__ void gemm_phase(PG8_LAS unsigned char* lds, const Gemm g, const Sched& S, const Epi& E) {
    int tid_ = threadIdx.x; asm volatile("" : "+v"(tid_)); const int tid = tid_, wid = __builtin_amdgcn_readfirstlane(tid >> 6), lane = tid & 63, wr = wid >> 2, wc = wid & 3, fr = lane & 15, fq = lane >> 4;
    const int K = g.K, nt = K / BK;
    unsigned voffA[2], voffB[2];
#pragma unroll
    for (int i = 0; i < 2; ++i) { int R, C; stage_rc(tid * 16 + i * 8192, R, C); const int Rb = Epi::PERM ? ((R & ~31) + perm32(R & 31)) : R;
        voffA[i] = (unsigned)(R * K + C) * 2u; voffB[i] = (unsigned)(Rb * K + C) * 2u; }
    const size_t kstep = (size_t)(BK * 2);
    const size_t hstep = (size_t)HALF * K * 2;
    const size_t tstep = 2 * hstep;
    const unsigned ldsw = (unsigned)wid * 1024u;
    const int aoff = lds_byte(wr * 64 + fr, fq * 8), boff = lds_byte(wc * 32 + fr, fq * 8);
#define PG8_SA(b, h) (((b) * 2 + (h)) * HTB)
#define PG8_SB(b, h) ((4 + (b) * 2 + (h)) * HTB)
#define PG8_STAGE(bufoff, gbase, voff) do { _Pragma("unroll") for (int _i = 0; _i < 2; ++_i) \
        __builtin_amdgcn_global_load_lds((const unsigned*)((const char*)(gbase) + (voff)[_i]), (PG8_LAS unsigned*)(lds + (bufoff) + ldsw + _i * 8192), 16, 0, 0); } while (0)
#define PG8_LDA(dst, b, h) do { _Pragma("unroll") for (int m = 0; m < 4; ++m) _Pragma("unroll") for (int k = 0; k < 2; ++k) dst[m][k] = *(const PG8_LAS bf16x8*)(lds + PG8_SA(b, h) + aoff + m * 2048 + k * 1024); } while (0)
#define PG8_LDB(dst, b, h) do { _Pragma("unroll") for (int n = 0; n < 2; ++n) _Pragma("unroll") for (int k = 0; k < 2; ++k) dst[n][k] = *(const PG8_LAS bf16x8*)(lds + PG8_SB(b, h) + boff + n * 2048 + k * 1024); } while (0)
#define PG8_MMA(ai, bj, At, Bt) do { __builtin_amdgcn_s_setprio(1); _Pragma("unroll") for (int m = 0; m < 4; ++m) _Pragma("unroll") for (int n = 0; n < 2; ++n) _Pragma("unroll") for (int k = 0; k < 2; ++k) \
        acc[ai][bj][m][n] = __builtin_amdgcn_mfma_f32_16x16x32_bf16(Bt[n][k], At[m][k], acc[ai][bj][m][n], 0, 0, 0); __builtin_amdgcn_s_setprio(0); } while (0)
#define PG8_WAIT_V(n) asm volatile("s_waitcnt vmcnt(" #n ")" ::: "memory")
#define PG8_WAIT_L(n) asm volatile("s_waitcnt lgkmcnt(" #n ")" ::: "memory")
#define PG8_BAR __builtin_amdgcn_s_barrier()
#define PG8_SCHED __builtin_amdgcn_sched_barrier(0)
    Unit cur, nxt; int ui = 0;
    if (!S.next(0, cur)) return;
    f32x4 acc[2][2][4][2];
#pragma unroll
    for (int a = 0; a < 2; ++a)
#pragma unroll
        for (int b = 0; b < 2; ++b)
#pragma unroll
            for (int m = 0; m < 4; ++m)
#pragma unroll
                for (int n = 0; n < 2; ++n) acc[a][b][m][n] = (f32x4){0.f, 0.f, 0.f, 0.f};
    bf16x8 At[4][2], B0[2][2], B1[2][2];
    const char* cA = (const char*)g.A + (size_t)cur.pm * tstep; const char* cB = (const char*)g.Bt + (size_t)cur.pn * tstep;
    S.a_ready(cur);
    if constexpr (SP2) {
        PG8_STAGE(PG8_SB(0, 0), cB, voffB); PG8_STAGE(PG8_SB(0, 1), cB + hstep, voffB); PG8_STAGE(PG8_SA(0, 0), cA, voffA); PG8_STAGE(PG8_SA(0, 1), cA + hstep, voffA);
        if (wr == 1) PG8_BAR;
        PG8_WAIT_V(2); PG8_BAR;
        PG8_STAGE(PG8_SB(1, 0), cB + kstep, voffB); PG8_STAGE(PG8_SA(1, 0), cA + kstep, voffA); PG8_STAGE(PG8_SB(1, 1), cB + hstep + kstep, voffB);
        PG8_WAIT_V(6); PG8_BAR;
    } else {
        PG8_STAGE(PG8_SB(0, 0), cB, voffB); PG8_STAGE(PG8_SA(0, 0), cA, voffA); PG8_STAGE(PG8_SB(0, 1), cB + hstep, voffB); PG8_STAGE(PG8_SA(0, 1), cA + hstep, voffA);
        if (wr == 1) PG8_BAR;
        PG8_WAIT_V(4); PG8_BAR;
        PG8_STAGE(PG8_SB(1, 0), cB + kstep, voffB); PG8_STAGE(PG8_SA(1, 0), cA + kstep, voffA); PG8_STAGE(PG8_SB(1, 1), cB + hstep + kstep, voffB);
        PG8_WAIT_V(6); PG8_BAR;
    }
    for (;;) {
        const bool has_next = S.next(ui + 1, nxt);
        const char* nA = has_next ? (const char*)g.A + (size_t)nxt.pm * tstep : cA; const char* nB = has_next ? (const char*)g.Bt + (size_t)nxt.pn * tstep : cB;
        for (int t = 0; t < nt; t += 2) {
            const bool last = (t == nt - 2);
            const char* a1 = cA + (size_t)(t + 1) * kstep;
            const char* a2 = last ? nA : cA + (size_t)(t + 2) * kstep; const char* b2 = last ? nB : cB + (size_t)(t + 2) * kstep;
            const char* a3 = a2 + kstep; const char* b3 = b2 + kstep;
            if (last && has_next) S.a_ready(nxt);
            if constexpr (SP2) {
            PG8_LDB(B0, 0, 0); PG8_LDB(B1, 0, 1); PG8_SCHED; PG8_LDA(At, 0, 0); PG8_STAGE(PG8_SA(1, 1), a1 + hstep, voffA);
            PG8_WAIT_V(8); PG8_WAIT_L(0); PG8_BAR; PG8_MMA(0, 0, At, B0); PG8_MMA(0, 1, At, B1); PG8_BAR; PG8_SCHED;
            PG8_LDA(At, 0, 1); PG8_STAGE(PG8_SB(0, 0), b2, voffB); PG8_STAGE(PG8_SB(0, 1), b2 + hstep, voffB); PG8_STAGE(PG8_SA(0, 0), a2, voffA);
            PG8_WAIT_V(8); PG8_WAIT_L(0); PG8_BAR; PG8_MMA(1, 0, At, B0); PG8_MMA(1, 1, At, B1); PG8_BAR; PG8_SCHED;
            PG8_LDB(B0, 1, 0); PG8_LDB(B1, 1, 1); PG8_SCHED; PG8_LDA(At, 1, 0); PG8_STAGE(PG8_SA(0, 1), a2 + hstep, voffA);
            PG8_WAIT_V(8); PG8_WAIT_L(0); PG8_BAR; PG8_MMA(0, 0, At, B0); PG8_MMA(0, 1, At, B1); PG8_BAR; PG8_SCHED;
            PG8_LDA(At, 1, 1); PG8_STAGE(PG8_SB(1, 0), b3, voffB); PG8_STAGE(PG8_SB(1, 1), b3 + hstep, voffB); PG8_STAGE(PG8_SA(1, 0), a3, voffA);
            PG8_WAIT_V(8); PG8_WAIT_L(0); PG8_BAR; PG8_MMA(1, 0, At, B0); PG8_MMA(1, 1, At, B1); PG8_BAR; PG8_SCHED;
            } else {
            PG8_LDB(B0, 0, 0); PG8_SCHED; PG8_LDA(At, 0, 0); PG8_STAGE(PG8_SA(1, 1), a1 + hstep, voffA);
            PG8_WAIT_L(8); PG8_BAR; PG8_WAIT_L(0); PG8_MMA(0, 0, At, B0); PG8_BAR; PG8_SCHED;
            PG8_LDB(B1, 0, 1); PG8_STAGE(PG8_SB(0, 0), b2, voffB);
            PG8_BAR; PG8_WAIT_L(0); PG8_MMA(0, 1, At, B1); PG8_BAR;
            PG8_LDA(At, 0, 1); PG8_STAGE(PG8_SA(0, 0), a2, voffA);
            PG8_BAR; PG8_WAIT_L(0); PG8_MMA(1, 0, At, B0); PG8_BAR; PG8_SCHED;
            PG8_STAGE(PG8_SB(0, 1), b2 + hstep, voffB);
            PG8_WAIT_V(6); PG8_BAR; PG8_MMA(1, 1, At, B1); PG8_BAR;
            PG8_LDB(B0, 1, 0); PG8_SCHED; PG8_LDA(At, 1, 0); PG8_STAGE(PG8_SA(0, 1), a2 + hstep, voffA);
            PG8_WAIT_L(8); PG8_BAR; PG8_WAIT_L(0); PG8_MMA(0, 0, At, B0); PG8_BAR; PG8_SCHED;
            PG8_LDB(B1, 1, 1); PG8_STAGE(PG8_SB(1, 0), b3, voffB);
            PG8_BAR; PG8_WAIT_L(0); PG8_MMA(0, 1, At, B1); PG8_BAR;
            PG8_LDA(At, 1, 1); PG8_STAGE(PG8_SA(1, 0), a3, voffA);
            PG8_BAR; PG8_WAIT_L(0); PG8_MMA(1, 0, At, B0); PG8_BAR; PG8_SCHED;
            PG8_STAGE(PG8_SB(1, 1), b3 + hstep, voffB);
            PG8_WAIT_V(6); PG8_BAR; PG8_MMA(1, 1, At, B1); PG8_BAR;
            }
        }
        if constexpr (ALIGN_EPI) { if (wr == 0) PG8_BAR; }
        if constexpr (!Epi::AFTER_DRAIN) { if (!(Epi::LAST_FUSED && !has_next)) { E(acc, cur, wr, wc, fr, fq); S.done(cur); } }
        if (!has_next) break;
#pragma unroll
        for (int a = 0; a < 2; ++a)
#pragma unroll
            for (int b = 0; b < 2; ++b)
#pragma unroll
                for (int m = 0; m < 4; ++m)
#pragma unroll
                    for (int n = 0; n < 2; ++n) acc[a][b][m][n] = (f32x4){0.f, 0.f, 0.f, 0.f};
        cur = nxt; cA = nA; cB = nB; ++ui;
        if constexpr (ALIGN_EPI) { if (wr == 1) PG8_BAR; }
    }
    PG8_WAIT_V(0);
    if constexpr (!ALIGN_EPI) { if (wr == 0) PG8_BAR; }
    PG8_BAR;
    if constexpr (Epi::AFTER_DRAIN || Epi::LAST_FUSED) { E.fused(acc, cur, wr, wc, fr, fq, lds, wid, lane); S.done(cur); }
#undef PG8_SA
#undef PG8_SB
#undef PG8_STAGE
#undef PG8_LDA
#undef PG8_LDB
#undef PG8_MMA
#undef PG8_WAIT_V
#undef PG8_WAIT_L
#undef PG8_BAR
#undef PG8_SCHED
}
}

namespace att {
#define ALAS __attribute__((address_space(3)))
using bf16x8 = __attribute__((ext_vector_type(8))) short;
using s16x4  = __attribute__((ext_vector_type(4))) short;
using f32x16 = __attribute__((ext_vector_type(16))) float;
constexpr int KVBLK = 64, SHM_V = KVBLK * 128 * 2, SHM_K = KVBLK * 128 * 2;
constexpr int L_V = 0, L_K = 2 * SHM_V, L_FLAG = 2 * SHM_V + 2 * SHM_K;
#define KSWZ(row, colB) ((row) * 256 + ((colB) ^ (((row) & 7) << 4)))
#define SBAR() __builtin_amdgcn_sched_barrier(0)
__device__ __forceinline__ int crow(int r, int hi) { return (r & 3) + 8 * (r >> 2) + 4 * hi; }
__device__ __forceinline__ unsigned cvtpk(float lo, float hi) { unsigned r; asm volatile("v_cvt_pk_bf16_f32 %0, %1, %2" : "=v"(r) : "v"(lo), "v"(hi)); return r; }
__device__ __forceinline__ void qkt(f32x16& p0, f32x16& p1, const ALAS unsigned char* Ks, const bf16x8* qr, int r32, int hi) {
    p0 = f32x16{}; p1 = f32x16{};
#pragma unroll
    for (int d0 = 0; d0 < 8; ++d0) { const int cb = (d0 * 16 + hi * 8) * 2;
        const bf16x8 b0 = *(const ALAS bf16x8*)(Ks + KSWZ(r32, cb));
        const bf16x8 b1 = *(const ALAS bf16x8*)(Ks + KSWZ(32 + r32, cb));
        p0 = __builtin_amdgcn_mfma_f32_32x32x16_bf16(b0, qr[d0], p0, 0, 0, 0);
        p1 = __builtin_amdgcn_mfma_f32_32x32x16_bf16(b1, qr[d0], p1, 0, 0, 0); }
}
__device__ __forceinline__ int v_st(int k, int c) { const int kk = (k & ~0xC) | ((k & 4) << 1) | ((k & 8) >> 1); return ((kk >> 3) * 4 + (c >> 5)) * 512 + ((kk & 7) * 32 + (c & 31)) * 2; }
__device__ __forceinline__ int v_rd_base(int lane) { return ((lane & 3) << 3) | (((lane >> 2) & 3) << 6) | (((lane >> 4) & 1) << 5) | (((lane >> 5) & 1) << 8); }
constexpr int v_rd_off(int d0, int ks, int half) { return d0 * 512 + ks * 4096 + half * 2048; }
template <int OFF> __device__ __forceinline__ s16x4 tr_read(int vb) { s16x4 r; asm volatile("ds_read_b64_tr_b16 %0, %1 offset:%2" : "=&v"(r) : "v"(vb), "i"(OFF) : "memory"); return r; }
template <int D0> __device__ __forceinline__ void pv_one(f32x16& od, int vb, bf16x8 pa0, bf16x8 pa1, bf16x8 pa2, bf16x8 pa3) {
    const s16x4 l0 = tr_read<v_rd_off(D0, 0, 0)>(vb), h0 = tr_read<v_rd_off(D0, 0, 1)>(vb), l1 = tr_read<v_rd_off(D0, 1, 0)>(vb), h1 = tr_read<v_rd_off(D0, 1, 1)>(vb);
    const s16x4 l2 = tr_read<v_rd_off(D0, 2, 0)>(vb), h2 = tr_read<v_rd_off(D0, 2, 1)>(vb), l3 = tr_read<v_rd_off(D0, 3, 0)>(vb), h3 = tr_read<v_rd_off(D0, 3, 1)>(vb);
    asm volatile("s_waitcnt lgkmcnt(0)" ::: "memory"); SBAR();
#define PK(L, H) (bf16x8){L[0], L[1], L[2], L[3], H[0], H[1], H[2], H[3]}
    od = __builtin_amdgcn_mfma_f32_32x32x16_bf16(pa0, PK(l0, h0), od, 0, 0, 0);
    od = __builtin_amdgcn_mfma_f32_32x32x16_bf16(pa1, PK(l1, h1), od, 0, 0, 0);
    od = __builtin_amdgcn_mfma_f32_32x32x16_bf16(pa2, PK(l2, h2), od, 0, 0, 0);
    od = __builtin_amdgcn_mfma_f32_32x32x16_bf16(pa3, PK(l3, h3), od, 0, 0, 0);
#undef PK
}
__device__ __forceinline__ void pv_d0(f32x16* o, int vb, bf16x8 pa0, bf16x8 pa1, bf16x8 pa2, bf16x8 pa3) {
    pv_one<0>(o[0], vb, pa0, pa1, pa2, pa3); pv_one<1>(o[1], vb, pa0, pa1, pa2, pa3); pv_one<2>(o[2], vb, pa0, pa1, pa2, pa3); pv_one<3>(o[3], vb, pa0, pa1, pa2, pa3);
}
__device__ __forceinline__ void pack_p(const f32x16& p0, const f32x16& p1, bf16x8& pa0, bf16x8& pa1, bf16x8& pa2, bf16x8& pa3) {
#define PK4(P, BASE, OUT) do { unsigned a0 = cvtpk(P[BASE + 0], P[BASE + 1]), a1 = cvtpk(P[BASE + 2], P[BASE + 3]);   \
    unsigned b0 = cvtpk(P[BASE + 4], P[BASE + 5]), b1 = cvtpk(P[BASE + 6], P[BASE + 7]);                              \
    auto r0 = __builtin_amdgcn_permlane32_swap(a0, b0, false, false); auto r1 = __builtin_amdgcn_permlane32_swap(a1, b1, false, false); \
    u32x4 w = {r0[0], r1[0], r0[1], r1[1]}; OUT = *reinterpret_cast<bf16x8*>(&w); } while (0)
    PK4(p0, 0, pa0); PK4(p0, 8, pa1); PK4(p1, 0, pa2); PK4(p1, 8, pa3);
#undef PK4
}
__device__ __forceinline__ float sp2(float z2) { return relu_i(z2) + __builtin_amdgcn_logf(1.0f + __builtin_amdgcn_exp2f(-fabsf(z2))); }
__device__ __forceinline__ void sb_weights(f32x16& p0, f32x16& p1, float& R, int hi) {
    float nl[32];
#pragma unroll
    for (int i = 0; i < 16; ++i) { const float z = p0[i], s = sp2(z); nl[i] = s; p0[i] = z - s; }
#pragma unroll
    for (int i = 0; i < 16; ++i) { const float z = p1[i], s = sp2(z); nl[16 + i] = s; p1[i] = z - s; }
    float S[9]; S[8] = 0.f;
#pragma unroll
    for (int g = 7; g >= 0; --g) S[g] = S[g + 1] + ((nl[4 * g] + nl[4 * g + 1]) + (nl[4 * g + 2] + nl[4 * g + 3]));
    float tot; { auto rr = __builtin_amdgcn_permlane32_swap(__float_as_uint(S[0]), __float_as_uint(S[0]), false, false); tot = __uint_as_float(rr[0]) + __uint_as_float(rr[1]); }
#pragma unroll
    for (int g = 0; g < 8; ++g) {
        const float snd = hi ? S[g] : S[g + 1];
        auto rr = __builtin_amdgcn_permlane32_swap(__float_as_uint(snd), __float_as_uint(snd), false, false);
        const float rcv = hi ? __uint_as_float(rr[0]) : __uint_as_float(rr[1]);
        const float t3 = R - S[g + 1] - rcv, t2 = t3 - nl[4 * g + 3], t1 = t2 - nl[4 * g + 2], t0 = t1 - nl[4 * g + 1];
        if (g < 4) { p0[4 * g + 3] = __builtin_amdgcn_exp2f(p0[4 * g + 3] + t3); p0[4 * g + 2] = __builtin_amdgcn_exp2f(p0[4 * g + 2] + t2); p0[4 * g + 1] = __builtin_amdgcn_exp2f(p0[4 * g + 1] + t1); p0[4 * g] = __builtin_amdgcn_exp2f(p0[4 * g] + t0); }
        else { const int q = 4 * (g - 4); p1[q + 3] = __builtin_amdgcn_exp2f(p1[q + 3] + t3); p1[q + 2] = __builtin_amdgcn_exp2f(p1[q + 2] + t2); p1[q + 1] = __builtin_amdgcn_exp2f(p1[q + 1] + t1); p1[q] = __builtin_amdgcn_exp2f(p1[q] + t0); }
    }
    R -= tot;
}
constexpr int L_STG = 69632;
__device__ __forceinline__ void epi_rows(ALAS unsigned char* lds, const f32x16* o, const float* rn, const bf16_t* __restrict__ gate0, const float* __restrict__ gain, bf16_t* __restrict__ out0, int wid, int lane) {
    const int r32 = lane & 31, hi = lane >> 5;
    ALAS bf16_t* stg = (ALAS bf16_t*)(lds + L_STG + wid * 8192);
#pragma unroll
    for (int r = 0; r < 16; ++r)
#pragma unroll
        for (int d0 = 0; d0 < 4; ++d0) stg[crow(r, hi) * 128 + 32 * d0 + r32] = (bf16_t)cvtpk(o[d0][r] * rn[r], 0.f);
    asm volatile("s_waitcnt lgkmcnt(0)" ::: "memory");
    const int cc = lane & 15, rr0 = lane >> 4;
    const f32x4 g0 = *(const f32x4*)(gain + 8 * cc), g1 = *(const f32x4*)(gain + 8 * cc + 4);
    u32x4 gt[8];
#pragma unroll
    for (int i = 0; i < 8; ++i) gt[i] = *(const u32x4*)(gate0 + (size_t)(4 * i + rr0) * 128 + 8 * cc);
#pragma unroll
    for (int i = 0; i < 8; ++i) { const int row = 4 * i + rr0;
        const u32x4 v = *(const ALAS u32x4*)(stg + row * 128 + 8 * cc); const u32x4 g = gt[i];
        float y[8], q[8];
        y[0] = bf2f(v.x & 0xffffu); y[1] = bf2f(v.x >> 16); y[2] = bf2f(v.y & 0xffffu); y[3] = bf2f(v.y >> 16); y[4] = bf2f(v.z & 0xffffu); y[5] = bf2f(v.z >> 16); y[6] = bf2f(v.w & 0xffffu); y[7] = bf2f(v.w >> 16);
        q[0] = bf2f(g.x & 0xffffu); q[1] = bf2f(g.x >> 16); q[2] = bf2f(g.y & 0xffffu); q[3] = bf2f(g.y >> 16); q[4] = bf2f(g.z & 0xffffu); q[5] = bf2f(g.z >> 16); q[6] = bf2f(g.w & 0xffffu); q[7] = bf2f(g.w >> 16);
#pragma unroll
        for (int e = 0; e < 8; ++e) y[e] = y[e] * (e < 4 ? g0[e & 3] : g1[e & 3]) * (q[e] / (1.0f + __expf(-q[e])));
        u32x4 w; w.x = cvtpk(y[0], y[1]); w.y = cvtpk(y[2], y[3]); w.z = cvtpk(y[4], y[5]); w.w = cvtpk(y[6], y[7]);
        *(u32x4*)(out0 + (size_t)row * DM + 8 * cc) = w; }
    asm volatile("s_waitcnt lgkmcnt(0)" ::: "memory");
}
constexpr float SB_EXIT = -160.0f;
template <bool EARLY>
__device__ __forceinline__ void sb_unit(ALAS unsigned char* lds, const bf16_t* __restrict__ proj, const float* __restrict__ gain, bf16_t* __restrict__ mixed, int b, int h, int qb) {
    int tid_ = threadIdx.x; asm volatile("" : "+v"(tid_)); const int tid = tid_, wid = __builtin_amdgcn_readfirstlane(tid >> 6), lane = tid & 63, r32 = lane & 31, hi = lane >> 5;
    const size_t tok0 = (size_t)b * SEQ; const int q0 = qb * 256, tw0 = q0 + 32 * wid;
    const bf16_t* Kg = proj + (size_t)(8 + h) * PHS + tok0 * 128; const bf16_t* Vg = proj + (size_t)(16 + h) * PHS + tok0 * 128;
    bf16x8 qr[8];
    { const bf16_t* Qw = proj + (size_t)h * PHS + (tok0 + tw0 + r32) * 128 + hi * 8;
#pragma unroll
      for (int d0 = 0; d0 < 8; ++d0) qr[d0] = *(const bf16x8*)(Qw + d0 * 16); }
    const int sr = tid >> 4, sc = (tid & 15) * 8;
    const int vst0 = v_st(sr, sc), vst1 = v_st(32 + sr, sc), kst0 = KSWZ(sr, sc * 2), kst1 = KSWZ(32 + sr, sc * 2);
    const int vb0 = (int)(unsigned)(size_t)(lds + L_V) + v_rd_base(lane);
    ALAS unsigned* flags = (ALAS unsigned*)(lds + L_FLAG);
    bf16x8 ks0, ks1, vs0, vs1;
#define SLOAD(k0) do { const size_t o0 = (size_t)((k0) + sr) * 128 + sc, o1 = (size_t)((k0) + 32 + sr) * 128 + sc; \
    vs0 = *(const bf16x8*)(Vg + o0); vs1 = *(const bf16x8*)(Vg + o1); ks0 = *(const bf16x8*)(Kg + o0); ks1 = *(const bf16x8*)(Kg + o1); } while (0)
#define SWRITE(bf) do { *(ALAS bf16x8*)(lds + L_V + (bf) * SHM_V + vst0) = vs0; *(ALAS bf16x8*)(lds + L_V + (bf) * SHM_V + vst1) = vs1; \
    *(ALAS bf16x8*)(lds + L_K + (bf) * SHM_K + kst0) = ks0; *(ALAS bf16x8*)(lds + L_K + (bf) * SHM_K + kst1) = ks1; } while (0)
    const int jmax = 4 * qb + 3;
    SLOAD(jmax * KVBLK); SWRITE(0); __syncthreads();
    float R = 0.f; f32x16 o[4] = {};
    for (int it = 0, j = jmax;; ++it, --j) {
        const int cur = it & 1, key0 = j * KVBLK;
        const bool act = (key0 < tw0 + 31) && !(EARLY && __all(R < SB_EXIT));
        if (!act && j > 0) SLOAD((j - 1) * KVBLK);
        if (act) {
            f32x16 p0, p1;
            qkt(p0, p1, lds + L_K + cur * SHM_K, qr, r32, hi);
            if (key0 + 63 >= tw0) {
                const int lim = tw0 + r32 - key0 - 4 * hi;
#pragma unroll
                for (int i = 0; i < 16; ++i) { const int kk = 8 * (i >> 2) + (i & 3); if (kk >= lim) p0[i] = -INFINITY; if (kk + 32 >= lim) p1[i] = -INFINITY; }
            }
            sb_weights(p0, p1, R, hi);
            SBAR(); if (j > 0) SLOAD((j - 1) * KVBLK); SBAR();
            bf16x8 pa0, pa1, pa2, pa3;
            pack_p(p0, p1, pa0, pa1, pa2, pa3);
            pv_d0(o, vb0 + cur * SHM_V, pa0, pa1, pa2, pa3);
        }
        if (EARLY) { const bool dn = __all(R < SB_EXIT); if (lane == 0) flags[cur * 8 + wid] = dn ? 1u : 0u; }
        if (j > 0) SWRITE(cur ^ 1);
        __syncthreads();
        if (j == 0) break;
        if (EARLY) { const u32x4 f0 = *(const ALAS u32x4*)(flags + cur * 8), f1 = *(const ALAS u32x4*)(flags + cur * 8 + 4);
            if ((f0.x & f0.y & f0.z & f0.w & f1.x & f1.y & f1.z & f1.w) != 0u) break; }
    }
#undef SLOAD
#undef SWRITE
    float rn[16];
#pragma unroll
    for (int r = 0; r < 16; ++r) { float ss = (o[0][r] * o[0][r] + o[1][r] * o[1][r]) + (o[2][r] * o[2][r] + o[3][r] * o[3][r]);
#pragma unroll
        for (int x = 1; x < 32; x <<= 1) ss += __shfl_xor(ss, x);
        rn[r] = 1.0f / sqrtf(ss * (1.0f / HD) + EPS); }
    epi_rows(lds, o, rn, proj + (size_t)(24 + h) * PHS + (tok0 + tw0) * 128, gain + h * HD, mixed + (tok0 + tw0) * DM + h * HD, wid, lane);
}
constexpr int L_WS = L_FLAG + 64;
constexpr float DSA_THR = 11.5f;
__device__ __forceinline__ void dsa_partial(f32x16& p0, f32x16& p1, unsigned long long mw, int hi, float& m_reg, float& mn, float& alpha) {
    const int mlo = (int)((unsigned)mw >> (4 * hi)), mhi = (int)((unsigned)(mw >> 32) >> (4 * hi));
    const unsigned NINF = 0xff800000u;
#pragma unroll
    for (int i = 0; i < 16; ++i) { const int kk = 8 * (i >> 2) + (i & 3);
        const unsigned t0 = (unsigned)__builtin_amdgcn_sbfe(mlo, kk, 1), t1 = (unsigned)__builtin_amdgcn_sbfe(mhi, kk, 1);
        p0[i] = __uint_as_float((__float_as_uint(p0[i]) & t0) | (NINF & ~t0)); p1[i] = __uint_as_float((__float_as_uint(p1[i]) & t1) | (NINF & ~t1)); }
    float pmax, pmb;
    pmax = max3_asm(p0[0], p0[1], p0[2]); pmb = max3_asm(p1[0], p1[1], p1[2]);
#pragma unroll
    for (int r = 3; r < 15; r += 2) { pmax = max3_asm(pmax, p0[r], p0[r + 1]); pmb = max3_asm(pmb, p1[r], p1[r + 1]); }
    pmax = max3_asm(pmax, p0[15], p1[15]); pmax = max3_asm(pmax, pmb, pmb);
    { auto rr = __builtin_amdgcn_permlane32_swap(__float_as_uint(pmax), __float_as_uint(pmax), false, false); pmax = max3_asm(__uint_as_float(rr[0]), __uint_as_float(rr[1]), __uint_as_float(rr[1])); }
    if (__builtin_expect(__all(pmax - m_reg <= DSA_THR), 1)) { mn = m_reg; alpha = 1.f; }
    else { mn = fmaxf(m_reg, pmax); alpha = __builtin_amdgcn_exp2f(m_reg - mn); m_reg = mn; }
#pragma unroll
    for (int r = 0; r < 16; ++r) { p0[r] -= mn; p1[r] -= mn; }
#pragma unroll
    for (int r = 0; r < 16; ++r) p0[r] = __builtin_amdgcn_exp2f(p0[r]);
}
__device__ __forceinline__ void dsa_finish(f32x16& p0, f32x16& p1, float alpha, float& l_reg, bf16x8& pa0, bf16x8& pa1, bf16x8& pa2, bf16x8& pa3) {
#pragma unroll
    for (int r = 0; r < 16; ++r) p1[r] = __builtin_amdgcn_exp2f(p1[r]);
    float ps = 0.f;
#pragma unroll
    for (int r = 0; r < 16; ++r) ps += p0[r];
#pragma unroll
    for (int r = 0; r < 16; ++r) ps += p1[r];
    { auto rr = __builtin_amdgcn_permlane32_swap(__float_as_uint(ps), __float_as_uint(ps), false, false); ps = __uint_as_float(rr[0]) + __uint_as_float(rr[1]); }
    l_reg = l_reg * alpha + ps;
    pack_p(p0, p1, pa0, pa1, pa2, pa3);
}
__device__ __forceinline__ void dsa_unit(ALAS unsigned char* lds, const bf16_t* __restrict__ proj, const unsigned long long* __restrict__ mask, const float* __restrict__ gain,
                                         bf16_t* __restrict__ mixed, int b, int h, int qb) {
    int tid_ = threadIdx.x; asm volatile("" : "+v"(tid_)); const int tid = tid_, wid = __builtin_amdgcn_readfirstlane(tid >> 6), lane = tid & 63, r32 = lane & 31, hi = lane >> 5, g = h >> 2;
    const size_t tok0 = (size_t)b * SEQ; const int q0 = qb * 256, tw0 = q0 + 32 * wid;
    const bf16_t* Kg = proj + (size_t)(40 + g) * PHS + tok0 * 128; const bf16_t* Vg = proj + (size_t)(42 + g) * PHS + tok0 * 128;
    bf16x8 qr[8];
    { const bf16_t* Qw = proj + (size_t)(32 + h) * PHS + (tok0 + tw0 + r32) * 128 + hi * 8;
#pragma unroll
      for (int d0 = 0; d0 < 8; ++d0) qr[d0] = *(const bf16x8*)(Qw + d0 * 16); }
    const unsigned long long* mrow = mask + (tok0 + tw0 + r32) * 64;
    const int sr = tid >> 4, sc = (tid & 15) * 8;
    const int vst0 = v_st(sr, sc), vst1 = v_st(32 + sr, sc), kst0 = KSWZ(sr, sc * 2), kst1 = KSWZ(32 + sr, sc * 2);
    const int vb0 = (int)(unsigned)(size_t)(lds + L_V) + v_rd_base(lane);
    ALAS float* wsl = (ALAS float*)(lds + L_WS) + wid * 64;
    bf16x8 eV0, eV1, eK0, eK1, oV0, oV1, oK0, oK1;
#define SLOAD_E(k0) do { const size_t o0 = (size_t)((k0) + sr) * 128 + sc, o1 = (size_t)((k0) + 32 + sr) * 128 + sc; eV0 = *(const bf16x8*)(Vg + o0); eV1 = *(const bf16x8*)(Vg + o1); eK0 = *(const bf16x8*)(Kg + o0); eK1 = *(const bf16x8*)(Kg + o1); } while (0)
#define SLOAD_O(k0) do { const size_t o0 = (size_t)((k0) + sr) * 128 + sc, o1 = (size_t)((k0) + 32 + sr) * 128 + sc; oV0 = *(const bf16x8*)(Vg + o0); oV1 = *(const bf16x8*)(Vg + o1); oK0 = *(const bf16x8*)(Kg + o0); oK1 = *(const bf16x8*)(Kg + o1); } while (0)
#define SWRITE_E() do { *(ALAS bf16x8*)(lds + L_V + vst0) = eV0; *(ALAS bf16x8*)(lds + L_V + vst1) = eV1; *(ALAS bf16x8*)(lds + L_K + kst0) = eK0; *(ALAS bf16x8*)(lds + L_K + kst1) = eK1; } while (0)
#define SWRITE_O() do { *(ALAS bf16x8*)(lds + L_V + SHM_V + vst0) = oV0; *(ALAS bf16x8*)(lds + L_V + SHM_V + vst1) = oV1; *(ALAS bf16x8*)(lds + L_K + SHM_K + kst0) = oK0; *(ALAS bf16x8*)(lds + L_K + SHM_K + kst1) = oK1; } while (0)
#define SWAIT() asm volatile("s_waitcnt vmcnt(4)" ::: "memory")
#define RESC(a) do { if (__any((a) < 1.f)) { if (hi == 0) wsl[r32] = (a); asm volatile("s_waitcnt lgkmcnt(0)" ::: "memory"); \
    _Pragma("unroll") for (int r = 0; r < 16; ++r) { const float al_ = wsl[crow(r, hi)]; _Pragma("unroll") for (int d = 0; d < 4; ++d) o[d][r] *= al_; } } } while (0)
    const int NT = 4 * qb + 4;
    float m_reg = -1e30f, l_reg = 0.f; f32x16 o[4] = {};
    f32x16 pA0, pA1, pB0, pB1; float mnA, mnB, alA, alB; bf16x8 pa0, pa1, pa2, pa3;
    SLOAD_E(0); unsigned long long mwA = mrow[0], mwB; asm volatile("s_waitcnt vmcnt(0)" ::: "memory"); SWRITE_E(); __syncthreads();
    qkt(pA0, pA1, lds + L_K, qr, r32, hi); dsa_partial(pA0, pA1, mwA, hi, m_reg, mnA, alA);
    SLOAD_O(KVBLK); SLOAD_E(2 * KVBLK);
    SWAIT(); SWRITE_O(); __syncthreads();
    for (int j = 1; j + 1 < NT; j += 2) {
        mwB = mrow[j];
        SBAR(); qkt(pB0, pB1, lds + L_K + SHM_K, qr, r32, hi);
        dsa_finish(pA0, pA1, alA, l_reg, pa0, pa1, pa2, pa3); SBAR();
        SLOAD_O((j + 2) * KVBLK); SBAR();
        pv_d0(o, vb0, pa0, pa1, pa2, pa3); dsa_partial(pB0, pB1, mwB, hi, m_reg, mnB, alB);
        __syncthreads(); SWAIT(); SWRITE_E();
        RESC(alB); __syncthreads();
        mwA = mrow[j + 1];
        SBAR(); qkt(pA0, pA1, lds + L_K, qr, r32, hi);
        dsa_finish(pB0, pB1, alB, l_reg, pa0, pa1, pa2, pa3); SBAR();
        if (j + 3 < NT) SLOAD_E((j + 3) * KVBLK); SBAR();
        pv_d0(o, vb0 + SHM_V, pa0, pa1, pa2, pa3); dsa_partial(pA0, pA1, mwA, hi, m_reg, mnA, alA);
        __syncthreads(); SWAIT(); SWRITE_O();
        RESC(alA); __syncthreads();
    }
    mwB = mrow[NT - 1];
    SBAR(); qkt(pB0, pB1, lds + L_K + SHM_K, qr, r32, hi);
    dsa_finish(pA0, pA1, alA, l_reg, pa0, pa1, pa2, pa3); SBAR();
    pv_d0(o, vb0, pa0, pa1, pa2, pa3); dsa_partial(pB0, pB1, mwB, hi, m_reg, mnB, alB);
    RESC(alB);
    dsa_finish(pB0, pB1, alB, l_reg, pa0, pa1, pa2, pa3); SBAR();
    pv_d0(o, vb0 + SHM_V, pa0, pa1, pa2, pa3);
    __syncthreads();
#undef SLOAD_E
#undef SLOAD_O
#undef SWRITE_E
#undef SWRITE_O
#undef SWAIT
#undef RESC
    if (hi == 0) wsl[32 + r32] = l_reg; asm volatile("s_waitcnt lgkmcnt(0)" ::: "memory");
    float rn[16];
#pragma unroll
    for (int r = 0; r < 16; ++r) { const float il = 1.0f / wsl[32 + crow(r, hi)];
#pragma unroll
        for (int d = 0; d < 4; ++d) o[d][r] *= il;
        float ss = (o[0][r] * o[0][r] + o[1][r] * o[1][r]) + (o[2][r] * o[2][r] + o[3][r] * o[3][r]);
#pragma unroll
        for (int x = 1; x < 32; x <<= 1) ss += __shfl_xor(ss, x);
        rn[r] = 1.0f / sqrtf(ss * (1.0f / HD) + EPS); }
    epi_rows(lds, o, rn, proj + (size_t)(44 + h) * PHS + (tok0 + tw0) * 128, gain + h * HD, mixed + (tok0 + tw0) * DM + 1024 + h * HD, wid, lane);
    asm volatile("s_waitcnt lgkmcnt(0)" ::: "memory");
}
}

namespace idx {
#define ILAS __attribute__((address_space(3)))
using bf16x8 = __attribute__((ext_vector_type(8))) short;
using f32x16 = __attribute__((ext_vector_type(16))) float;
constexpr int L_SC = 0, L_HIST = 131072, L_CAND = 131072 + 8192, L_TCTR = 131072 + 16384, CAND_CAP = 256;
__device__ __forceinline__ int lbin(float v, float mn, float scale) { return (int)fminf(fmaxf((v - mn) * scale, 0.f), 255.f); }
__device__ __forceinline__ void index_unit(ILAS unsigned char* lds, const bf16_t* __restrict__ proj, const float* __restrict__ iw, unsigned long long* __restrict__ mask, int b, int t0, int uidx) {
    int tid_ = threadIdx.x; asm volatile("" : "+v"(tid_)); const int tid = tid_, wid = __builtin_amdgcn_readfirstlane(tid >> 6), lane = tid & 63, r = lane & 31, hi = lane >> 5;
    const size_t tok0 = (size_t)b * SEQ;
    ILAS unsigned* sc = (ILAS unsigned*)(lds + L_SC);
    ILAS unsigned* tctr = (ILAS unsigned*)(lds + L_TCTR);
    {
        bf16x8 af[4][4]; float wv[4][16];
#pragma unroll
        for (int T = 0; T < 4; ++T) {
            const bf16_t* qb = proj + IQF_OFF + ((((tok0 + t0) >> 3) * 4 + T) * 4 * 64 + lane) * 8;
#pragma unroll
            for (int ks = 0; ks < 4; ++ks) af[T][ks] = *(const bf16x8*)(qb + ks * 512);
            const float* wp = iw + (tok0 + t0 + 2 * T + hi) * 16;
#pragma unroll
            for (int i = 0; i < 4; ++i) { const f32x4 w4 = *(const f32x4*)(wp + 4 * i); wv[T][4 * i] = w4.x; wv[T][4 * i + 1] = w4.y; wv[T][4 * i + 2] = w4.z; wv[T][4 * i + 3] = w4.w; }
        }
        const int nt32 = 2 * ((t0 + 8 + 63) >> 6), nt32p = (nt32 + 15) & ~15;
        const bf16_t* kb = proj + IKC_OFF + (tok0 >> 5) * (4 * 64 * 8) + lane * 8;
        bf16x8 b0[4], b1[4], b2[4];
#define KLOAD(dst, j) do { _Pragma("unroll") for (int ks = 0; ks < 4; ++ks) dst[ks] = *(const bf16x8*)(kb + (size_t)(j) * (4 * 64 * 8) + ks * 512); } while (0)
#define CLAIM(dst) do { unsigned c_ = 0u; if (lane == 0) c_ = __hip_atomic_fetch_add(tctr + (uidx & 1), 1u, __ATOMIC_RELAXED, __HIP_MEMORY_SCOPE_WORKGROUP); dst = __builtin_amdgcn_readfirstlane((int)c_); } while (0)
        int j0, j1, j2;
        CLAIM(j0); CLAIM(j1);
        if (j0 < nt32) KLOAD(b0, j0);
        if (j1 < nt32) KLOAD(b1, j1);
        while (j0 < nt32p) {
            CLAIM(j2);
            if (j2 < nt32) KLOAD(b2, j2);
            const int key0 = 32 * j0;
            if (j0 < nt32) {
#pragma unroll
                for (int T = 0; T < 4; ++T) {
                    f32x16 acc = {};
#pragma unroll
                    for (int ks = 0; ks < 4; ++ks) acc = __builtin_amdgcn_mfma_f32_32x32x16_bf16(af[T][ks], b0[ks], acc, 0, 0, 0);
                    float sv = 0.f;
#pragma unroll
                    for (int rr = 0; rr < 16; ++rr) sv = fmaf(wv[T][rr], relu_i(acc[rr]), sv);
                    const int q = 2 * T + hi, key = key0 + r;
                    sc[q * SEQ + key] = (key <= t0 + q) ? __float_as_uint(sv) : 0xff800000u;
                }
            } else {
#pragma unroll
                for (int T = 0; T < 4; ++T) sc[(2 * T + hi) * SEQ + key0 + r] = 0xff800000u;
            }
#pragma unroll
            for (int ks = 0; ks < 4; ++ks) { b0[ks] = b1[ks]; b1[ks] = b2[ks]; }
            j0 = j1; j1 = j2;
        }
#undef KLOAD
#undef CLAIM
    }
    asm volatile("s_waitcnt lgkmcnt(0)" ::: "memory");
    __syncthreads();
    if (tid == 0) tctr[(uidx + 1) & 1] = 0u;
    const int t = t0 + wid, N = t + 1, NE = (N + 63) >> 6, NE8 = (NE + 7) & ~7;
    const ILAS unsigned* myrow = sc + wid * SEQ + lane;
    float v[64];
#pragma unroll
    for (int c = 0; c < 8; ++c) {
        if (8 * c < NE8) {
#pragma unroll
            for (int i = 0; i < 8; ++i) v[8 * c + i] = __uint_as_float(myrow[64 * (8 * c + i)]);
        } else {
#pragma unroll
            for (int i = 0; i < 8; ++i) v[8 * c + i] = -INFINITY;
        }
    }
    asm volatile("s_waitcnt lgkmcnt(0)" ::: "memory");
    __syncthreads();
    unsigned long long myw = 0ull;
    if (N <= TOPK) {
        for (int e = 0; e < NE; ++e) { const unsigned long long bm = __ballot(64 * e + lane <= t); if (lane == e) myw = bm; }
    } else {
        ILAS unsigned* hist = (ILAS unsigned*)(lds + L_HIST) + wid * 256;
        ILAS unsigned* cand = (ILAS unsigned*)(lds + L_CAND) + wid * CAND_CAP;
        float mx = -INFINITY, mn = INFINITY;
#pragma unroll
        for (int c = 0; c < 8; ++c) if (8 * c < NE8) {
            if (64 * (8 * c + 8) <= N) {
#pragma unroll
                for (int i = 0; i < 8; ++i) { mx = fmaxf(mx, v[8 * c + i]); mn = fminf(mn, v[8 * c + i]); }
            } else {
#pragma unroll
                for (int i = 0; i < 8; ++i) { mx = fmaxf(mx, v[8 * c + i]); mn = fminf(mn, (64 * (8 * c + i) + lane <= t) ? v[8 * c + i] : INFINITY); }
            }
        }
        mx = wave_max_dpp(mx); mn = wave_min_dpp(mn);
        const float scale = (mx > mn) ? 256.0f / (mx - mn) : 0.f;
        *(ILAS u32x4*)(hist + 4 * lane) = (u32x4){0u, 0u, 0u, 0u};
        asm volatile("s_waitcnt lgkmcnt(0)" ::: "memory");
#pragma unroll
        for (int c = 0; c < 8; ++c) if (8 * c < NE8) {
#pragma unroll
            for (int i = 0; i < 8; ++i) __hip_atomic_fetch_add(hist + lbin(v[8 * c + i], mn, scale), 1u, __ATOMIC_RELAXED, __HIP_MEMORY_SCOPE_WORKGROUP);
        }
        asm volatile("s_waitcnt lgkmcnt(0)" ::: "memory");
        int bstar, need; unsigned cb;
        {
            const u32x4 c4 = *(const ILAS u32x4*)(hist + 4 * lane);
            const unsigned s4 = (c4.x + c4.y) + (c4.z + c4.w);
            unsigned sl = s4;
#pragma unroll
            for (int off = 1; off < 64; off <<= 1) { const unsigned tt = __shfl_down(sl, off); if (lane + off < 64) sl += tt; }
            const unsigned long long bal = __ballot(sl >= (unsigned)TOPK);
            const int ls = 63 - __clzll((long long)bal);
            const unsigned above = (unsigned)__builtin_amdgcn_readlane((int)sl, ls) - (unsigned)__builtin_amdgcn_readlane((int)s4, ls);
            const unsigned cx = (unsigned)__builtin_amdgcn_readlane((int)c4.x, ls), cy = (unsigned)__builtin_amdgcn_readlane((int)c4.y, ls);
            const unsigned cz = (unsigned)__builtin_amdgcn_readlane((int)c4.z, ls), cw = (unsigned)__builtin_amdgcn_readlane((int)c4.w, ls);
            unsigned ab = above; int d;
            if (ab + cw >= (unsigned)TOPK) { d = 3; cb = cw; } else { ab += cw;
                if (ab + cz >= (unsigned)TOPK) { d = 2; cb = cz; } else { ab += cz;
                    if (ab + cy >= (unsigned)TOPK) { d = 1; cb = cy; } else { ab += cy; d = 0; cb = cx; } } }
            bstar = 4 * ls + d; need = TOPK - (int)ab;
        }
        unsigned tau; int req;
        if (cb <= (unsigned)CAND_CAP) {
            int base = 0;
#pragma unroll
            for (int c = 0; c < 8; ++c) if (8 * c < NE8) {
#pragma unroll
                for (int i = 0; i < 8; ++i) { const float vv = v[8 * c + i]; const bool in = lbin(vv, mn, scale) == bstar; const unsigned long long m = __ballot(in);
                    if (m != 0ull) { if (in) cand[base + __builtin_amdgcn_mbcnt_hi((unsigned)(m >> 32), __builtin_amdgcn_mbcnt_lo((unsigned)m, 0u))] = fkey(vv); base += __popcll(m); } }
            }
            asm volatile("s_waitcnt lgkmcnt(0)" ::: "memory");
            unsigned k0 = 0u, k1 = 0u, k2 = 0u, k3 = 0u; int c0 = 0, c1 = 0, c2 = 0, c3 = 0;
            const int ncb = (int)cb;
            if (lane < ncb) k0 = cand[lane]; if (64 + lane < ncb) k1 = cand[64 + lane]; if (128 + lane < ncb) k2 = cand[128 + lane]; if (192 + lane < ncb) k3 = cand[192 + lane];
            asm volatile("s_waitcnt lgkmcnt(0)" ::: "memory");
#define RANK_FROM(KV, OFS) do { const int nj_ = min(64, ncb - (OFS)); for (int jj = 0; jj < nj_; ++jj) { const unsigned kj = (unsigned)__builtin_amdgcn_readlane((int)(KV), jj); const int j = (OFS) + jj; \
                c0 += (kj > k0 || (kj == k0 && j < lane)) ? 1 : 0; \
                if (ncb > 64) { c1 += (kj > k1 || (kj == k1 && j < 64 + lane)) ? 1 : 0; c2 += (kj > k2 || (kj == k2 && j < 128 + lane)) ? 1 : 0; c3 += (kj > k3 || (kj == k3 && j < 192 + lane)) ? 1 : 0; } } } while (0)
            RANK_FROM(k0, 0); if (ncb > 64) RANK_FROM(k1, 64); if (ncb > 128) RANK_FROM(k2, 128); if (ncb > 192) RANK_FROM(k3, 192);
#undef RANK_FROM
            const unsigned long long h0 = __ballot(lane < ncb && c0 == need - 1), h1 = __ballot(64 + lane < ncb && c1 == need - 1), h2 = __ballot(128 + lane < ncb && c2 == need - 1), h3 = __ballot(192 + lane < ncb && c3 == need - 1);
            if (h0) tau = (unsigned)__builtin_amdgcn_readlane((int)k0, __builtin_ctzll(h0)); else if (h1) tau = (unsigned)__builtin_amdgcn_readlane((int)k1, __builtin_ctzll(h1));
            else if (h2) tau = (unsigned)__builtin_amdgcn_readlane((int)k2, __builtin_ctzll(h2)); else tau = (unsigned)__builtin_amdgcn_readlane((int)k3, __builtin_ctzll(h3));
            req = __popcll(__ballot(lane < ncb && c0 < need && k0 == tau)) + __popcll(__ballot(64 + lane < ncb && c1 < need && k1 == tau))
                + __popcll(__ballot(128 + lane < ncb && c2 < need && k2 == tau)) + __popcll(__ballot(192 + lane < ncb && c3 < need && k3 == tau));
        } else {
            unsigned pref = 0u; int krem = TOPK;
            for (int pass = 0; pass < 4; ++pass) {
                const int shift = 24 - 8 * pass;
                *(ILAS u32x4*)(hist + 4 * lane) = (u32x4){0u, 0u, 0u, 0u};
                asm volatile("s_waitcnt lgkmcnt(0)" ::: "memory");
#pragma unroll
                for (int c = 0; c < 8; ++c) if (8 * c < NE8) {
#pragma unroll
                    for (int i = 0; i < 8; ++i) { const unsigned k = fkey(v[8 * c + i]);
                        const bool mt = (pass == 0) ? true : ((k >> ((shift + 8) & 31)) == pref);
                        if (mt) __hip_atomic_fetch_add(hist + ((k >> shift) & 255u), 1u, __ATOMIC_RELAXED, __HIP_MEMORY_SCOPE_WORKGROUP); }
                }
                asm volatile("s_waitcnt lgkmcnt(0)" ::: "memory");
                const u32x4 c4 = *(const ILAS u32x4*)(hist + 4 * lane);
                const unsigned s4 = (c4.x + c4.y) + (c4.z + c4.w);
                unsigned sl = s4;
#pragma unroll
                for (int off = 1; off < 64; off <<= 1) { const unsigned tt = __shfl_down(sl, off); if (lane + off < 64) sl += tt; }
                const unsigned long long bal = __ballot(sl >= (unsigned)krem);
                const int ls = 63 - __clzll((long long)bal);
                const unsigned above = (unsigned)__builtin_amdgcn_readlane((int)sl, ls) - (unsigned)__builtin_amdgcn_readlane((int)s4, ls);
                const unsigned cx = (unsigned)__builtin_amdgcn_readlane((int)c4.x, ls), cy = (unsigned)__builtin_amdgcn_readlane((int)c4.y, ls);
                const unsigned cz = (unsigned)__builtin_amdgcn_readlane((int)c4.z, ls), cw = (unsigned)__builtin_amdgcn_readlane((int)c4.w, ls);
                unsigned ab = above; int d;
                if (ab + cw >= (unsigned)krem) d = 3; else { ab += cw;
                    if (ab + cz >= (unsigned)krem) d = 2; else { ab += cz;
                        if (ab + cy >= (unsigned)krem) d = 1; else { ab += cy; d = 0; } } }
                pref = (pref << 8) | (unsigned)(4 * ls + d); krem -= (int)ab;
            }
            tau = pref; req = krem;
        }
        int rleft = req; int wlo = 0, whi = 0;
        const float tauf = __uint_as_float((tau & 0x80000000u) ? (tau & 0x7fffffffu) : ~tau);
#pragma unroll
        for (int c = 0; c < 8; ++c) if (8 * c < NE8) {
#pragma unroll
            for (int i = 0; i < 8; ++i) { const float vv = v[8 * c + i];
                const unsigned long long gt = __ballot(vv > tauf); unsigned long long em = __ballot(vv == tauf), take = 0ull;
                if (em != 0ull) { const int cnt = __popcll(em);
                    if (cnt <= rleft) { take = em; rleft -= cnt; }
                    else { while (rleft > 0) { const unsigned long long bb = em & (~em + 1ull); take |= bb; em ^= bb; --rleft; } } }
                const unsigned long long bm = gt | take;
                if (lane == 8 * c + i) { wlo = (int)(unsigned)bm; whi = (int)(unsigned)(bm >> 32); }
            }
        }
        myw = ((unsigned long long)(unsigned)whi << 32) | (unsigned long long)(unsigned)wlo;
    }
    mask[(tok0 + t) * 64 + lane] = myw;
}
}

#define LAS __attribute__((address_space(3)))
#define RLX_AGENT __ATOMIC_RELAXED, __HIP_MEMORY_SCOPE_AGENT
#define XB_TMO      128
#define XB_XCNT(j)  (256  + 64 * (j))
#define XB_XSUB(j)  (1280 + 64 * (j))
#define XB_XGEN(j)  (2304 + 64 * (j))
#define XB_TOP      3328
#define XB_TOPGEN   3392
#define XCD_BAR_WORDS 3456
#define XB_SPIN_CAP (1u << 18)

__device__ __forceinline__ unsigned xb_ld(unsigned* p)              { return __hip_atomic_load(p, __ATOMIC_RELAXED, __HIP_MEMORY_SCOPE_AGENT); }
__device__ __forceinline__ unsigned xb_add(unsigned* p, unsigned v) { return __hip_atomic_fetch_add(p, v, __ATOMIC_RELAXED, __HIP_MEMORY_SCOPE_AGENT); }
__device__ __forceinline__ unsigned xb_xcc_id() { return (unsigned)__builtin_amdgcn_s_getreg((3 << 11) | 20) & 0xFu; }
#define XB_SPIN(cond, bar) do { unsigned _sp = 0; while (cond) { __builtin_amdgcn_s_sleep(1); \
    if ((++_sp & 255u) == 0u) { if (xb_ld(&(bar)[XB_TMO])) break; if (_sp > XB_SPIN_CAP) { atomicAdd(&(bar)[XB_TMO], 1u); break; } } } } while (0)

struct XcdBarrier {
    unsigned* bar; unsigned x;
    volatile LAS unsigned* st;
};

__device__ __forceinline__ XcdBarrier xcd_barrier_post(unsigned* bar, volatile LAS unsigned* st) {
    XcdBarrier b; b.bar = bar; b.x = xb_xcc_id(); b.st = st;
    if (threadIdx.x == 0) (void)xb_add(&bar[XB_XCNT(b.x)], 1u);
    return b;
}
__device__ __forceinline__ void xcd_barrier_complete(unsigned* bar, unsigned x, unsigned& nloc, unsigned& nx) {
    const unsigned G = gridDim.x * gridDim.y * gridDim.z;
    unsigned sum, cnt, mine, sp = 0u;
    for (;;) {
        sum = 0u; cnt = 0u; mine = 0u;
#pragma unroll
        for (unsigned j = 0; j < 16; ++j) { const unsigned c = xb_ld(&bar[XB_XCNT(j)]); sum += c; cnt += (c > 0u) ? 1u : 0u; mine = (j == x) ? c : mine; }
        if (sum == G) break;
        __builtin_amdgcn_s_sleep(1);
        if ((++sp & 255u) == 0u) { if (xb_ld(&bar[XB_TMO])) break; if (sp > XB_SPIN_CAP) { atomicAdd(&bar[XB_TMO], 1u); break; } }
    }
    nloc = mine > 0u ? mine : 1u; nx = cnt > 0u ? cnt : 1u;
}

__device__ __forceinline__ void xcd_barrier(const XcdBarrier& b) {
    asm volatile("s_waitcnt vmcnt(0)" ::: "memory");
    __syncthreads();
    if (threadIdx.x == 0) {
        unsigned* bar = b.bar;
        __builtin_amdgcn_s_waitcnt(0);
        unsigned nloc = b.st[0], nx = b.st[1];
        if (nloc == 0u) { xcd_barrier_complete(bar, b.x, nloc, nx); b.st[0] = nloc; b.st[1] = nx; }
        const unsigned old = xb_add(&bar[XB_XSUB(b.x)], 1u);
        const unsigned gen = old / nloc;
        if (old + 1u == (gen + 1u) * nloc) {
            __builtin_amdgcn_fence(__ATOMIC_RELEASE, "agent");
            asm volatile("s_waitcnt vmcnt(0)" ::: "memory");
            const unsigned og = xb_add(&bar[XB_TOP], 1u);
            const unsigned tg = og / nx;
            if (og + 1u == (tg + 1u) * nx) xb_add(&bar[XB_TOPGEN], 1u);
            else XB_SPIN(xb_ld(&bar[XB_TOPGEN]) == tg, bar);
            __builtin_amdgcn_fence(__ATOMIC_ACQUIRE, "agent");
            xb_add(&bar[XB_XGEN(b.x)], 1u);
            asm volatile("s_waitcnt vmcnt(0)" ::: "memory");
        } else {
            XB_SPIN(xb_ld(&bar[XB_XGEN(b.x)]) == gen, bar);
            __builtin_amdgcn_fence(__ATOMIC_ACQUIRE, "agent");
            asm volatile("s_waitcnt vmcnt(0)" ::: "memory");
        }
    }
    __syncthreads();
}

#define GAS __attribute__((address_space(1)))
#define LDS_WAIT() asm volatile("s_waitcnt lgkmcnt(0)" ::: "memory")
constexpr int NWAVES = 8, LDS_BYTES = 149504;
constexpr int CG_SEAM = 3;

struct Args { const float* x; const int* pos; const float* norm_g; const float* w_in; const float* sb_g; const float* dsa_g; const float* w_out; const float* final_g; float* out; unsigned char* ws; int ph_lo, ph_hi; };

__device__ __forceinline__ void transpose_item(const float* __restrict__ W, int K, int N, int NPAD, bf16_t* __restrict__ WT, LAS float* scr, int item, int lane) {
    const int nblk = NPAD / 32, kb = item / nblk, nb = item % nblk, k0 = 64 * kb, n0 = 32 * nb;
    const int n = n0 + (lane & 31); const bool ok = n < N;
    float tv[32];
#pragma unroll
    for (int i = 0; i < 32; ++i) tv[i] = ok ? W[(size_t)(k0 + 2 * i + (lane >> 5)) * N + n] : 0.f;
#pragma unroll
    for (int i = 0; i < 32; ++i) scr[(2 * i + (lane >> 5)) * 33 + (lane & 31)] = tv[i];
    LDS_WAIT();
    const int c = lane & 7;
#pragma unroll
    for (int j = 0; j < 4; ++j) { const int nn = (lane >> 3) + 8 * j; const LAS float* s = scr + (8 * c) * 33 + nn;
        u32x4 o; o.x = pk2(s[0 * 33], s[1 * 33]); o.y = pk2(s[2 * 33], s[3 * 33]); o.z = pk2(s[4 * 33], s[5 * 33]); o.w = pk2(s[6 * 33], s[7 * 33]);
        *(u32x4*)(WT + (size_t)(n0 + nn) * K + k0 + 8 * c) = o; }
    LDS_WAIT();
}
__device__ __forceinline__ void rmsnorm_4rows_bf16(const float* __restrict__ x, const float* __restrict__ g, bf16_t* __restrict__ hn, int m0, int mstep, int lane) {
    f32x4 v[4][8]; float ss[4];
#pragma unroll
    for (int q = 0; q < 4; ++q) { const int m = min(m0 + q * mstep, NTOK - 1); const f32x4* xr = (const f32x4*)(x + (size_t)m * DM) + lane;
#pragma unroll
        for (int j = 0; j < 8; ++j) v[q][j] = xr[64 * j]; }
#pragma unroll
    for (int q = 0; q < 4; ++q) { float s = 0.f;
#pragma unroll
        for (int j = 0; j < 8; ++j) s += (v[q][j].x * v[q][j].x + v[q][j].y * v[q][j].y) + (v[q][j].z * v[q][j].z + v[q][j].w * v[q][j].w);
        ss[q] = 1.0f / sqrtf(wave_sum_dpp(s) * (1.0f / DM) + EPS); }
    const f32x4* gr = (const f32x4*)g + lane;
#pragma unroll
    for (int j = 0; j < 8; ++j) { const f32x4 gg = gr[64 * j];
#pragma unroll
        for (int q = 0; q < 4; ++q) { const int m = m0 + q * mstep; if (m < NTOK) { const float r = ss[q]; u32x2 w;
            w.x = pk2(v[q][j].x * r * gg.x, v[q][j].y * r * gg.y); w.y = pk2(v[q][j].z * r * gg.z, v[q][j].w * r * gg.w);
            ((u32x2*)(hn + (size_t)m * DM) + lane)[64 * j] = w; } } }
}

__global__ void __launch_bounds__(NWAVES * 64, 2) mega(Args a) {
    extern __shared__ __attribute__((aligned(16))) unsigned char lds_raw[];
    LAS unsigned char* lds = (LAS unsigned char*)lds_raw;
    int tid_ = threadIdx.x; asm volatile("" : "+v"(tid_)); const int tid = tid_, lane = tid & 63, wave = __builtin_amdgcn_readfirstlane(tid >> 6);
    const int G = gridDim.x, bx = blockIdx.x;
    unsigned char* ws = a.ws;
    bf16_t* HN = (bf16_t*)(ws + WS_HN); bf16_t* WT1 = (bf16_t*)(ws + WS_WT1); bf16_t* WT2 = (bf16_t*)(ws + WS_WT2);
    float* IW = (float*)(ws + WS_IW); float* R128 = (float*)(ws + WS_R128); float* R64 = (float*)(ws + WS_R64); bf16_t* PROJ = (bf16_t*)(ws + WS_PROJ);
    bf16_t* MIXED = (bf16_t*)(ws + WS_MIXED); bf16_t* YB = (bf16_t*)(ws + WS_PROJ); float* SSP = (float*)(ws + WS_SSP); unsigned long long* MASKW = (unsigned long long*)(ws + WS_MASK); const unsigned long long* MASK = MASKW;
    const int lo = a.ph_lo, hi = a.ph_hi;
#define IN(k) (lo <= (k) && (k) < hi)
    if (tid < 2) ((volatile LAS unsigned*)(lds + LDS_BYTES - 64))[tid] = 0u;
    __syncthreads();
    unsigned* const xbw = (unsigned*)(ws + WS_CTL) + 4096;
    unsigned* const pcnt = (unsigned*)(ws + WS_CTL) + 16384;
    const XcdBarrier xbar = xcd_barrier_post(xbw, (volatile LAS unsigned*)(lds + LDS_BYTES - 64));
#define SEAM(k) do { if (IN(k) && IN((k) + 1)) { if ((k) == CG_SEAM) cooperative_groups::this_grid().sync(); else xcd_barrier(xbar); } } while (0)

    if (IN(0)) {
        const int gw = bx * NWAVES + wave, NGW = G * NWAVES;
        LAS float* scr = (LAS float*)(lds + wave * 16384);
        constexpr int I1 = (DM / 64) * (NP / 32), I2 = (DM / 64) * (DM / 32);
        {
            static const double IRV[16] = {0.15915494309189535, 0.070086521587798503, 0.03086376340470123, 0.013591370636193905, 0.0059851857127137054, 0.002635675898667414, 0.001160663641240061, 0.00051111750453754386,
                                           0.00022507907903927653, 9.9117309369019355e-05, 4.3647952792802891e-05, 1.9221100684944863e-05, 8.4643308082414014e-06, 3.7274086019153519e-06, 1.6414262627950345e-06, 7.2282930688328648e-07};
            for (int i = bx * (NWAVES * 64) + tid; i < NTOK * 24; i += G * NWAVES * 64) {
                const int tok = i / 24, j = i % 24; const double rev = (double)a.pos[tok] * IRV[j < 16 ? j : 2 * (j - 16)];
                const float rr = (float)(rev - floor(rev)); const float sn = __builtin_amdgcn_sinf(rr), cs = __builtin_amdgcn_cosf(rr);
                if (j < 16) { R128[tok * 32 + j] = cs; R128[tok * 32 + 16 + j] = sn; } else { R64[tok * 16 + (j - 16)] = cs; R64[tok * 16 + 8 + (j - 16)] = sn; }
            }
        }

        for (int it = gw; it < I1 + I2; it += NGW) {
            if (it < I1) transpose_item(a.w_in, DM, D_IN, NP, WT1, scr, it, lane);
            else transpose_item(a.w_out, DM, DM, DM, WT2, scr, it - I1, lane);
        }

        for (int m = gw; m < NTOK; m += 4 * NGW) rmsnorm_4rows_bf16(a.x, a.norm_g, HN, m, NGW, lane);

    }
    SEAM(0);
    if (IN(1)) {
        pg8::Gemm g{HN, WT1, NTOK, NP, DM}; pg8::StaticOrder S; S.init(NTOK, NP, G, bx);
        pg8::EpiProj E{PROJ, IW, R128, R64};
        pg8::gemm_phase<pg8::EpiProj, pg8::StaticOrder, true, true>(lds, g, S, E);
    }
    SEAM(1);
    if (IN(2)) {
        const int vcu = (G % 8 == 0) ? (bx % 8) * (G / 8) + bx / 8 : bx;
        if (tid < 2) ((LAS unsigned*)(lds + idx::L_TCTR))[tid] = 0u;
        __syncthreads();
        for (int k = 0;; ++k) {
            const int sI = k * G + ((k & 1) ? (G - 1 - vcu) : vcu);
            if (sI >= NTOK / 8) break;
            idx::index_unit(lds, PROJ, IW, MASKW, sI & 3, 8 * (511 - (sI >> 2)), k);
        }
        __syncthreads();
    }

    SEAM(2);
    if (IN(3)) {
        const int vcu = (G % 8 == 0) ? (bx % 8) * (G / 8) + bx / 8 : bx;
        for (int p = vcu; p < BATCH * SBH * 8; p += G) {
            const int bh = p >> 3, sI = p & 7, b = bh / SBH, h = bh % SBH;
            for (int k = 0; k < 2; ++k) att::sb_unit<true>(lds, PROJ, a.sb_g, MIXED, b, h, k == 0 ? 15 - sI : sI);
        }
    }

    if (IN(3)) {
        const int vcu = (G % 8 == 0) ? (bx % 8) * (G / 8) + bx / 8 : bx;
        for (int p = vcu; p < BATCH * DSH * 8; p += G) {
            const int bh = p >> 3, sI = p & 7, b = bh / DSH, h = bh % DSH;
            for (int k = 0; k < 2; ++k) att::dsa_unit(lds, PROJ, MASK, a.dsa_g, MIXED, b, h, k == 0 ? 15 - sI : sI);
        }
    }

    SEAM(3);
    if (IN(4)) {
        pg8::Gemm g{MIXED, WT2, NTOK, DM, DM}; pg8::StaticOrder S; S.init(NTOK, DM, G, bx);
        pg8::Unit u0_; S.next(0, u0_);
        pg8::EpiOut E{a.x, YB, SSP, a.out, a.final_g, pcnt, u0_.pn, (G == 256) ? 1 : 0};
        pg8::gemm_phase<pg8::EpiOut, pg8::StaticOrder, true, true>(lds, g, S, E);
    }
    if (G != 256) { SEAM(4); }
    if (IN(5) && G != 256) {
        const int gw = bx * NWAVES + wave, NGW = G * NWAVES;
        for (int m = gw; m < NTOK; m += NGW) {
            const float sp = (lane < 32) ? SSP[(size_t)m * 32 + lane] : 0.f;
            const float r = 1.0f / sqrtf(wave_sum(sp) * (1.0f / DM) + EPS);
            const u32x4* yr = (const u32x4*)(YB + (size_t)m * DM) + lane; const f32x4* gr = (const f32x4*)a.final_g + 2 * lane; f32x4* orow = (f32x4*)(a.out + (size_t)m * DM) + 2 * lane;
#pragma unroll
            for (int j = 0; j < 4; ++j) { const u32x4 v = yr[64 * j]; const f32x4 g0 = gr[128 * j], g1 = gr[128 * j + 1];
                orow[128 * j] = (f32x4){bf2f(v.x & 0xffffu) * r * g0.x, bf2f(v.x >> 16) * r * g0.y, bf2f(v.y & 0xffffu) * r * g0.z, bf2f(v.y >> 16) * r * g0.w};
                orow[128 * j + 1] = (f32x4){bf2f(v.z & 0xffffu) * r * g1.x, bf2f(v.z >> 16) * r * g1.y, bf2f(v.w & 0xffffu) * r * g1.z, bf2f(v.w >> 16) * r * g1.w}; }
        }
    }

#undef IN
#undef SEAM
}

extern "C" void kernel_launch(void* const* d_in, const int* in_sizes, int n_in, void* d_out, int out_size, void* d_ws, size_t ws_size, hipStream_t stream) {
    static int grid = 0;
    if (grid == 0) {
        if (n_in != 8 || in_sizes[0] != NTOK * DM || out_size != NTOK * DM || ws_size < WS_END) {
            fprintf(stderr, "kernel_launch: shape mismatch n_in %d in0 %d out %d ws %zu (need %zu)\n", n_in, n_in > 0 ? in_sizes[0] : -1, out_size, ws_size, (size_t)WS_END); grid = -1; return; }
        int dev = 0, cus = 0;
        if (hipGetDevice(&dev) != hipSuccess || hipDeviceGetAttribute(&cus, hipDeviceAttributeMultiprocessorCount, dev) != hipSuccess) { grid = -1; return; }
        if (hipFuncSetAttribute((const void*)mega, hipFuncAttributeMaxDynamicSharedMemorySize, LDS_BYTES) != hipSuccess) { fprintf(stderr, "kernel_launch: hipFuncSetAttribute failed\n"); grid = -1; return; }
        int per_cu = 0;
        if (hipOccupancyMaxActiveBlocksPerMultiprocessor(&per_cu, (const void*)mega, NWAVES * 64, LDS_BYTES) != hipSuccess || per_cu < 1) { fprintf(stderr, "kernel_launch: occupancy query says %d blocks per CU\n", per_cu); grid = -1; return; }
        grid = cus;
    }
    if (grid < 0) return;
    const float* x = (const float*)d_in[0]; const float* sb_g = (const float*)d_in[4]; const float* dsa_g = (const float*)d_in[5]; const float* final_g = (const float*)d_in[7];
    unsigned char* ws = (unsigned char*)d_ws; float* out = (float*)d_out;
    bf16_t* MIXED = (bf16_t*)(ws + WS_MIXED); bf16_t* WT2 = (bf16_t*)(ws + WS_WT2);
    float* IW = (float*)(ws + WS_IW);
    unsigned long long* MASK = (unsigned long long*)(ws + WS_MASK); bf16_t* PROJ = (bf16_t*)(ws + WS_PROJ);
    hipMemsetAsync(ws + WS_CTL, 0, 1 * MiB, stream);
    Args a{};
    a.x = x; a.pos = (const int*)d_in[1]; a.norm_g = (const float*)d_in[2]; a.w_in = (const float*)d_in[3]; a.sb_g = sb_g; a.dsa_g = dsa_g; a.w_out = (const float*)d_in[6]; a.final_g = final_g;
    a.out = out; a.ws = ws;
    a.ph_lo = 0; a.ph_hi = 6;
    void* kargs[] = {(void*)&a};
    const hipError_t le = hipLaunchCooperativeKernel((const void*)mega, dim3(grid), dim3(NWAVES * 64), kargs, LDS_BYTES, stream);
    if (le != hipSuccess) fprintf(stderr, "kernel_launch: cooperative launch failed: %s (grid %d)\n", hipGetErrorString(le), grid);
}
```

```cpp
#include <hip/hip_runtime.h>
#include <cstdio>
#include <cstdint>
#include <hip/hip_cooperative_groups.h>

constexpr int BATCH = 4, SEQ = 4096, DM = 2048, NTOK = BATCH * SEQ;
constexpr int HD = 128, SBH = 8, DSH = 8, DKV = 2, IH = 16, ID = 64, TOPK = 256;
constexpr int D_IN = 7760, NP = 7936;
constexpr size_t PHS = (size_t)NTOK * 128;
constexpr size_t IQF_OFF = 52 * PHS;
constexpr size_t IKC_OFF = 60 * PHS;
constexpr int C_SBQ = 0, C_SBK = 1024, C_SBV = 2048, C_SBG = 3072, C_DQ = 4096, C_DK = 5120, C_DV = 5376, C_DG = 5632, C_IQ = 6656, C_IK = 7680, C_IW = 7744;
constexpr float EPS = 1e-6f;
constexpr float C2 = 0.08838834764831845f * 1.4426950408889634f;
constexpr float IWS = 1.0f / 32.0f;

constexpr size_t MiB = 1u << 20;
constexpr size_t WS_CTL = 0;
constexpr size_t WS_HN = 1 * MiB;
constexpr size_t WS_MIXED = 368 * MiB;
constexpr size_t WS_RSTD = 512 * 1024;
constexpr size_t WS_WT1 = 65 * MiB;
constexpr size_t WS_WT2 = 96 * MiB;
constexpr size_t WS_IW = 104 * MiB;
constexpr size_t WS_R128 = 105 * MiB;
constexpr size_t WS_R64 = 107 * MiB;
constexpr size_t WS_MASK = 108 * MiB;
constexpr size_t WS_PROJ = 116 * MiB;
constexpr size_t WS_SSP = 366 * MiB;
constexpr size_t WS_END = 432 * MiB;

#define WAVE_SYNC() asm volatile("s_waitcnt lgkmcnt(0)" ::: "memory")
typedef unsigned short bf16_t;
typedef float f32x4 __attribute__((ext_vector_type(4)));
typedef unsigned u32x4 __attribute__((ext_vector_type(4)));
typedef unsigned u32x2 __attribute__((ext_vector_type(2)));

__device__ __forceinline__ unsigned f2bf(float f) { unsigned u = __builtin_bit_cast(unsigned, f); return (u + 0x7fffu + ((u >> 16) & 1u)) >> 16; }
__device__ __forceinline__ float bf2f(unsigned h) { return __builtin_bit_cast(float, h << 16); }
__device__ __forceinline__ unsigned pk2(float lo, float hi) { return f2bf(lo) | (f2bf(hi) << 16); }
__device__ __forceinline__ float wave_sum(float v) {
#pragma unroll
    for (int o = 1; o < 64; o <<= 1) v += __shfl_xor(v, o);
    return v;
}
__device__ __forceinline__ float wave_max(float v) {
#pragma unroll
    for (int o = 1; o < 64; o <<= 1) v = fmaxf(v, __shfl_xor(v, o));
    return v;
}

template <int CTRL> __device__ __forceinline__ float dppf(float v) { return __builtin_bit_cast(float, __builtin_amdgcn_update_dpp(0, __builtin_bit_cast(int, v), CTRL, 0xf, 0xf, true)); }
__device__ __forceinline__ float wave_max_dpp(float v) {
    v = fmaxf(v, dppf<0xB1>(v)); v = fmaxf(v, dppf<0x4E>(v)); v = fmaxf(v, dppf<0x141>(v)); v = fmaxf(v, dppf<0x140>(v));
    const int iv = __builtin_bit_cast(int, v);
    const float a = __builtin_bit_cast(float, __builtin_amdgcn_readlane(iv, 0)), b = __builtin_bit_cast(float, __builtin_amdgcn_readlane(iv, 16)), c = __builtin_bit_cast(float, __builtin_amdgcn_readlane(iv, 32)), d = __builtin_bit_cast(float, __builtin_amdgcn_readlane(iv, 48));
    return fmaxf(fmaxf(a, b), fmaxf(c, d));
}
__device__ __forceinline__ float wave_sum_dpp(float v) {
    v += dppf<0xB1>(v); v += dppf<0x4E>(v); v += dppf<0x141>(v); v += dppf<0x140>(v);
    const int iv = __builtin_bit_cast(int, v);
    const float a = __builtin_bit_cast(float, __builtin_amdgcn_readlane(iv, 0)), b = __builtin_bit_cast(float, __builtin_amdgcn_readlane(iv, 16)), c = __builtin_bit_cast(float, __builtin_amdgcn_readlane(iv, 32)), d = __builtin_bit_cast(float, __builtin_amdgcn_readlane(iv, 48));
    return (a + b) + (c + d);
}
__device__ __forceinline__ float wave_min_dpp(float v) { return -wave_max_dpp(-v); }
__device__ __forceinline__ float relu_i(float x) { return __builtin_bit_cast(float, max(__builtin_bit_cast(int, x), 0)); }
template <int CTRL> __device__ __forceinline__ unsigned dppu(unsigned v) { return (unsigned)__builtin_amdgcn_update_dpp(0, (int)v, CTRL, 0xF, 0xF, false); }
template <int S, unsigned M> __device__ __forceinline__ unsigned tr_stage(unsigned w, unsigned other, bool up) {
    const unsigned rot = __builtin_amdgcn_alignbit(other, other, up ? (unsigned)(32 - S) : (unsigned)S);
    const unsigned keep = up ? M : ~M;
    return (w & keep) | (rot & ~keep);
}
__device__ __forceinline__ float min3_asm(float a, float b, float c) { float r; asm("v_min3_f32 %0, %1, %2, %3" : "=v"(r) : "v"(a), "v"(b), "v"(c)); return r; }
__device__ __forceinline__ float max3_asm(float a, float b, float c) { float r; asm("v_max3_f32 %0, %1, %2, %3" : "=v"(r) : "v"(a), "v"(b), "v"(c)); return r; }
__device__ __forceinline__ unsigned fkey(float f) { unsigned u = __builtin_bit_cast(unsigned, f); return (u & 0x80000000u) ? ~u : (u | 0x80000000u); }

namespace pg8 {
#define PG8_LAS __attribute__((address_space(3)))
typedef unsigned short bf16_t;
typedef short bf16x8 __attribute__((ext_vector_type(8)));
typedef float f32x4 __attribute__((ext_vector_type(4)));
typedef unsigned u32x4 __attribute__((ext_vector_type(4)));
constexpr int BM = 256, BK = 64, HALF = 128, HTB = HALF * BK * 2  , STAGE_BYTES = 8 * HTB, NXCD = 8, WGM = 8;

__host__ __device__ __forceinline__ int lds_byte(int r, int c) { const int st = (r >> 4) * 2 + (c >> 5), rr = r & 15, cc = c & 31, ob = rr * 64 + cc * 2; return st * 1024 + (ob ^ (((ob >> 9) & 1) << 5)); }
__host__ __device__ __forceinline__ void stage_rc(int b, int& R, int& C) { const int st = b / 1024, sb = b % 1024, swz = sb ^ (((sb >> 9) & 1) << 5); R = (st >> 1) * 16 + swz / 64; C = (st & 1) * 32 + (swz % 64) / 2; }
__host__ __device__ __forceinline__ int perm32(int rho) { const int n = rho >> 4, i = rho & 15; return 8 * (i >> 2) + 4 * n + (i & 3); }

struct Unit { int pm, pn; };
struct Gemm { const bf16_t* A; const bf16_t* Bt; int M, N, K; };

struct StaticOrder {
    int nM, nN, nwg, G, c, remap;
    __host__ __device__ void init(int M, int N, int G_, int c_, int remap_ = 0) { nM = M / BM; nN = N / BM; nwg = nM * nN; G = G_; c = c_; remap = remap_; }
    __host__ __device__ __forceinline__ bool next(int i, Unit& u) const {
        const long L = (long)i * G + c; if (L >= nwg) return false;
        int wgid = (int)L; { const int q = nwg / NXCD, r = nwg % NXCD, xcd = wgid % NXCD, off = wgid / NXCD; wgid = (xcd < r ? xcd * (q + 1) : r * (q + 1) + (xcd - r) * q) + off; }
        const int nig = WGM * nN, gid = wgid / nig, fm = gid * WGM, gsz = (nM - fm) < WGM ? (nM - fm) : WGM;
        u.pm = fm + ((wgid % nig) % gsz); u.pn = (wgid % nig) / gsz;
        if (remap) { const int sl = u.pn; u.pn = sl < 10 ? 16 + sl : (sl < 26 ? sl - 10 : sl); }
        return true;
    }
    __device__ __forceinline__ void a_ready(const Unit&) const {}
    __device__ __forceinline__ void done(const Unit&) const {}
};
}

namespace pg8 {
__device__ __forceinline__ unsigned cvt_pk_bf16(float lo, float hi) { unsigned r; asm volatile("v_cvt_pk_bf16_f32 %0, %1, %2" : "=v"(r) : "v"(lo), "v"(hi)); return r; }
struct EpiProj {
    static constexpr bool PERM = true, AFTER_DRAIN = false, LAST_FUSED = false, EVERY_FUSED = false;
    bf16_t* proj; float* iw; const float* r128; const float* r64; const float* rstd;
    __device__ __forceinline__ void operator()(const f32x4 (&acc)[2][2][4][2], const Unit& u, int wr, int wc, int fr, int fq) const {
        const int pn = u.pn;
        const int row0 = u.pm * BM + wr * 64 + fr, col0 = pn * BM + wc * 32 + 8 * fq;
        const bool rope128 = (pn >= 16 && pn <= 20) && wc == 0;
        const bool rope64 = ((pn >= 26 && pn <= 29) && (wc & 1) == 0) || (pn == 30 && wc == 0);
        const bool iwt = (pn == 30 && wc == 2);
        const float sc = (pn < 4 || (pn >= 16 && pn < 20)) ? C2 : 1.f;
#pragma unroll
        for (int ai = 0; ai < 2; ++ai)
#pragma unroll
            for (int m = 0; m < 4; ++m) {
                const int row = row0 + ai * HALF + m * 16;
                const float rs = rstd[row] * sc;
                f32x4 cs0 = {1.f, 1.f, 1.f, 1.f}, cs1 = cs0, sn0 = {0.f, 0.f, 0.f, 0.f}, sn1 = sn0;
                if (rope128) { const float* t = r128 + (size_t)row * 32 + 8 * (fq & 1); cs0 = *(const f32x4*)t; cs1 = *(const f32x4*)(t + 4); sn0 = *(const f32x4*)(t + 16); sn1 = *(const f32x4*)(t + 20);
                    if (fq < 2) { sn0 = -sn0; sn1 = -sn1; } }
                if (rope64) { const float* t = r64 + (size_t)row * 16; cs0 = *(const f32x4*)t; cs1 = *(const f32x4*)(t + 4); sn0 = *(const f32x4*)(t + 8); sn1 = *(const f32x4*)(t + 12);
                    if (fq == 0) { sn0 = -sn0; sn1 = -sn1; } if (fq >= 2) { cs0 = (f32x4){1.f, 1.f, 1.f, 1.f}; cs1 = cs0; sn0 = (f32x4){0.f, 0.f, 0.f, 0.f}; sn1 = sn0; } }
#pragma unroll
                for (int bj = 0; bj < 2; ++bj) {
                    f32x4 v0 = acc[ai][bj][m][0] * rs, v1 = acc[ai][bj][m][1] * rs;
                    if (rope128 || (rope64 && (pn != 30 || bj == 0))) {
                        const int xm = rope128 ? 32 : 16;
                        f32x4 p0, p1;
#pragma unroll
                        for (int e = 0; e < 4; ++e) { p0[e] = __shfl_xor(v0[e], xm); p1[e] = __shfl_xor(v1[e], xm); }
                        v0 = v0 * cs0 + p0 * sn0; v1 = v1 * cs1 + p1 * sn1;
                    }
                    if (iwt && bj == 0 && fq < 2) { float* ip = iw + (size_t)row * 16 + 8 * fq; *(f32x4*)ip = v0 * IWS; *(f32x4*)(ip + 4) = v1 * IWS; }
                    u32x4 w; w.x = cvt_pk_bf16(v0[0], v0[1]); w.y = cvt_pk_bf16(v0[2], v0[3]); w.z = cvt_pk_bf16(v1[0], v1[1]); w.w = cvt_pk_bf16(v1[2], v1[3]);
                    if (pn < 26) *(u32x4*)(proj + (size_t)(2 * pn + bj) * PHS + (size_t)row * 128 + wc * 32 + 8 * fq) = w;
                    else if (pn < 30) {
                        const int c = (pn - 26) * 256 + 128 * bj + 32 * wc + 8 * fq, head = c >> 6, ks = (c >> 4) & 3, hi_ = (c >> 3) & 1;
                        const int rho = (head & 3) + 4 * (row & 1) + 8 * (head >> 2);
                        *(u32x4*)(proj + IQF_OFF + ((((size_t)(row >> 3) * 4 + ((row >> 1) & 3)) * 4 + ks) * 64 + hi_ * 32 + rho) * 8) = w;
                    } else if (bj == 0 && wc < 2) {
                        const int c = 32 * wc + 8 * fq, ks = c >> 4, hi_ = (c >> 3) & 1;
                        *(u32x4*)(proj + IKC_OFF + ((((size_t)(row >> 5)) * 4 + ks) * 64 + hi_ * 32 + (row & 31)) * 8) = w;
                    }
                }
            }
    }
};
}

namespace pg8 {
struct EpiOut {
    static constexpr bool PERM = true, AFTER_DRAIN = false, LAST_FUSED = true, EVERY_FUSED = false;
    const float* x; bf16_t* yb; float* ssp;
    float* out; const float* fg; unsigned* cnt; int pn0; int fuse;
    __device__ __forceinline__ void operator()(const f32x4 (&acc)[2][2][4][2], const Unit& u, int wr, int wc, int fr, int fq) const {
        const int row0 = u.pm * BM + wr * 64 + fr, col0 = u.pn * BM + wc * 32 + 8 * fq;
#pragma unroll
        for (int ai = 0; ai < 2; ++ai)
#pragma unroll
            for (int m = 0; m < 4; ++m) {
                const int row = row0 + ai * HALF + m * 16; const size_t off = (size_t)row * DM + col0; float s = 0.f;
#pragma unroll
                for (int bj = 0; bj < 2; ++bj) {
                    const f32x4 y0 = *(const f32x4*)(x + off + bj * HALF) + acc[ai][bj][m][0], y1 = *(const f32x4*)(x + off + bj * HALF + 4) + acc[ai][bj][m][1];
                    u32x4 w; w.x = cvt_pk_bf16(y0[0], y0[1]); w.y = cvt_pk_bf16(y0[2], y0[3]); w.z = cvt_pk_bf16(y1[0], y1[1]); w.w = cvt_pk_bf16(y1[2], y1[3]);
                    *(u32x4*)(yb + off + bj * HALF) = w;
                    s += (y0[0] * y0[0] + y0[1] * y0[1]) + (y0[2] * y0[2] + y0[3] * y0[3]) + (y1[0] * y1[0] + y1[1] * y1[1]) + (y1[2] * y1[2] + y1[3] * y1[3]);
                }
                s += __shfl_xor(s, 16); s += __shfl_xor(s, 32);
                if (fq == 0) ssp[(size_t)row * 32 + u.pn * 4 + wc] = s;
            }
    }
    __device__ __forceinline__ void fused(f32x4 (&acc)[2][2][4][2], const Unit& u, int wr, int wc, int fr, int fq, PG8_LAS unsigned char* lds, int wid, int lane) const {
        if (!fuse) { (*this)(acc, u, wr, wc, fr, fq); return; }
        const int row0 = u.pm * BM + wr * 64 + fr, col0 = u.pn * BM + wc * 32 + 8 * fq;
#pragma unroll
        for (int ai = 0; ai < 2; ++ai)
#pragma unroll
            for (int m = 0; m < 4; ++m) {
                const int row = row0 + ai * HALF + m * 16; const size_t off = (size_t)row * DM + col0; float s = 0.f;
#pragma unroll
                for (int bj = 0; bj < 2; ++bj) {
                    const f32x4 y0 = *(const f32x4*)(x + off + bj * HALF) + acc[ai][bj][m][0], y1 = *(const f32x4*)(x + off + bj * HALF + 4) + acc[ai][bj][m][1];
                    acc[ai][bj][m][0] = y0; acc[ai][bj][m][1] = y1;
                    s += (y0[0] * y0[0] + y0[1] * y0[1]) + (y0[2] * y0[2] + y0[3] * y0[3]) + (y1[0] * y1[0] + y1[1] * y1[1]) + (y1[2] * y1[2] + y1[3] * y1[3]);
                }
                s += __shfl_xor(s, 16); s += __shfl_xor(s, 32);
                if (fq == 0) ssp[(size_t)row * 32 + u.pn * 4 + wc] = s;
            }
        asm volatile("s_waitcnt vmcnt(0)" ::: "memory"); __syncthreads();
        unsigned* pc = cnt + 64 * u.pm;
        if (wid == 0) {
            if (lane == 0) { __builtin_amdgcn_fence(__ATOMIC_RELEASE, "agent"); asm volatile("s_waitcnt vmcnt(0)" ::: "memory"); __hip_atomic_fetch_add(pc, 1u, __ATOMIC_RELAXED, __HIP_MEMORY_SCOPE_AGENT); }
            unsigned sp = 0u;
            while ((unsigned)__builtin_amdgcn_readfirstlane((int)__hip_atomic_load(pc, __ATOMIC_RELAXED, __HIP_MEMORY_SCOPE_AGENT)) < 4u) { __builtin_amdgcn_s_sleep(2); if (++sp > (1u << 17)) break; }
            __builtin_amdgcn_fence(__ATOMIC_ACQUIRE, "agent"); asm volatile("s_waitcnt vmcnt(0)" ::: "memory");
        }
        __syncthreads();
        PG8_LAS float* tab = (PG8_LAS float*)lds;
        { const int t = wid * 64 + lane;
          if (t < 256) { const f32x4* pp = (const f32x4*)(ssp + (size_t)(u.pm * BM + t) * 32); float q = 0.f;
#pragma unroll
              for (int i = 0; i < 8; ++i) { const f32x4 v = pp[i]; q += (v[0] + v[1]) + (v[2] + v[3]); }
              tab[t] = 1.0f / sqrtf(q * (1.0f / DM) + EPS); } }
        asm volatile("s_waitcnt lgkmcnt(0)" ::: "memory"); __syncthreads();
        f32x4 gv[2][2];
#pragma unroll
        for (int bj = 0; bj < 2; ++bj) { gv[bj][0] = *(const f32x4*)(fg + col0 + bj * HALF); gv[bj][1] = *(const f32x4*)(fg + col0 + bj * HALF + 4); }
#pragma unroll
        for (int ai = 0; ai < 2; ++ai)
#pragma unroll
            for (int m = 0; m < 4; ++m) { const float rs = tab[ai * HALF + wr * 64 + m * 16 + fr]; const size_t off = (size_t)(row0 + ai * HALF + m * 16) * DM + col0;
#pragma unroll
                for (int bj = 0; bj < 2; ++bj) { *(f32x4*)(out + off + bj * HALF) = acc[ai][bj][m][0] * rs * gv[bj][0]; *(f32x4*)(out + off + bj * HALF + 4) = acc[ai][bj][m][1] * rs * gv[bj][1]; } }
        const int colA = pn0 * BM + wc * 32 + 8 * fq;
#pragma unroll
        for (int bj = 0; bj < 2; ++bj) { gv[bj][0] = *(const f32x4*)(fg + colA + bj * HALF); gv[bj][1] = *(const f32x4*)(fg + colA + bj * HALF + 4); }
#pragma unroll
        for (int ai = 0; ai < 2; ++ai)
#pragma unroll
            for (int m = 0; m < 4; ++m) { const float rs = tab[ai * HALF + wr * 64 + m * 16 + fr]; const size_t off = (size_t)(row0 + ai * HALF + m * 16) * DM + colA;
#pragma unroll
                for (int bj = 0; bj < 2; ++bj) { const u32x4 v = *(const u32x4*)(yb + off + bj * HALF);
                    const f32x4 a0 = {__builtin_bit_cast(float, v.x << 16), __builtin_bit_cast(float, v.x & 0xffff0000u), __builtin_bit_cast(float, v.y << 16), __builtin_bit_cast(float, v.y & 0xffff0000u)};
                    const f32x4 a1 = {__builtin_bit_cast(float, v.z << 16), __builtin_bit_cast(float, v.z & 0xffff0000u), __builtin_bit_cast(float, v.w << 16), __builtin_bit_cast(float, v.w & 0xffff0000u)};
                    *(f32x4*)(out + off + bj * HALF) = a0 * rs * gv[bj][0]; *(f32x4*)(out + off + bj * HALF + 4) = a1 * rs * gv[bj][1]; } }
    }
};
}

namespace pg8 {
struct PanelOrder {
    int c;
    __device__ __forceinline__ bool next(int i, Unit& u) const { if (i >= 2) return false; const int x = c & 7, l = c >> 3; u.pm = 8 * x + 4 * i + (l >> 3); u.pn = l & 7; return true; }
    __device__ __forceinline__ void a_ready(const Unit&) const {}
    __device__ __forceinline__ void done(const Unit&) const {}
};
struct EpiOutNorm {
    static constexpr bool PERM = false, AFTER_DRAIN = false, LAST_FUSED = false, EVERY_FUSED = true;
    const bf16_t* x; float* ssp; float* out; const float* fg; unsigned* cnt;
    __device__ __forceinline__ void operator()(const f32x4 (&)[2][2][4][2], const Unit&, int, int, int, int) const {}
    __device__ __forceinline__ void fused(f32x4 (&acc)[2][2][4][2], const Unit& u, int wr, int wc, int fr, int fq, PG8_LAS unsigned char* spare, int wid, int lane) const {
        const int row0 = u.pm * BM + wr * 64 + fr, col0 = u.pn * BM + wc * 32 + 4 * fq;
#pragma unroll
        for (int ai = 0; ai < 2; ++ai)
#pragma unroll
            for (int m = 0; m < 4; ++m) {
                const int row = row0 + ai * HALF + m * 16; const size_t off = (size_t)row * DM + col0; float s = 0.f;
#pragma unroll
                for (int bj = 0; bj < 2; ++bj) {
                    const u32x2 xa = *(const u32x2*)(x + off + bj * HALF), xb = *(const u32x2*)(x + off + bj * HALF + 16);
                    const f32x4 x0 = {__uint_as_float(xa.x << 16), __uint_as_float(xa.x & 0xffff0000u), __uint_as_float(xa.y << 16), __uint_as_float(xa.y & 0xffff0000u)};
                    const f32x4 x1 = {__uint_as_float(xb.x << 16), __uint_as_float(xb.x & 0xffff0000u), __uint_as_float(xb.y << 16), __uint_as_float(xb.y & 0xffff0000u)};
                    const f32x4 y0 = x0 + acc[ai][bj][m][0], y1 = x1 + acc[ai][bj][m][1];
                    acc[ai][bj][m][0] = y0; acc[ai][bj][m][1] = y1;
                    s += (y0[0] * y0[0] + y0[1] * y0[1]) + (y0[2] * y0[2] + y0[3] * y0[3]) + (y1[0] * y1[0] + y1[1] * y1[1]) + (y1[2] * y1[2] + y1[3] * y1[3]);
                }
                s += __shfl_xor(s, 16); s += __shfl_xor(s, 32);
                if (fq == 0) ssp[(size_t)row * 32 + u.pn * 4 + wc] = s;
            }
        asm volatile("s_waitcnt vmcnt(0)" ::: "memory"); __syncthreads();
        unsigned* pc = cnt + 64 * u.pm;
        if (wid == 0) {
            if (lane == 0) { __builtin_amdgcn_fence(__ATOMIC_RELEASE, "agent"); asm volatile("s_waitcnt vmcnt(0)" ::: "memory"); __hip_atomic_fetch_add(pc, 1u, __ATOMIC_RELAXED, __HIP_MEMORY_SCOPE_AGENT); }
            unsigned sp = 0u;
            while ((unsigned)__builtin_amdgcn_readfirstlane((int)__hip_atomic_load(pc, __ATOMIC_RELAXED, __HIP_MEMORY_SCOPE_AGENT)) < 8u) { __builtin_amdgcn_s_sleep(2); if (++sp > (1u << 17)) break; }
            __builtin_amdgcn_fence(__ATOMIC_ACQUIRE, "agent"); asm volatile("s_waitcnt vmcnt(0)" ::: "memory");
        }
        __syncthreads();
        PG8_LAS float* tab = (PG8_LAS float*)spare;
        { const int t = wid * 64 + lane;
          if (t < 256) { const f32x4* pp = (const f32x4*)(ssp + (size_t)(u.pm * BM + t) * 32); float q = 0.f;
#pragma unroll
              for (int i = 0; i < 8; ++i) { const f32x4 v = pp[i]; q += (v[0] + v[1]) + (v[2] + v[3]); }
              tab[t] = 1.0f / sqrtf(q * (1.0f / DM) + EPS); } }
        asm volatile("s_waitcnt lgkmcnt(0)" ::: "memory"); __syncthreads();
        f32x4 gv[2][2];
#pragma unroll
        for (int bj = 0; bj < 2; ++bj) { gv[bj][0] = *(const f32x4*)(fg + col0 + bj * HALF); gv[bj][1] = *(const f32x4*)(fg + col0 + bj * HALF + 16); }
#pragma unroll
        for (int ai = 0; ai < 2; ++ai)
#pragma unroll
            for (int m = 0; m < 4; ++m) { const float rs = tab[ai * HALF + wr * 64 + m * 16 + fr]; const size_t off = (size_t)(row0 + ai * HALF + m * 16) * DM + col0;
#pragma unroll
                for (int bj = 0; bj < 2; ++bj) { *(f32x4*)(out + off + bj * HALF) = acc[ai][bj][m][0] * rs * gv[bj][0]; *(f32x4*)(out + off + bj * HALF + 16) = acc[ai][bj][m][1] * rs * gv[bj][1]; } }
        asm volatile("s_waitcnt lgkmcnt(0)" ::: "memory"); __syncthreads();
    }
};
}
namespace pg8 {
template <class Epi, class Sched, bool ALIGN_EPI = false, bool SP2 = false>
__device__ __forceinline__ void gemm_phase(PG8_LAS unsigned char* lds, const Gemm g, const Sched& S, const Epi& E) {
    int tid_ = threadIdx.x; asm volatile("" : "+v"(tid_)); const int tid = tid_, wid = __builtin_amdgcn_readfirstlane(tid >> 6), lane = tid & 63, wr = wid >> 2, wc = wid & 3, fr = lane & 15, fq = lane >> 4;
    const int K = g.K, nt = K / BK;
    unsigned voffA[2], voffB[2];
#pragma unroll
    for (int i = 0; i < 2; ++i) { int R, C; stage_rc(tid * 16 + i * 8192, R, C); const int Rb = Epi::PERM ? ((R & ~31) + perm32(R & 31)) : R;
        voffA[i] = (unsigned)(R * K + C) * 2u; voffB[i] = (unsigned)(Rb * K + C) * 2u; }
    const size_t kstep = (size_t)(BK * 2);
    const size_t hstep = (size_t)HALF * K * 2;
    const size_t tstep = 2 * hstep;
    const unsigned ldsw = (unsigned)wid * 1024u;
    const int aoff = lds_byte(wr * 64 + fr, fq * 8), boff = lds_byte(wc * 32 + fr, fq * 8);
#define PG8_SA(b, h) (((b) * 2 + (h)) * HTB)
#define PG8_SB(b, h) ((4 + (b) * 2 + (h)) * HTB)
#define PG8_STAGE(bufoff, gbase, voff) do { _Pragma("unroll") for (int _i = 0; _i < 2; ++_i) \
        __builtin_amdgcn_global_load_lds((const unsigned*)((const char*)(gbase) + (voff)[_i]), (PG8_LAS unsigned*)(lds + (bufoff) + ldsw + _i * 8192), 16, 0, 0); } while (0)
#define PG8_LDA(dst, b, h) do { _Pragma("unroll") for (int m = 0; m < 4; ++m) _Pragma("unroll") for (int k = 0; k < 2; ++k) dst[m][k] = *(const PG8_LAS bf16x8*)(lds + PG8_SA(b, h) + aoff + m * 2048 + k * 1024); } while (0)
#define PG8_LDB(dst, b, h) do { _Pragma("unroll") for (int n = 0; n < 2; ++n) _Pragma("unroll") for (int k = 0; k < 2; ++k) dst[n][k] = *(const PG8_LAS bf16x8*)(lds + PG8_SB(b, h) + boff + n * 2048 + k * 1024); } while (0)
#define PG8_MMA(ai, bj, At, Bt) do { __builtin_amdgcn_s_setprio(1); _Pragma("unroll") for (int m = 0; m < 4; ++m) _Pragma("unroll") for (int n = 0; n < 2; ++n) _Pragma("unroll") for (int k = 0; k < 2; ++k) \
        acc[ai][bj][m][n] = __builtin_amdgcn_mfma_f32_16x16x32_bf16(Bt[n][k], At[m][k], acc[ai][bj][m][n], 0, 0, 0); __builtin_amdgcn_s_setprio(0); } while (0)
#define PG8_WAIT_V(n) asm volatile("s_waitcnt vmcnt(" #n ")" ::: "memory")
#define PG8_WAIT_L(n) asm volatile("s_waitcnt lgkmcnt(" #n ")" ::: "memory")
#define PG8_BAR __builtin_amdgcn_s_barrier()
#define PG8_SCHED __builtin_amdgcn_sched_barrier(0)
    Unit cur, nxt; int ui = 0;
    if (!S.next(0, cur)) return;
    f32x4 acc[2][2][4][2];
#pragma unroll
    for (int a = 0; a < 2; ++a)
#pragma unroll
        for (int b = 0; b < 2; ++b)
#pragma unroll
            for (int m = 0; m < 4; ++m)
#pragma unroll
                for (int n = 0; n < 2; ++n) acc[a][b][m][n] = (f32x4){0.f, 0.f, 0.f, 0.f};
    bf16x8 At[4][2], B0[2][2], B1[2][2];
    const char* cA = (const char*)g.A + (size_t)cur.pm * tstep; const char* cB = (const char*)g.Bt + (size_t)cur.pn * tstep;
    S.a_ready(cur);
    if constexpr (SP2) {
        PG8_STAGE(PG8_SB(0, 0), cB, voffB); PG8_STAGE(PG8_SB(0, 1), cB + hstep, voffB); PG8_STAGE(PG8_SA(0, 0), cA, voffA); PG8_STAGE(PG8_SA(0, 1), cA + hstep, voffA);
        if (wr == 1) PG8_BAR;
        PG8_WAIT_V(2); PG8_BAR;
        PG8_STAGE(PG8_SB(1, 0), cB + kstep, voffB); PG8_STAGE(PG8_SA(1, 0), cA + kstep, voffA); PG8_STAGE(PG8_SB(1, 1), cB + hstep + kstep, voffB);
        PG8_WAIT_V(6); PG8_BAR;
    } else {
        PG8_STAGE(PG8_SB(0, 0), cB, voffB); PG8_STAGE(PG8_SA(0, 0), cA, voffA); PG8_STAGE(PG8_SB(0, 1), cB + hstep, voffB); PG8_STAGE(PG8_SA(0, 1), cA + hstep, voffA);
        if (wr == 1) PG8_BAR;
        PG8_WAIT_V(4); PG8_BAR;
        PG8_STAGE(PG8_SB(1, 0), cB + kstep, voffB); PG8_STAGE(PG8_SA(1, 0), cA + kstep, voffA); PG8_STAGE(PG8_SB(1, 1), cB + hstep + kstep, voffB);
        PG8_WAIT_V(6); PG8_BAR;
    }
    for (;;) {
        const bool has_next = S.next(ui + 1, nxt);
        const char* nA = has_next ? (const char*)g.A + (size_t)nxt.pm * tstep : cA; const char* nB = has_next ? (const char*)g.Bt + (size_t)nxt.pn * tstep : cB;
        for (int t = 0; t < nt; t += 2) {
            const bool last = (t == nt - 2);
            const char* a1 = cA + (size_t)(t + 1) * kstep;
            const char* a2 = last ? nA : cA + (size_t)(t + 2) * kstep; const char* b2 = last ? nB : cB + (size_t)(t + 2) * kstep;
            const char* a3 = a2 + kstep; const char* b3 = b2 + kstep;
            if (last && has_next) S.a_ready(nxt);
            if constexpr (SP2) {
            PG8_LDB(B0, 0, 0); PG8_LDB(B1, 0, 1); PG8_SCHED; PG8_LDA(At, 0, 0); PG8_STAGE(PG8_SA(1, 1), a1 + hstep, voffA);
            PG8_WAIT_V(8); PG8_WAIT_L(0); PG8_BAR; PG8_MMA(0, 0, At, B0); PG8_MMA(0, 1, At, B1); PG8_BAR; PG8_SCHED;
            PG8_LDA(At, 0, 1); PG8_STAGE(PG8_SB(0, 0), b2, voffB); PG8_STAGE(PG8_SB(0, 1), b2 + hstep, voffB); PG8_STAGE(PG8_SA(0, 0), a2, voffA);
            PG8_WAIT_V(8); PG8_WAIT_L(0); PG8_BAR; PG8_MMA(1, 0, At, B0); PG8_MMA(1, 1, At, B1); PG8_BAR; PG8_SCHED;
            PG8_LDB(B0, 1, 0); PG8_LDB(B1, 1, 1); PG8_SCHED; PG8_LDA(At, 1, 0); PG8_STAGE(PG8_SA(0, 1), a2 + hstep, voffA);
            PG8_WAIT_V(8); PG8_WAIT_L(0); PG8_BAR; PG8_MMA(0, 0, At, B0); PG8_MMA(0, 1, At, B1); PG8_BAR; PG8_SCHED;
            PG8_LDA(At, 1, 1); PG8_STAGE(PG8_SB(1, 0), b3, voffB); PG8_STAGE(PG8_SB(1, 1), b3 + hstep, voffB); PG8_STAGE(PG8_SA(1, 0), a3, voffA);
            PG8_WAIT_V(8); PG8_WAIT_L(0); PG8_BAR; PG8_MMA(1, 0, At, B0); PG8_MMA(1, 1, At, B1); PG8_BAR; PG8_SCHED;
            } else {
            PG8_LDB(B0, 0, 0); PG8_SCHED; PG8_LDA(At, 0, 0); PG8_STAGE(PG8_SA(1, 1), a1 + hstep, voffA);
            PG8_WAIT_L(8); PG8_BAR; PG8_WAIT_L(0); PG8_MMA(0, 0, At, B0); PG8_BAR; PG8_SCHED;
            PG8_LDB(B1, 0, 1); PG8_STAGE(PG8_SB(0, 0), b2, voffB);
            PG8_BAR; PG8_WAIT_L(0); PG8_MMA(0, 1, At, B1); PG8_BAR;
            PG8_LDA(At, 0, 1); PG8_STAGE(PG8_SA(0, 0), a2, voffA);
            PG8_BAR; PG8_WAIT_L(0); PG8_MMA(1, 0, At, B0); PG8_BAR; PG8_SCHED;
            PG8_STAGE(PG8_SB(0, 1), b2 + hstep, voffB);
            PG8_WAIT_V(6); PG8_BAR; PG8_MMA(1, 1, At, B1); PG8_BAR;
            PG8_LDB(B0, 1, 0); PG8_SCHED; PG8_LDA(At, 1, 0); PG8_STAGE(PG8_SA(0, 1), a2 + hstep, voffA);
            PG8_WAIT_L(8); PG8_BAR; PG8_WAIT_L(0); PG8_MMA(0, 0, At, B0); PG8_BAR; PG8_SCHED;
            PG8_LDB(B1, 1, 1); PG8_STAGE(PG8_SB(1, 0), b3, voffB);
            PG8_BAR; PG8_WAIT_L(0); PG8_MMA(0, 1, At, B1); PG8_BAR;
            PG8_LDA(At, 1, 1); PG8_STAGE(PG8_SA(1, 0), a3, voffA);
            PG8_BAR; PG8_WAIT_L(0); PG8_MMA(1, 0, At, B0); PG8_BAR; PG8_SCHED;
            PG8_STAGE(PG8_SB(1, 1), b3 + hstep, voffB);
            PG8_WAIT_V(6); PG8_BAR; PG8_MMA(1, 1, At, B1); PG8_BAR;
            }
        }
        if constexpr (ALIGN_EPI) { if (wr == 0) PG8_BAR; }
        if constexpr (Epi::EVERY_FUSED) { E.fused(acc, cur, wr, wc, fr, fq, lds + STAGE_BYTES, wid, lane); S.done(cur); }
        else if constexpr (!Epi::AFTER_DRAIN) { if (!(Epi::LAST_FUSED && !has_next)) { E(acc, cur, wr, wc, fr, fq); S.done(cur); } }
        if (!has_next) break;
#pragma unroll
        for (int a = 0; a < 2; ++a)
#pragma unroll
            for (int b = 0; b < 2; ++b)
#pragma unroll
                for (int m = 0; m < 4; ++m)
#pragma unroll
                    for (int n = 0; n < 2; ++n) acc[a][b][m][n] = (f32x4){0.f, 0.f, 0.f, 0.f};
        cur = nxt; cA = nA; cB = nB; ++ui;
        if constexpr (ALIGN_EPI) { if (wr == 1) PG8_BAR; }
    }
    PG8_WAIT_V(0);
    if constexpr (!ALIGN_EPI) { if (wr == 0) PG8_BAR; }
    PG8_BAR;
    if constexpr (!Epi::EVERY_FUSED && (Epi::AFTER_DRAIN || Epi::LAST_FUSED)) { E.fused(acc, cur, wr, wc, fr, fq, lds, wid, lane); S.done(cur); }
#undef PG8_SA
#undef PG8_SB
#undef PG8_STAGE
#undef PG8_LDA
#undef PG8_LDB
#undef PG8_MMA
#undef PG8_WAIT_V
#undef PG8_WAIT_L
#undef PG8_BAR
#undef PG8_SCHED
}
}

namespace att {
#define ALAS __attribute__((address_space(3)))
using bf16x8 = __attribute__((ext_vector_type(8))) short;
using s16x4  = __attribute__((ext_vector_type(4))) short;
using f32x16 = __attribute__((ext_vector_type(16))) float;
constexpr int KVBLK = 64, SHM_V = KVBLK * 128 * 2, SHM_K = KVBLK * 128 * 2;
constexpr int L_V = 0, L_K = 2 * SHM_V, L_FLAG = 2 * SHM_V + 2 * SHM_K;
#define KSWZ(row, colB) ((row) * 256 + ((colB) ^ (((row) & 7) << 4)))
#define SBAR() __builtin_amdgcn_sched_barrier(0)
__device__ __forceinline__ int crow(int r, int hi) { return (r & 3) + 8 * (r >> 2) + 4 * hi; }
__device__ __forceinline__ unsigned cvtpk(float lo, float hi) { unsigned r; asm volatile("v_cvt_pk_bf16_f32 %0, %1, %2" : "=v"(r) : "v"(lo), "v"(hi)); return r; }
__device__ __forceinline__ void qkt(f32x16& p0, f32x16& p1, const ALAS unsigned char* Ks, const bf16x8* qr, int r32, int hi) {
    p0 = f32x16{}; p1 = f32x16{};
#pragma unroll
    for (int d0 = 0; d0 < 8; ++d0) { const int cb = (d0 * 16 + hi * 8) * 2;
        const bf16x8 b0 = *(const ALAS bf16x8*)(Ks + KSWZ(r32, cb));
        const bf16x8 b1 = *(const ALAS bf16x8*)(Ks + KSWZ(32 + r32, cb));
        p0 = __builtin_amdgcn_mfma_f32_32x32x16_bf16(b0, qr[d0], p0, 0, 0, 0);
        p1 = __builtin_amdgcn_mfma_f32_32x32x16_bf16(b1, qr[d0], p1, 0, 0, 0); }
}
__device__ __forceinline__ int v_st(int k, int c) { const int kk = (k & ~0xC) | ((k & 4) << 1) | ((k & 8) >> 1); return ((kk >> 3) * 4 + (c >> 5)) * 512 + ((kk & 7) * 32 + (c & 31)) * 2; }
__device__ __forceinline__ int v_rd_base(int lane) { return ((lane & 3) << 3) | (((lane >> 2) & 3) << 6) | (((lane >> 4) & 1) << 5) | (((lane >> 5) & 1) << 8); }
constexpr int v_rd_off(int d0, int ks, int half) { return d0 * 512 + ks * 4096 + half * 2048; }
template <int OFF> __device__ __forceinline__ s16x4 tr_read(int vb) { s16x4 r; asm volatile("ds_read_b64_tr_b16 %0, %1 offset:%2" : "=&v"(r) : "v"(vb), "i"(OFF) : "memory"); return r; }
template <int D0> __device__ __forceinline__ void pv_one(f32x16& od, int vb, bf16x8 pa0, bf16x8 pa1, bf16x8 pa2, bf16x8 pa3) {
    const s16x4 l0 = tr_read<v_rd_off(D0, 0, 0)>(vb), h0 = tr_read<v_rd_off(D0, 0, 1)>(vb), l1 = tr_read<v_rd_off(D0, 1, 0)>(vb), h1 = tr_read<v_rd_off(D0, 1, 1)>(vb);
    const s16x4 l2 = tr_read<v_rd_off(D0, 2, 0)>(vb), h2 = tr_read<v_rd_off(D0, 2, 1)>(vb), l3 = tr_read<v_rd_off(D0, 3, 0)>(vb), h3 = tr_read<v_rd_off(D0, 3, 1)>(vb);
    asm volatile("s_waitcnt lgkmcnt(0)" ::: "memory"); SBAR();
#define PK(L, H) (bf16x8){L[0], L[1], L[2], L[3], H[0], H[1], H[2], H[3]}
    od = __builtin_amdgcn_mfma_f32_32x32x16_bf16(pa0, PK(l0, h0), od, 0, 0, 0);
    od = __builtin_amdgcn_mfma_f32_32x32x16_bf16(pa1, PK(l1, h1), od, 0, 0, 0);
    od = __builtin_amdgcn_mfma_f32_32x32x16_bf16(pa2, PK(l2, h2), od, 0, 0, 0);
    od = __builtin_amdgcn_mfma_f32_32x32x16_bf16(pa3, PK(l3, h3), od, 0, 0, 0);
#undef PK
}
__device__ __forceinline__ void pv_d0(f32x16* o, int vb, bf16x8 pa0, bf16x8 pa1, bf16x8 pa2, bf16x8 pa3) {
    pv_one<0>(o[0], vb, pa0, pa1, pa2, pa3); pv_one<1>(o[1], vb, pa0, pa1, pa2, pa3); pv_one<2>(o[2], vb, pa0, pa1, pa2, pa3); pv_one<3>(o[3], vb, pa0, pa1, pa2, pa3);
}
__device__ __forceinline__ void pack_p(const f32x16& p0, const f32x16& p1, bf16x8& pa0, bf16x8& pa1, bf16x8& pa2, bf16x8& pa3) {
#define PK4(P, BASE, OUT) do { unsigned a0 = cvtpk(P[BASE + 0], P[BASE + 1]), a1 = cvtpk(P[BASE + 2], P[BASE + 3]);   \
    unsigned b0 = cvtpk(P[BASE + 4], P[BASE + 5]), b1 = cvtpk(P[BASE + 6], P[BASE + 7]);                              \
    auto r0 = __builtin_amdgcn_permlane32_swap(a0, b0, false, false); auto r1 = __builtin_amdgcn_permlane32_swap(a1, b1, false, false); \
    u32x4 w = {r0[0], r1[0], r0[1], r1[1]}; OUT = *reinterpret_cast<bf16x8*>(&w); } while (0)
    PK4(p0, 0, pa0); PK4(p0, 8, pa1); PK4(p1, 0, pa2); PK4(p1, 8, pa3);
#undef PK4
}
__device__ __forceinline__ void sb_weights(f32x16& p0, f32x16& p1, float& P, int hi) {
    float om[32];
#pragma unroll
    for (int i = 0; i < 16; ++i) { const float u = __builtin_amdgcn_exp2f(__builtin_amdgcn_fmed3f(p0[i], -INFINITY, 126.f)), o_ = __builtin_amdgcn_rcpf(1.0f + u); om[i] = o_; p0[i] = u * o_; }
#pragma unroll
    for (int i = 0; i < 16; ++i) { const float u = __builtin_amdgcn_exp2f(__builtin_amdgcn_fmed3f(p1[i], -INFINITY, 126.f)), o_ = __builtin_amdgcn_rcpf(1.0f + u); om[16 + i] = o_; p1[i] = u * o_; }
    float S[9]; S[8] = 1.f;
#pragma unroll
    for (int g = 7; g >= 0; --g) S[g] = S[g + 1] * ((om[4 * g] * om[4 * g + 1]) * (om[4 * g + 2] * om[4 * g + 3]));
    float tot; { auto rr = __builtin_amdgcn_permlane32_swap(__float_as_uint(S[0]), __float_as_uint(S[0]), false, false); tot = __uint_as_float(rr[0]) * __uint_as_float(rr[1]); }
#pragma unroll
    for (int g = 0; g < 8; ++g) {
        const float snd = hi ? S[g] : S[g + 1];
        auto rr = __builtin_amdgcn_permlane32_swap(__float_as_uint(snd), __float_as_uint(snd), false, false);
        const float rcv = hi ? __uint_as_float(rr[0]) : __uint_as_float(rr[1]);
        const float t3 = P * S[g + 1] * rcv, t2 = t3 * om[4 * g + 3], t1 = t2 * om[4 * g + 2], t0 = t1 * om[4 * g + 1];
        if (g < 4) { p0[4 * g + 3] *= t3; p0[4 * g + 2] *= t2; p0[4 * g + 1] *= t1; p0[4 * g] *= t0; }
        else { const int q = 4 * (g - 4); p1[q + 3] *= t3; p1[q + 2] *= t2; p1[q + 1] *= t1; p1[q] *= t0; }
    }
    P *= tot;
}
constexpr int L_STG = 69632;
__device__ __forceinline__ void epi_rows(ALAS unsigned char* lds, const f32x16* o, const float* rn, const bf16_t* __restrict__ gate0, const float* __restrict__ gain, bf16_t* __restrict__ out0, int wid, int lane) {
    const int r32 = lane & 31, hi = lane >> 5;
    ALAS bf16_t* stg = (ALAS bf16_t*)(lds + L_STG + wid * 8192);
#pragma unroll
    for (int r = 0; r < 16; ++r)
#pragma unroll
        for (int d0 = 0; d0 < 4; ++d0) stg[crow(r, hi) * 128 + 32 * d0 + r32] = (bf16_t)cvtpk(o[d0][r] * rn[r], 0.f);
    asm volatile("s_waitcnt lgkmcnt(0)" ::: "memory");
    const int cc = lane & 15, rr0 = lane >> 4;
    const f32x4 g0 = *(const f32x4*)(gain + 8 * cc), g1 = *(const f32x4*)(gain + 8 * cc + 4);
    u32x4 gt[8];
#pragma unroll
    for (int i = 0; i < 8; ++i) gt[i] = *(const u32x4*)(gate0 + (size_t)(4 * i + rr0) * 128 + 8 * cc);
#pragma unroll
    for (int i = 0; i < 8; ++i) { const int row = 4 * i + rr0;
        const u32x4 v = *(const ALAS u32x4*)(stg + row * 128 + 8 * cc); const u32x4 g = gt[i];
        float y[8], q[8];
        y[0] = bf2f(v.x & 0xffffu); y[1] = bf2f(v.x >> 16); y[2] = bf2f(v.y & 0xffffu); y[3] = bf2f(v.y >> 16); y[4] = bf2f(v.z & 0xffffu); y[5] = bf2f(v.z >> 16); y[6] = bf2f(v.w & 0xffffu); y[7] = bf2f(v.w >> 16);
        q[0] = bf2f(g.x & 0xffffu); q[1] = bf2f(g.x >> 16); q[2] = bf2f(g.y & 0xffffu); q[3] = bf2f(g.y >> 16); q[4] = bf2f(g.z & 0xffffu); q[5] = bf2f(g.z >> 16); q[6] = bf2f(g.w & 0xffffu); q[7] = bf2f(g.w >> 16);
#pragma unroll
        for (int e = 0; e < 8; ++e) y[e] = y[e] * (e < 4 ? g0[e & 3] : g1[e & 3]) * (q[e] / (1.0f + __expf(-q[e])));
        u32x4 w; w.x = cvtpk(y[0], y[1]); w.y = cvtpk(y[2], y[3]); w.z = cvtpk(y[4], y[5]); w.w = cvtpk(y[6], y[7]);
        *(u32x4*)(out0 + (size_t)row * DM + 8 * cc) = w; }
    asm volatile("s_waitcnt lgkmcnt(0)" ::: "memory");
}
constexpr float SB_EXIT = 1e-37f;
template <bool EARLY>
__device__ __forceinline__ void sb_unit(ALAS unsigned char* lds, const bf16_t* __restrict__ proj, const float* __restrict__ gain, bf16_t* __restrict__ mixed, int b, int h, int qb) {
    int tid_ = threadIdx.x; asm volatile("" : "+v"(tid_)); const int tid = tid_, wid = __builtin_amdgcn_readfirstlane(tid >> 6), lane = tid & 63, r32 = lane & 31, hi = lane >> 5;
    const size_t tok0 = (size_t)b * SEQ; const int q0 = qb * 256, tw0 = q0 + 32 * wid;
    const bf16_t* Kg = proj + (size_t)(8 + h) * PHS + tok0 * 128; const bf16_t* Vg = proj + (size_t)(16 + h) * PHS + tok0 * 128;
    bf16x8 qr[8];
    { const bf16_t* Qw = proj + (size_t)h * PHS + (tok0 + tw0 + r32) * 128 + hi * 8;
#pragma unroll
      for (int d0 = 0; d0 < 8; ++d0) qr[d0] = *(const bf16x8*)(Qw + d0 * 16); }
    const int sr = tid >> 4, sc = (tid & 15) * 8;
    const int vst0 = v_st(sr, sc), vst1 = v_st(32 + sr, sc), kst0 = KSWZ(sr, sc * 2), kst1 = KSWZ(32 + sr, sc * 2);
    const int vb0 = (int)(unsigned)(size_t)(lds + L_V) + v_rd_base(lane);
    ALAS unsigned* flags = (ALAS unsigned*)(lds + L_FLAG);
    bf16x8 ks0, ks1, vs0, vs1;
#define SLOAD(k0) do { const size_t o0 = (size_t)((k0) + sr) * 128 + sc, o1 = (size_t)((k0) + 32 + sr) * 128 + sc; \
    vs0 = *(const bf16x8*)(Vg + o0); vs1 = *(const bf16x8*)(Vg + o1); ks0 = *(const bf16x8*)(Kg + o0); ks1 = *(const bf16x8*)(Kg + o1); } while (0)
#define SWRITE(bf) do { *(ALAS bf16x8*)(lds + L_V + (bf) * SHM_V + vst0) = vs0; *(ALAS bf16x8*)(lds + L_V + (bf) * SHM_V + vst1) = vs1; \
    *(ALAS bf16x8*)(lds + L_K + (bf) * SHM_K + kst0) = ks0; *(ALAS bf16x8*)(lds + L_K + (bf) * SHM_K + kst1) = ks1; } while (0)
    const int jmax = 4 * qb + 3;
    SLOAD(jmax * KVBLK); SWRITE(0); __syncthreads();
    float R = 1.f; f32x16 o[4] = {};
    for (int it = 0, j = jmax;; ++it, --j) {
        const int cur = it & 1, key0 = j * KVBLK;
        const bool act = (key0 < tw0 + 31) && !(EARLY && __all(R < SB_EXIT));
        if (!act && j > 0) SLOAD((j - 1) * KVBLK);
        if (act) {
            f32x16 p0, p1;
            qkt(p0, p1, lds + L_K + cur * SHM_K, qr, r32, hi);
            if (key0 + 63 >= tw0) {
                const int lim = tw0 + r32 - key0 - 4 * hi;
#pragma unroll
                for (int i = 0; i < 16; ++i) { const int kk = 8 * (i >> 2) + (i & 3); if (kk >= lim) p0[i] = -INFINITY; if (kk + 32 >= lim) p1[i] = -INFINITY; }
            }
            sb_weights(p0, p1, R, hi);
            SBAR(); if (j > 0) SLOAD((j - 1) * KVBLK); SBAR();
            bf16x8 pa0, pa1, pa2, pa3;
            pack_p(p0, p1, pa0, pa1, pa2, pa3);
            pv_d0(o, vb0 + cur * SHM_V, pa0, pa1, pa2, pa3);
        }
        if (EARLY) { const bool dn = __all(R < SB_EXIT); if (lane == 0) flags[cur * 8 + wid] = dn ? 1u : 0u; }
        if (j > 0) SWRITE(cur ^ 1);
        __syncthreads();
        if (j == 0) break;
        if (EARLY) { const u32x4 f0 = *(const ALAS u32x4*)(flags + cur * 8), f1 = *(const ALAS u32x4*)(flags + cur * 8 + 4);
            if ((f0.x & f0.y & f0.z & f0.w & f1.x & f1.y & f1.z & f1.w) != 0u) break; }
    }
#undef SLOAD
#undef SWRITE
    float rn[16];
#pragma unroll
    for (int r = 0; r < 16; ++r) { float ss = (o[0][r] * o[0][r] + o[1][r] * o[1][r]) + (o[2][r] * o[2][r] + o[3][r] * o[3][r]);
#pragma unroll
        for (int x = 1; x < 32; x <<= 1) ss += __shfl_xor(ss, x);
        rn[r] = 1.0f / sqrtf(ss * (1.0f / HD) + EPS); }
    epi_rows(lds, o, rn, proj + (size_t)(24 + h) * PHS + (tok0 + tw0) * 128, gain + h * HD, mixed + (tok0 + tw0) * DM + h * HD, wid, lane);
}
constexpr int L_WS = L_FLAG + 64;
constexpr float DSA_THR = 11.5f;
__device__ __forceinline__ void dsa_partial(f32x16& p0, f32x16& p1, unsigned long long mw, int hi, float& m_reg, float& mn, float& alpha) {
    const int mlo = (int)((unsigned)mw >> (4 * hi)), mhi = (int)((unsigned)(mw >> 32) >> (4 * hi));
    const unsigned NINF = 0xff800000u;
#pragma unroll
    for (int i = 0; i < 16; ++i) { const int kk = 8 * (i >> 2) + (i & 3);
        const unsigned t0 = (unsigned)__builtin_amdgcn_sbfe(mlo, kk, 1), t1 = (unsigned)__builtin_amdgcn_sbfe(mhi, kk, 1);
        p0[i] = __uint_as_float((__float_as_uint(p0[i]) & t0) | (NINF & ~t0)); p1[i] = __uint_as_float((__float_as_uint(p1[i]) & t1) | (NINF & ~t1)); }
    float pmax, pmb;
    pmax = max3_asm(p0[0], p0[1], p0[2]); pmb = max3_asm(p1[0], p1[1], p1[2]);
#pragma unroll
    for (int r = 3; r < 15; r += 2) { pmax = max3_asm(pmax, p0[r], p0[r + 1]); pmb = max3_asm(pmb, p1[r], p1[r + 1]); }
    pmax = max3_asm(pmax, p0[15], p1[15]); pmax = max3_asm(pmax, pmb, pmb);
    { auto rr = __builtin_amdgcn_permlane32_swap(__float_as_uint(pmax), __float_as_uint(pmax), false, false); pmax = max3_asm(__uint_as_float(rr[0]), __uint_as_float(rr[1]), __uint_as_float(rr[1])); }
    if (__builtin_expect(__all(pmax - m_reg <= DSA_THR), 1)) { mn = m_reg; alpha = 1.f; }
    else { mn = fmaxf(m_reg, pmax); alpha = __builtin_amdgcn_exp2f(m_reg - mn); m_reg = mn; }
#pragma unroll
    for (int r = 0; r < 16; ++r) { p0[r] -= mn; p1[r] -= mn; }
#pragma unroll
    for (int r = 0; r < 16; ++r) p0[r] = __builtin_amdgcn_exp2f(p0[r]);
}
__device__ __forceinline__ void dsa_finish(f32x16& p0, f32x16& p1, float alpha, float& l_reg, bf16x8& pa0, bf16x8& pa1, bf16x8& pa2, bf16x8& pa3) {
#pragma unroll
    for (int r = 0; r < 16; ++r) p1[r] = __builtin_amdgcn_exp2f(p1[r]);
    float ps = 0.f;
#pragma unroll
    for (int r = 0; r < 16; ++r) ps += p0[r];
#pragma unroll
    for (int r = 0; r < 16; ++r) ps += p1[r];
    { auto rr = __builtin_amdgcn_permlane32_swap(__float_as_uint(ps), __float_as_uint(ps), false, false); ps = __uint_as_float(rr[0]) + __uint_as_float(rr[1]); }
    l_reg = l_reg * alpha + ps;
    pack_p(p0, p1, pa0, pa1, pa2, pa3);
}
__device__ __forceinline__ void dsa_unit(ALAS unsigned char* lds, const bf16_t* __restrict__ proj, const unsigned long long* __restrict__ mask, const float* __restrict__ gain,
                                         bf16_t* __restrict__ mixed, int b, int h, int qb) {
    int tid_ = threadIdx.x; asm volatile("" : "+v"(tid_)); const int tid = tid_, wid = __builtin_amdgcn_readfirstlane(tid >> 6), lane = tid & 63, r32 = lane & 31, hi = lane >> 5, g = h >> 2;
    const size_t tok0 = (size_t)b * SEQ; const int q0 = qb * 256, tw0 = q0 + 32 * wid;
    const bf16_t* Kg = proj + (size_t)(40 + g) * PHS + tok0 * 128; const bf16_t* Vg = proj + (size_t)(42 + g) * PHS + tok0 * 128;
    bf16x8 qr[8];
    { const bf16_t* Qw = proj + (size_t)(32 + h) * PHS + (tok0 + tw0 + r32) * 128 + hi * 8;
#pragma unroll
      for (int d0 = 0; d0 < 8; ++d0) qr[d0] = *(const bf16x8*)(Qw + d0 * 16); }
    const unsigned long long* mrow = mask + (tok0 + tw0 + r32) * 64;
    const int sr = tid >> 4, sc = (tid & 15) * 8;
    const int vst0 = v_st(sr, sc), vst1 = v_st(32 + sr, sc), kst0 = KSWZ(sr, sc * 2), kst1 = KSWZ(32 + sr, sc * 2);
    const int vb0 = (int)(unsigned)(size_t)(lds + L_V) + v_rd_base(lane);
    ALAS float* wsl = (ALAS float*)(lds + L_WS) + wid * 64;
    bf16x8 eV0, eV1, eK0, eK1, oV0, oV1, oK0, oK1;
#define SLOAD_E(k0) do { const size_t o0 = (size_t)((k0) + sr) * 128 + sc, o1 = (size_t)((k0) + 32 + sr) * 128 + sc; eV0 = *(const bf16x8*)(Vg + o0); eV1 = *(const bf16x8*)(Vg + o1); eK0 = *(const bf16x8*)(Kg + o0); eK1 = *(const bf16x8*)(Kg + o1); } while (0)
#define SLOAD_O(k0) do { const size_t o0 = (size_t)((k0) + sr) * 128 + sc, o1 = (size_t)((k0) + 32 + sr) * 128 + sc; oV0 = *(const bf16x8*)(Vg + o0); oV1 = *(const bf16x8*)(Vg + o1); oK0 = *(const bf16x8*)(Kg + o0); oK1 = *(const bf16x8*)(Kg + o1); } while (0)
#define SWRITE_E() do { *(ALAS bf16x8*)(lds + L_V + vst0) = eV0; *(ALAS bf16x8*)(lds + L_V + vst1) = eV1; *(ALAS bf16x8*)(lds + L_K + kst0) = eK0; *(ALAS bf16x8*)(lds + L_K + kst1) = eK1; } while (0)
#define SWRITE_O() do { *(ALAS bf16x8*)(lds + L_V + SHM_V + vst0) = oV0; *(ALAS bf16x8*)(lds + L_V + SHM_V + vst1) = oV1; *(ALAS bf16x8*)(lds + L_K + SHM_K + kst0) = oK0; *(ALAS bf16x8*)(lds + L_K + SHM_K + kst1) = oK1; } while (0)
#define SWAIT() asm volatile("s_waitcnt vmcnt(4)" ::: "memory")
#define RESC(a) do { if (__any((a) < 1.f)) { if (hi == 0) wsl[r32] = (a); asm volatile("s_waitcnt lgkmcnt(0)" ::: "memory"); \
    _Pragma("unroll") for (int r = 0; r < 16; ++r) { const float al_ = wsl[crow(r, hi)]; _Pragma("unroll") for (int d = 0; d < 4; ++d) o[d][r] *= al_; } } } while (0)
    const int NT = 4 * qb + 4;
    float m_reg = -1e30f, l_reg = 0.f; f32x16 o[4] = {};
    f32x16 pA0, pA1, pB0, pB1; float mnA, mnB, alA, alB; bf16x8 pa0, pa1, pa2, pa3;
    SLOAD_E(0); unsigned long long mwA = mrow[0], mwB; asm volatile("s_waitcnt vmcnt(0)" ::: "memory"); SWRITE_E(); __syncthreads();
    qkt(pA0, pA1, lds + L_K, qr, r32, hi); dsa_partial(pA0, pA1, mwA, hi, m_reg, mnA, alA);
    SLOAD_O(KVBLK); SLOAD_E(2 * KVBLK);
    SWAIT(); SWRITE_O(); __syncthreads();
    for (int j = 1; j + 1 < NT; j += 2) {
        mwB = mrow[j];
        SBAR(); qkt(pB0, pB1, lds + L_K + SHM_K, qr, r32, hi);
        dsa_finish(pA0, pA1, alA, l_reg, pa0, pa1, pa2, pa3); SBAR();
        SLOAD_O((j + 2) * KVBLK); SBAR();
        pv_d0(o, vb0, pa0, pa1, pa2, pa3); dsa_partial(pB0, pB1, mwB, hi, m_reg, mnB, alB);
        __syncthreads(); SWAIT(); SWRITE_E();
        RESC(alB); __syncthreads();
        mwA = mrow[j + 1];
        SBAR(); qkt(pA0, pA1, lds + L_K, qr, r32, hi);
        dsa_finish(pB0, pB1, alB, l_reg, pa0, pa1, pa2, pa3); SBAR();
        if (j + 3 < NT) SLOAD_E((j + 3) * KVBLK); SBAR();
        pv_d0(o, vb0 + SHM_V, pa0, pa1, pa2, pa3); dsa_partial(pA0, pA1, mwA, hi, m_reg, mnA, alA);
        __syncthreads(); SWAIT(); SWRITE_O();
        RESC(alA); __syncthreads();
    }
    mwB = mrow[NT - 1];
    SBAR(); qkt(pB0, pB1, lds + L_K + SHM_K, qr, r32, hi);
    dsa_finish(pA0, pA1, alA, l_reg, pa0, pa1, pa2, pa3); SBAR();
    pv_d0(o, vb0, pa0, pa1, pa2, pa3); dsa_partial(pB0, pB1, mwB, hi, m_reg, mnB, alB);
    RESC(alB);
    dsa_finish(pB0, pB1, alB, l_reg, pa0, pa1, pa2, pa3); SBAR();
    pv_d0(o, vb0 + SHM_V, pa0, pa1, pa2, pa3);
    __syncthreads();
#undef SLOAD_E
#undef SLOAD_O
#undef SWRITE_E
#undef SWRITE_O
#undef SWAIT
#undef RESC
    if (hi == 0) wsl[32 + r32] = l_reg; asm volatile("s_waitcnt lgkmcnt(0)" ::: "memory");
    float rn[16];
#pragma unroll
    for (int r = 0; r < 16; ++r) { const float il = 1.0f / wsl[32 + crow(r, hi)];
#pragma unroll
        for (int d = 0; d < 4; ++d) o[d][r] *= il;
        float ss = (o[0][r] * o[0][r] + o[1][r] * o[1][r]) + (o[2][r] * o[2][r] + o[3][r] * o[3][r]);
#pragma unroll
        for (int x = 1; x < 32; x <<= 1) ss += __shfl_xor(ss, x);
        rn[r] = 1.0f / sqrtf(ss * (1.0f / HD) + EPS); }
    epi_rows(lds, o, rn, proj + (size_t)(44 + h) * PHS + (tok0 + tw0) * 128, gain + h * HD, mixed + (tok0 + tw0) * DM + 1024 + h * HD, wid, lane);
    asm volatile("s_waitcnt lgkmcnt(0)" ::: "memory");
}
}

namespace idx {
#define ILAS __attribute__((address_space(3)))
using bf16x8 = __attribute__((ext_vector_type(8))) short;
using f32x16 = __attribute__((ext_vector_type(16))) float;
constexpr int L_SC = 0, L_HIST = 131072, L_CAND = 131072 + 8192, L_TCTR = 131072 + 16384, CAND_CAP = 256;
__device__ __forceinline__ float tmap(float v, float scale, float nms) { return __builtin_fmaf(v, scale, nms); }
__device__ __forceinline__ int lbin(float t) { return (int)fminf(fmaxf(t, 0.f), 255.f); }
__device__ __forceinline__ void index_unit(ILAS unsigned char* lds, const bf16_t* __restrict__ proj, const float* __restrict__ iw, unsigned long long* __restrict__ mask, int b, int t0, int uidx, int nb, int nt0) {
    int tid_ = threadIdx.x; asm volatile("" : "+v"(tid_)); const int tid = tid_, wid = __builtin_amdgcn_readfirstlane(tid >> 6), lane = tid & 63, r = lane & 31, hi = lane >> 5;
    const size_t tok0 = (size_t)b * SEQ;
    ILAS unsigned* sc = (ILAS unsigned*)(lds + L_SC);
    ILAS unsigned* tctr = (ILAS unsigned*)(lds + L_TCTR);
    {
        bf16x8 af[4][4]; float wv[4][16];
#pragma unroll
        for (int T = 0; T < 4; ++T) {
            const bf16_t* qb = proj + IQF_OFF + ((((tok0 + t0) >> 3) * 4 + T) * 4 * 64 + lane) * 8;
#pragma unroll
            for (int ks = 0; ks < 4; ++ks) af[T][ks] = *(const bf16x8*)(qb + ks * 512);
            const float* wp = iw + (tok0 + t0 + 2 * T + hi) * 16;
#pragma unroll
            for (int i = 0; i < 4; ++i) { const f32x4 w4 = *(const f32x4*)(wp + 4 * i); wv[T][4 * i] = w4.x; wv[T][4 * i + 1] = w4.y; wv[T][4 * i + 2] = w4.z; wv[T][4 * i + 3] = w4.w; }
        }
        const int nt32 = 2 * ((t0 + 8 + 63) >> 6), nt32p = (nt32 + 15) & ~15;
        const bf16_t* kb = proj + IKC_OFF + (tok0 >> 5) * (4 * 64 * 8) + lane * 8;
        bf16x8 b0[4], b1[4], b2[4];
#define KLOAD(dst, j) do { _Pragma("unroll") for (int ks = 0; ks < 4; ++ks) dst[ks] = *(const bf16x8*)(kb + (size_t)(j) * (4 * 64 * 8) + ks * 512); } while (0)
#define CLAIM(dst) do { unsigned c_ = 0u; if (lane == 0) c_ = __hip_atomic_fetch_add(tctr + (uidx & 1), 1u, __ATOMIC_RELAXED, __HIP_MEMORY_SCOPE_WORKGROUP); dst = __builtin_amdgcn_readfirstlane((int)c_); } while (0)
        int j0, j1, j2;
        CLAIM(j0); CLAIM(j1);
        if (j0 < nt32) KLOAD(b0, j0);
        if (j1 < nt32) KLOAD(b1, j1);
        while (j0 < nt32p) {
            CLAIM(j2);
            if (j2 < nt32) KLOAD(b2, j2);
            const int key0 = 32 * j0;
            if (j0 < nt32) {
#pragma unroll
                for (int T = 0; T < 4; ++T) {
                    f32x16 acc = {};
#pragma unroll
                    for (int ks = 0; ks < 4; ++ks) acc = __builtin_amdgcn_mfma_f32_32x32x16_bf16(af[T][ks], b0[ks], acc, 0, 0, 0);
                    float sv = 0.f;
#pragma unroll
                    for (int rr = 0; rr < 16; ++rr) sv = fmaf(wv[T][rr], relu_i(acc[rr]), sv);
                    const int q = 2 * T + hi, key = key0 + r;
                    sc[q * SEQ + key] = (key <= t0 + q) ? __float_as_uint(sv) : 0xff800000u;
                }
            } else {
#pragma unroll
                for (int T = 0; T < 4; ++T) sc[(2 * T + hi) * SEQ + key0 + r] = 0xff800000u;
            }
#pragma unroll
            for (int ks = 0; ks < 4; ++ks) { b0[ks] = b1[ks]; b1[ks] = b2[ks]; }
            j0 = j1; j1 = j2;
        }
#undef KLOAD
#undef CLAIM
    }
    asm volatile("s_waitcnt lgkmcnt(0)" ::: "memory");
    __syncthreads();
    if (tid == 0) tctr[(uidx + 1) & 1] = 0u;
    const int t = t0 + wid, N = t + 1, NE = (N + 63) >> 6, NE8 = (NE + 7) & ~7;
    const ILAS unsigned* myrow = sc + wid * SEQ + lane;
    float v[64];
#pragma unroll
    for (int c = 0; c < 8; ++c) {
        if (8 * c < NE8) {
#pragma unroll
            for (int i = 0; i < 8; ++i) v[8 * c + i] = __uint_as_float(myrow[64 * (8 * c + i)]);
        } else {
#pragma unroll
            for (int i = 0; i < 8; ++i) v[8 * c + i] = -INFINITY;
        }
    }
    asm volatile("s_waitcnt lgkmcnt(0)" ::: "memory");
    __syncthreads();
    float pf = 0.f;
    if (nt0 >= 0 && tid < 132) {
        const size_t ntok = (size_t)nb * SEQ + nt0;
        const char* p = tid < 128 ? (const char*)(proj + IQF_OFF + ((ntok >> 3) * 4) * (4 * 64 * 8)) + tid * 128 : (const char*)(iw + ntok * 16) + (tid - 128) * 128;
        pf = *(const float*)p;
    }
    unsigned long long myw = 0ull;
    if (N <= TOPK) {
        for (int e = 0; e < NE; ++e) { const unsigned long long bm = __ballot(64 * e + lane <= t); if (lane == e) myw = bm; }
    } else {
        ILAS unsigned* hist = (ILAS unsigned*)(lds + L_HIST) + wid * 256;
        ILAS unsigned* cand = (ILAS unsigned*)(lds + L_CAND) + wid * CAND_CAP;
        float mx = -INFINITY, mn = INFINITY;
#pragma unroll
        for (int c = 0; c < 8; ++c) if (8 * c < NE8) {
            if (64 * (8 * c + 8) <= N) {
#pragma unroll
                for (int i = 0; i < 8; i += 2) { mx = max3_asm(mx, v[8 * c + i], v[8 * c + i + 1]); mn = min3_asm(mn, v[8 * c + i], v[8 * c + i + 1]); }
            } else {
#pragma unroll
                for (int i = 0; i < 8; ++i) { mx = fmaxf(mx, v[8 * c + i]); mn = fminf(mn, (64 * (8 * c + i) + lane <= t) ? v[8 * c + i] : INFINITY); }
            }
        }
        mx = wave_max_dpp(mx); mn = wave_min_dpp(mn);
        const float scale = (mx > mn) ? fminf(256.0f / (mx - mn), 1e30f) : 1.0f, nms = -mn * scale;
        *(ILAS u32x4*)(hist + 4 * lane) = (u32x4){0u, 0u, 0u, 0u};
        asm volatile("s_waitcnt lgkmcnt(0)" ::: "memory");
#pragma unroll
        for (int c = 0; c < 8; ++c) if (8 * c < NE8) {
#pragma unroll
            for (int i = 0; i < 8; ++i) __hip_atomic_fetch_add(hist + lbin(tmap(v[8 * c + i], scale, nms)), 1u, __ATOMIC_RELAXED, __HIP_MEMORY_SCOPE_WORKGROUP);
        }
        asm volatile("s_waitcnt lgkmcnt(0)" ::: "memory");
        int bstar, need; unsigned cb;
        {
            const u32x4 c4 = *(const ILAS u32x4*)(hist + 4 * lane);
            const unsigned s4 = (c4.x + c4.y) + (c4.z + c4.w);
            unsigned sl = s4;
#pragma unroll
            for (int off = 1; off < 64; off <<= 1) { const unsigned tt = __shfl_down(sl, off); if (lane + off < 64) sl += tt; }
            const unsigned long long bal = __ballot(sl >= (unsigned)TOPK);
            const int ls = 63 - __clzll((long long)bal);
            const unsigned above = (unsigned)__builtin_amdgcn_readlane((int)sl, ls) - (unsigned)__builtin_amdgcn_readlane((int)s4, ls);
            const unsigned cx = (unsigned)__builtin_amdgcn_readlane((int)c4.x, ls), cy = (unsigned)__builtin_amdgcn_readlane((int)c4.y, ls);
            const unsigned cz = (unsigned)__builtin_amdgcn_readlane((int)c4.z, ls), cw = (unsigned)__builtin_amdgcn_readlane((int)c4.w, ls);
            unsigned ab = above; int d;
            if (ab + cw >= (unsigned)TOPK) { d = 3; cb = cw; } else { ab += cw;
                if (ab + cz >= (unsigned)TOPK) { d = 2; cb = cz; } else { ab += cz;
                    if (ab + cy >= (unsigned)TOPK) { d = 1; cb = cy; } else { ab += cy; d = 0; cb = cx; } } }
            bstar = 4 * ls + d; need = TOPK - (int)ab;
        }
        unsigned tau; int req, eqtot;
        if (cb <= (unsigned)CAND_CAP) {
            int base = 0;
            const float blo = (bstar == 0) ? -INFINITY : (float)bstar, bhi = (bstar == 255) ? INFINITY : (float)(bstar + 1);
#pragma unroll
            for (int c = 0; c < 8; ++c) if (8 * c < NE8) {
#pragma unroll
                for (int i = 0; i < 8; ++i) { const float vv = v[8 * c + i]; const float tt = tmap(vv, scale, nms); const bool in = (tt >= blo) && (tt < bhi); const unsigned long long m = __ballot(in);
                    if (m != 0ull) { if (in) cand[base + __builtin_amdgcn_mbcnt_hi((unsigned)(m >> 32), __builtin_amdgcn_mbcnt_lo((unsigned)m, 0u))] = fkey(vv); base += __popcll(m); } }
            }
            asm volatile("s_waitcnt lgkmcnt(0)" ::: "memory");
            unsigned k0 = 0u, k1 = 0u, k2 = 0u, k3 = 0u; int c0 = 0, c1 = 0, c2 = 0, c3 = 0;
            const int ncb = (int)cb;
            if (lane < ncb) k0 = cand[lane]; if (64 + lane < ncb) k1 = cand[64 + lane]; if (128 + lane < ncb) k2 = cand[128 + lane]; if (192 + lane < ncb) k3 = cand[192 + lane];
            asm volatile("s_waitcnt lgkmcnt(0)" ::: "memory");
#define RANK_FROM(KV, OFS) do { const int nj_ = min(64, ncb - (OFS)); for (int jj = 0; jj < nj_; ++jj) { const unsigned kj = (unsigned)__builtin_amdgcn_readlane((int)(KV), jj); const int j = (OFS) + jj; \
                c0 += (kj > k0 || (kj == k0 && j < lane)) ? 1 : 0; \
                if (ncb > 64) { c1 += (kj > k1 || (kj == k1 && j < 64 + lane)) ? 1 : 0; c2 += (kj > k2 || (kj == k2 && j < 128 + lane)) ? 1 : 0; c3 += (kj > k3 || (kj == k3 && j < 192 + lane)) ? 1 : 0; } } } while (0)
            RANK_FROM(k0, 0); if (ncb > 64) RANK_FROM(k1, 64); if (ncb > 128) RANK_FROM(k2, 128); if (ncb > 192) RANK_FROM(k3, 192);
#undef RANK_FROM
            const unsigned long long h0 = __ballot(lane < ncb && c0 == need - 1), h1 = __ballot(64 + lane < ncb && c1 == need - 1), h2 = __ballot(128 + lane < ncb && c2 == need - 1), h3 = __ballot(192 + lane < ncb && c3 == need - 1);
            if (h0) tau = (unsigned)__builtin_amdgcn_readlane((int)k0, __builtin_ctzll(h0)); else if (h1) tau = (unsigned)__builtin_amdgcn_readlane((int)k1, __builtin_ctzll(h1));
            else if (h2) tau = (unsigned)__builtin_amdgcn_readlane((int)k2, __builtin_ctzll(h2)); else tau = (unsigned)__builtin_amdgcn_readlane((int)k3, __builtin_ctzll(h3));
            req = __popcll(__ballot(lane < ncb && c0 < need && k0 == tau)) + __popcll(__ballot(64 + lane < ncb && c1 < need && k1 == tau))
                + __popcll(__ballot(128 + lane < ncb && c2 < need && k2 == tau)) + __popcll(__ballot(192 + lane < ncb && c3 < need && k3 == tau));
            eqtot = __popcll(__ballot(lane < ncb && k0 == tau)) + __popcll(__ballot(64 + lane < ncb && k1 == tau)) + __popcll(__ballot(128 + lane < ncb && k2 == tau)) + __popcll(__ballot(192 + lane < ncb && k3 == tau));
        } else {
            unsigned pref = 0u; int krem = TOPK; unsigned lastc = 0u;
            for (int pass = 0; pass < 4; ++pass) {
                const int shift = 24 - 8 * pass;
                *(ILAS u32x4*)(hist + 4 * lane) = (u32x4){0u, 0u, 0u, 0u};
                asm volatile("s_waitcnt lgkmcnt(0)" ::: "memory");
#pragma unroll
                for (int c = 0; c < 8; ++c) if (8 * c < NE8) {
#pragma unroll
                    for (int i = 0; i < 8; ++i) { const unsigned k = fkey(v[8 * c + i]);
                        const bool mt = (pass == 0) ? true : ((k >> ((shift + 8) & 31)) == pref);
                        if (mt) __hip_atomic_fetch_add(hist + ((k >> shift) & 255u), 1u, __ATOMIC_RELAXED, __HIP_MEMORY_SCOPE_WORKGROUP); }
                }
                asm volatile("s_waitcnt lgkmcnt(0)" ::: "memory");
                const u32x4 c4 = *(const ILAS u32x4*)(hist + 4 * lane);
                const unsigned s4 = (c4.x + c4.y) + (c4.z + c4.w);
                unsigned sl = s4;
#pragma unroll
                for (int off = 1; off < 64; off <<= 1) { const unsigned tt = __shfl_down(sl, off); if (lane + off < 64) sl += tt; }
                const unsigned long long bal = __ballot(sl >= (unsigned)krem);
                const int ls = 63 - __clzll((long long)bal);
                const unsigned above = (unsigned)__builtin_amdgcn_readlane((int)sl, ls) - (unsigned)__builtin_amdgcn_readlane((int)s4, ls);
                const unsigned cx = (unsigned)__builtin_amdgcn_readlane((int)c4.x, ls), cy = (unsigned)__builtin_amdgcn_readlane((int)c4.y, ls);
                const unsigned cz = (unsigned)__builtin_amdgcn_readlane((int)c4.z, ls), cw = (unsigned)__builtin_amdgcn_readlane((int)c4.w, ls);
                unsigned ab = above; int d;
                if (ab + cw >= (unsigned)krem) { d = 3; lastc = cw; } else { ab += cw;
                    if (ab + cz >= (unsigned)krem) { d = 2; lastc = cz; } else { ab += cz;
                        if (ab + cy >= (unsigned)krem) { d = 1; lastc = cy; } else { ab += cy; d = 0; lastc = cx; } } }
                pref = (pref << 8) | (unsigned)(4 * ls + d); krem -= (int)ab;
            }
            tau = pref; req = krem; eqtot = (int)lastc;
        }
        int wlo = 0, whi = 0;
        const float tauf = __uint_as_float((tau & 0x80000000u) ? (tau & 0x7fffffffu) : ~tau);
        if (eqtot == req) {
            unsigned clo = 0u, chi = 0u;
#pragma unroll
            for (int c = 7; c >= 4; --c) if (8 * c < NE8) {
#pragma unroll
                for (int i = 7; i >= 0; --i) chi = (chi << 1) | ((v[8 * c + i] >= tauf) ? 1u : 0u);
            }
#pragma unroll
            for (int c = 3; c >= 0; --c) if (8 * c < NE8) {
#pragma unroll
                for (int i = 7; i >= 0; --i) clo = (clo << 1) | ((v[8 * c + i] >= tauf) ? 1u : 0u);
            }
            { auto rr = __builtin_amdgcn_permlane32_swap(clo, chi, false, false); clo = rr[0]; chi = rr[1]; }
            { const bool up = (lane & 16) == 0; const unsigned ol = (unsigned)__builtin_amdgcn_ds_swizzle((int)clo, 0x401F), oh = (unsigned)__builtin_amdgcn_ds_swizzle((int)chi, 0x401F);
              clo = tr_stage<16, 0x0000FFFFu>(clo, ol, up); chi = tr_stage<16, 0x0000FFFFu>(chi, oh, up); }
            { const bool up = (lane & 8) == 0; const unsigned ol = dppu<0x128>(clo), oh = dppu<0x128>(chi);
              clo = tr_stage<8, 0x00FF00FFu>(clo, ol, up); chi = tr_stage<8, 0x00FF00FFu>(chi, oh, up); }
            { const bool up = (lane & 4) == 0; const unsigned ol = (unsigned)__builtin_amdgcn_ds_swizzle((int)clo, 0x101F), oh = (unsigned)__builtin_amdgcn_ds_swizzle((int)chi, 0x101F);
              clo = tr_stage<4, 0x0F0F0F0Fu>(clo, ol, up); chi = tr_stage<4, 0x0F0F0F0Fu>(chi, oh, up); }
            { const bool up = (lane & 2) == 0; const unsigned ol = dppu<0x4E>(clo), oh = dppu<0x4E>(chi);
              clo = tr_stage<2, 0x33333333u>(clo, ol, up); chi = tr_stage<2, 0x33333333u>(chi, oh, up); }
            { const bool up = (lane & 1) == 0; const unsigned ol = dppu<0xB1>(clo), oh = dppu<0xB1>(chi);
              clo = tr_stage<1, 0x55555555u>(clo, ol, up); chi = tr_stage<1, 0x55555555u>(chi, oh, up); }
            wlo = (int)clo; whi = (int)chi;
        } else {
            int elo = 0, ehi = 0;
#pragma unroll
            for (int c = 0; c < 8; ++c) if (8 * c < NE8) {
#pragma unroll
                for (int i = 0; i < 8; ++i) { const float vv = v[8 * c + i];
                    const unsigned long long gt = __ballot(vv > tauf), em = __ballot(vv == tauf);
                    asm("s_nop 1\n\tv_writelane_b32 %0, %4, %8\n\tv_writelane_b32 %1, %5, %8\n\tv_writelane_b32 %2, %6, %8\n\tv_writelane_b32 %3, %7, %8" : "+v"(wlo), "+v"(whi), "+v"(elo), "+v"(ehi)
                        : "s"((unsigned)gt), "s"((unsigned)(gt >> 32)), "s"((unsigned)em), "s"((unsigned)(em >> 32)), "n"(8 * c + i));
                }
            }
            const unsigned long long eqw = ((unsigned long long)(unsigned)ehi << 32) | (unsigned long long)(unsigned)elo;
            const int cnt = __popcll(eqw); int inc = cnt;
#pragma unroll
            for (int off = 1; off < 64; off <<= 1) { const int tt = __shfl_up(inc, off); if (lane >= off) inc += tt; }
            int ntake = req - (inc - cnt);
            unsigned long long take = 0ull;
            if (ntake >= cnt) take = eqw;
            else { unsigned long long rem = eqw; while (ntake > 0) { const unsigned long long bb = rem & (~rem + 1ull); take |= bb; rem ^= bb; --ntake; } }
            wlo |= (int)(unsigned)take; whi |= (int)(unsigned)(take >> 32);
        }
        myw = ((unsigned long long)(unsigned)whi << 32) | (unsigned long long)(unsigned)wlo;
    }
    mask[(tok0 + t) * 64 + lane] = myw;
    asm volatile("" :: "v"(pf));
}
}

#define LAS __attribute__((address_space(3)))
#define RLX_AGENT __ATOMIC_RELAXED, __HIP_MEMORY_SCOPE_AGENT
#define XB_TMO      128
#define XB_XCNT(j)  (256  + 64 * (j))
#define XB_XSUB(j)  (1280 + 64 * (j))
#define XB_XGEN(j)  (2304 + 64 * (j))
#define XB_TOP      3328
#define XB_TOPGEN   3392
#define XCD_BAR_WORDS 3456
#define XB_SPIN_CAP (1u << 18)

__device__ __forceinline__ unsigned xb_ld(unsigned* p)              { return __hip_atomic_load(p, __ATOMIC_RELAXED, __HIP_MEMORY_SCOPE_AGENT); }
__device__ __forceinline__ unsigned xb_add(unsigned* p, unsigned v) { return __hip_atomic_fetch_add(p, v, __ATOMIC_RELAXED, __HIP_MEMORY_SCOPE_AGENT); }
__device__ __forceinline__ unsigned xb_xcc_id() { return (unsigned)__builtin_amdgcn_s_getreg((3 << 11) | 20) & 0xFu; }
#define XB_SPIN(cond, bar) do { unsigned _sp = 0; while (cond) { __builtin_amdgcn_s_sleep(1); \
    if ((++_sp & 255u) == 0u) { if (xb_ld(&(bar)[XB_TMO])) break; if (_sp > XB_SPIN_CAP) { atomicAdd(&(bar)[XB_TMO], 1u); break; } } } } while (0)

struct XcdBarrier {
    unsigned* bar; unsigned x;
    volatile LAS unsigned* st;
};

__device__ __forceinline__ XcdBarrier xcd_barrier_post(unsigned* bar, volatile LAS unsigned* st) {
    XcdBarrier b; b.bar = bar; b.x = xb_xcc_id(); b.st = st;
    if (threadIdx.x == 0) (void)xb_add(&bar[XB_XCNT(b.x)], 1u);
    return b;
}
__device__ __forceinline__ void xcd_barrier_complete(unsigned* bar, unsigned x, unsigned& nloc, unsigned& nx) {
    const unsigned G = gridDim.x * gridDim.y * gridDim.z;
    unsigned sum, cnt, mine, sp = 0u;
    for (;;) {
        sum = 0u; cnt = 0u; mine = 0u;
#pragma unroll
        for (unsigned j = 0; j < 16; ++j) { const unsigned c = xb_ld(&bar[XB_XCNT(j)]); sum += c; cnt += (c > 0u) ? 1u : 0u; mine = (j == x) ? c : mine; }
        if (sum == G) break;
        __builtin_amdgcn_s_sleep(1);
        if ((++sp & 255u) == 0u) { if (xb_ld(&bar[XB_TMO])) break; if (sp > XB_SPIN_CAP) { atomicAdd(&bar[XB_TMO], 1u); break; } }
    }
    nloc = mine > 0u ? mine : 1u; nx = cnt > 0u ? cnt : 1u;
}

__device__ __forceinline__ void xcd_barrier(const XcdBarrier& b) {
    asm volatile("s_waitcnt vmcnt(0)" ::: "memory");
    __syncthreads();
    if (threadIdx.x == 0) {
        unsigned* bar = b.bar;
        __builtin_amdgcn_s_waitcnt(0);
        unsigned nloc = b.st[0], nx = b.st[1];
        if (nloc == 0u) { xcd_barrier_complete(bar, b.x, nloc, nx); b.st[0] = nloc; b.st[1] = nx; }
        const unsigned old = xb_add(&bar[XB_XSUB(b.x)], 1u);
        const unsigned gen = old / nloc;
        if (old + 1u == (gen + 1u) * nloc) {
            __builtin_amdgcn_fence(__ATOMIC_RELEASE, "agent");
            asm volatile("s_waitcnt vmcnt(0)" ::: "memory");
            const unsigned og = xb_add(&bar[XB_TOP], 1u);
            const unsigned tg = og / nx;
            if (og + 1u == (tg + 1u) * nx) xb_add(&bar[XB_TOPGEN], 1u);
            else XB_SPIN(xb_ld(&bar[XB_TOPGEN]) == tg, bar);
            __builtin_amdgcn_fence(__ATOMIC_ACQUIRE, "agent");
            xb_add(&bar[XB_XGEN(b.x)], 1u);
            asm volatile("s_waitcnt vmcnt(0)" ::: "memory");
        } else {
            XB_SPIN(xb_ld(&bar[XB_XGEN(b.x)]) == gen, bar);
            __builtin_amdgcn_fence(__ATOMIC_ACQUIRE, "agent");
            asm volatile("s_waitcnt vmcnt(0)" ::: "memory");
        }
    }
    __syncthreads();
}

#define GAS __attribute__((address_space(1)))
#define LDS_WAIT() asm volatile("s_waitcnt lgkmcnt(0)" ::: "memory")
constexpr int NWAVES = 8, LDS_BYTES = 149504;

struct Args { const float* x; const int* pos; const float* norm_g; const float* w_in; const float* sb_g; const float* dsa_g; const float* w_out; const float* final_g; float* out; unsigned char* ws; int ph_lo, ph_hi; };

__device__ __forceinline__ void transpose_item(const float* __restrict__ W, int K, int N, int NPAD, bf16_t* __restrict__ WT, LAS float* scr, int item, int lane, const float* __restrict__ gk = nullptr) {
    const int nblk = NPAD / 32, kb = item / nblk, nb = item % nblk, k0 = 64 * kb, n0 = 32 * nb;
    const int n = n0 + (lane & 31); const bool ok = n < N;
    float tv[32];
#pragma unroll
    for (int i = 0; i < 32; ++i) tv[i] = ok ? __builtin_nontemporal_load(W + (size_t)(k0 + 2 * i + (lane >> 5)) * N + n) : 0.f;
    if (gk) {
#pragma unroll
        for (int i = 0; i < 32; ++i) tv[i] *= gk[k0 + 2 * i + (lane >> 5)]; }
#pragma unroll
    for (int i = 0; i < 32; ++i) scr[(2 * i + (lane >> 5)) * 33 + (lane & 31)] = tv[i];
    LDS_WAIT();
    const int c = lane & 7;
#pragma unroll
    for (int j = 0; j < 4; ++j) { const int nn = (lane >> 3) + 8 * j; const LAS float* s = scr + (8 * c) * 33 + nn;
        u32x4 o; o.x = pk2(s[0 * 33], s[1 * 33]); o.y = pk2(s[2 * 33], s[3 * 33]); o.z = pk2(s[4 * 33], s[5 * 33]); o.w = pk2(s[6 * 33], s[7 * 33]);
        *(u32x4*)(WT + (size_t)(n0 + nn) * K + k0 + 8 * c) = o; }
    LDS_WAIT();
}
__device__ __forceinline__ void rmsnorm_4rows_bf16(const float* __restrict__ x, float* __restrict__ rstd, bf16_t* __restrict__ hn, int m0, int mstep, int lane) {
    f32x4 v[4][8]; float ss[4];
#pragma unroll
    for (int q = 0; q < 4; ++q) { const int m = min(m0 + q * mstep, NTOK - 1); const f32x4* xr = (const f32x4*)(x + (size_t)m * DM) + lane;
#pragma unroll
        for (int j = 0; j < 8; ++j) v[q][j] = __builtin_nontemporal_load(xr + 64 * j); }
#pragma unroll
    for (int q = 0; q < 4; ++q) { float s = 0.f;
#pragma unroll
        for (int j = 0; j < 8; ++j) s += (v[q][j].x * v[q][j].x + v[q][j].y * v[q][j].y) + (v[q][j].z * v[q][j].z + v[q][j].w * v[q][j].w);
        ss[q] = 1.0f / sqrtf(wave_sum_dpp(s) * (1.0f / DM) + EPS); }
#pragma unroll
    for (int q = 0; q < 4; ++q) { const int m = m0 + q * mstep; if (m < NTOK && lane == 0) rstd[m] = ss[q]; }
#pragma unroll
    for (int j = 0; j < 8; ++j) {
#pragma unroll
        for (int q = 0; q < 4; ++q) { const int m = m0 + q * mstep; if (m < NTOK) { u32x2 w;
            w.x = pk2(v[q][j].x, v[q][j].y); w.y = pk2(v[q][j].z, v[q][j].w);
            ((u32x2*)(hn + (size_t)m * DM) + lane)[64 * j] = w; } } }
}

__global__ void __launch_bounds__(NWAVES * 64, 2) mega(Args a) {
    extern __shared__ __attribute__((aligned(16))) unsigned char lds_raw[];
    LAS unsigned char* lds = (LAS unsigned char*)lds_raw;
    int tid_ = threadIdx.x; asm volatile("" : "+v"(tid_)); const int tid = tid_, lane = tid & 63, wave = __builtin_amdgcn_readfirstlane(tid >> 6);
    const int G = gridDim.x, bx = blockIdx.x;
    unsigned char* ws = a.ws;
    bf16_t* HN = (bf16_t*)(ws + WS_HN); bf16_t* WT1 = (bf16_t*)(ws + WS_WT1); bf16_t* WT2 = (bf16_t*)(ws + WS_WT2);
    float* IW = (float*)(ws + WS_IW); float* R128 = (float*)(ws + WS_R128); float* R64 = (float*)(ws + WS_R64); bf16_t* PROJ = (bf16_t*)(ws + WS_PROJ);
    bf16_t* MIXED = (bf16_t*)(ws + WS_MIXED); bf16_t* YB = (bf16_t*)(ws + WS_PROJ); float* SSP = (float*)(ws + WS_SSP); unsigned long long* MASKW = (unsigned long long*)(ws + WS_MASK); const unsigned long long* MASK = MASKW;
    const int lo = a.ph_lo, hi = a.ph_hi;
#define IN(k) (lo <= (k) && (k) < hi)
    if (tid < 2) ((volatile LAS unsigned*)(lds + LDS_BYTES - 64))[tid] = 0u;
    __syncthreads();
    unsigned* const xbw = (unsigned*)(ws + WS_CTL) + 4096;
    unsigned* const pcnt = (unsigned*)(ws + WS_CTL) + 16384;
    if (bx == 0) for (int i = tid; i < XCD_BAR_WORDS; i += NWAVES * 64) __hip_atomic_store(xbw + i, 0u, __ATOMIC_RELAXED, __HIP_MEMORY_SCOPE_AGENT);
    unsigned* const mcnt = pcnt + 64 * 64;
    if (bx == 0) for (int i = tid; i < 2 * 64 * 64; i += NWAVES * 64) __hip_atomic_store(pcnt + i, 0u, __ATOMIC_RELAXED, __HIP_MEMORY_SCOPE_AGENT);
    XcdBarrier xbar; xbar.bar = xbw; xbar.x = 0u; xbar.st = (volatile LAS unsigned*)(lds + LDS_BYTES - 64);
#define SEAM(k) do { if (IN(k) && IN((k) + 1)) xcd_barrier(xbar); } while (0)
    if (hi - lo > 1) { cooperative_groups::this_grid().sync(); xbar = xcd_barrier_post(xbw, (volatile LAS unsigned*)(lds + LDS_BYTES - 64)); }

    if (IN(0)) {
        const int gw = bx * NWAVES + wave, NGW = G * NWAVES;
        LAS float* scr = (LAS float*)(lds + wave * 16384);
        constexpr int I1 = (DM / 64) * (NP / 32), I2 = (DM / 64) * (DM / 32);
        {
            static const double IRV[16] = {0.15915494309189535, 0.070086521587798503, 0.03086376340470123, 0.013591370636193905, 0.0059851857127137054, 0.002635675898667414, 0.001160663641240061, 0.00051111750453754386,
                                           0.00022507907903927653, 9.9117309369019355e-05, 4.3647952792802891e-05, 1.9221100684944863e-05, 8.4643308082414014e-06, 3.7274086019153519e-06, 1.6414262627950345e-06, 7.2282930688328648e-07};
            for (int i = bx * (NWAVES * 64) + tid; i < NTOK * 24; i += G * NWAVES * 64) {
                const int tok = i / 24, j = i % 24; const double rev = (double)a.pos[tok] * IRV[j < 16 ? j : 2 * (j - 16)];
                const float rr = (float)(rev - floor(rev)); const float sn = __builtin_amdgcn_sinf(rr), cs = __builtin_amdgcn_cosf(rr);
                if (j < 16) { R128[tok * 32 + j] = cs; R128[tok * 32 + 16 + j] = sn; } else { R64[tok * 16 + (j - 16)] = cs; R64[tok * 16 + 8 + (j - 16)] = sn; }
            }
        }

        const bool wout_here = !(G == 256 && ((NTOK / 256) * (NP / 256)) % 256 != 0);
        for (int it = gw; it < I1 + (wout_here ? I2 : 0); it += NGW) {
            if (it < I1) transpose_item(a.w_in, DM, D_IN, NP, WT1, scr, it, lane, a.norm_g);
            else transpose_item(a.w_out, DM, DM, DM, WT2, scr, it - I1, lane);
        }

        for (int m = gw; m < NTOK; m += 4 * NGW) rmsnorm_4rows_bf16(a.x, (float*)(ws + WS_RSTD), HN, m, NGW, lane);

    }
    SEAM(0);
    if (IN(1)) {
        pg8::Gemm g{HN, WT1, NTOK, NP, DM}; pg8::StaticOrder S; S.init(NTOK, NP, G, bx, 1);
        pg8::EpiProj E{PROJ, IW, R128, R64, (const float*)(ws + WS_RSTD)};
        pg8::gemm_phase<pg8::EpiProj, pg8::StaticOrder, true, true>(lds, g, S, E);
        constexpr int NW1 = (NTOK / 256) * (NP / 256), REM1 = NW1 % 256;
        if (G == 256 && REM1 != 0 && bx >= REM1) {
            __syncthreads();
            constexpr int I2 = (DM / 64) * (DM / 32); const int nidle = 256 - REM1;
            LAS float* scr = (LAS float*)(lds + wave * 16384);
            for (int it = (bx - REM1) * NWAVES + wave; it < I2; it += nidle * NWAVES) transpose_item(a.w_out, DM, DM, DM, WT2, scr, it, lane);
        }
    }
    SEAM(1);
    if (IN(2)) {
        const int vcu = (G % 8 == 0) ? (bx % 8) * (G / 8) + bx / 8 : bx;
        if (tid < 2) ((LAS unsigned*)(lds + idx::L_TCTR))[tid] = 0u;
        __syncthreads();
        for (int k = 0;; ++k) {
            const int sI = k * G + ((k & 1) ? (G - 1 - vcu) : vcu);
            if (sI >= NTOK / 8) break;
            const int sN = (k + 1) * G + (((k + 1) & 1) ? (G - 1 - vcu) : vcu); const bool hn = sN < NTOK / 8;
            idx::index_unit(lds, PROJ, IW, MASKW, sI & 3, 8 * (511 - (sI >> 2)), k, hn ? (sN & 3) : 0, hn ? 8 * (511 - (sN >> 2)) : -1);
        }
        asm volatile("s_waitcnt vmcnt(0)" ::: "memory");
        __syncthreads();
        if (tid == 0) {
            __builtin_amdgcn_fence(__ATOMIC_RELEASE, "agent"); asm volatile("s_waitcnt vmcnt(0)" ::: "memory");
            for (int k = 0;; ++k) {
                const int sI = k * G + ((k & 1) ? (G - 1 - vcu) : vcu);
                if (sI >= NTOK / 8) break;
                __hip_atomic_fetch_add(mcnt + 64 * ((sI & 3) * 16 + ((8 * (511 - (sI >> 2))) >> 8)), 1u, __ATOMIC_RELAXED, __HIP_MEMORY_SCOPE_AGENT);
            }
        }
    }

    if (IN(3)) {
        unsigned* const sbq = pcnt + 32;
        unsigned* const dq = pcnt + 64 * (bx & 7) + 48;
        volatile LAS unsigned* qs = (volatile LAS unsigned*)(lds + LDS_BYTES - 64) + 4;
        constexpr unsigned NSBU = BATCH * SBH * 16, NDQ = 64;
        unsigned pend = 0u;
        if (tid == 0) qs[0] = __hip_atomic_fetch_add(sbq, 1u, __ATOMIC_RELAXED, __HIP_MEMORY_SCOPE_AGENT);
        __syncthreads();
        unsigned uq = qs[0];
        while (uq < NSBU) {
            if (tid == 0) pend = __hip_atomic_fetch_add(sbq, 1u, __ATOMIC_RELAXED, __HIP_MEMORY_SCOPE_AGENT);
            const int qb = 15 - (int)(uq >> 5), bh = (int)(uq & 31u);
            att::sb_unit<true>(lds, PROJ, a.sb_g, MIXED, bh / SBH, bh % SBH, qb);
            __syncthreads();
            if (tid == 0) qs[0] = pend;
            __syncthreads();
            uq = qs[0];
        }
        if (tid == 0) qs[0] = __hip_atomic_fetch_add(dq, 1u, __ATOMIC_RELAXED, __HIP_MEMORY_SCOPE_AGENT);
        __syncthreads();
        uq = qs[0];
        while (uq < NDQ) {
            const int x = bx & 7, b = x >> 1, h = 4 * (x & 1) + (int)(uq & 3u), qb = 15 - (int)(uq >> 2);
            if (wave == 0) {
                unsigned* pc = mcnt + 64 * (b * 16 + qb); unsigned sp = 0u;
                while ((unsigned)__builtin_amdgcn_readfirstlane((int)__hip_atomic_load(pc, __ATOMIC_RELAXED, __HIP_MEMORY_SCOPE_AGENT)) < 32u) { __builtin_amdgcn_s_sleep(4); if (++sp > (1u << 22)) break; }
                __builtin_amdgcn_fence(__ATOMIC_ACQUIRE, "agent"); asm volatile("s_waitcnt vmcnt(0)" ::: "memory");
            }
            __syncthreads();
            att::dsa_unit(lds, PROJ, MASK, a.dsa_g, MIXED, b, h, qb);
            __syncthreads();
            if (tid == 0) qs[0] = __hip_atomic_fetch_add(dq, 1u, __ATOMIC_RELAXED, __HIP_MEMORY_SCOPE_AGENT);
            __syncthreads();
            uq = qs[0];
        }
    }

    SEAM(3);
    if (IN(4)) {
        pg8::Gemm g{MIXED, WT2, NTOK, DM, DM};
        if (G == 256) {
            pg8::PanelOrder S{bx}; pg8::EpiOutNorm E{HN, SSP, a.out, a.final_g, pcnt};
            pg8::gemm_phase<pg8::EpiOutNorm, pg8::PanelOrder, true, true>(lds, g, S, E);
        } else {
            pg8::StaticOrder S; S.init(NTOK, DM, G, bx);
            pg8::EpiOut E{a.x, YB, SSP, a.out, a.final_g, pcnt, 0, 0};
            pg8::gemm_phase<pg8::EpiOut, pg8::StaticOrder, true, true>(lds, g, S, E);
        }
    }
    if (G != 256) { SEAM(4); }
    if (IN(5) && G != 256) {
        const int gw = bx * NWAVES + wave, NGW = G * NWAVES;
        for (int m = gw; m < NTOK; m += NGW) {
            const float sp = (lane < 32) ? SSP[(size_t)m * 32 + lane] : 0.f;
            const float r = 1.0f / sqrtf(wave_sum(sp) * (1.0f / DM) + EPS);
            const u32x4* yr = (const u32x4*)(YB + (size_t)m * DM) + lane; const f32x4* gr = (const f32x4*)a.final_g + 2 * lane; f32x4* orow = (f32x4*)(a.out + (size_t)m * DM) + 2 * lane;
#pragma unroll
            for (int j = 0; j < 4; ++j) { const u32x4 v = yr[64 * j]; const f32x4 g0 = gr[128 * j], g1 = gr[128 * j + 1];
                orow[128 * j] = (f32x4){bf2f(v.x & 0xffffu) * r * g0.x, bf2f(v.x >> 16) * r * g0.y, bf2f(v.y & 0xffffu) * r * g0.z, bf2f(v.y >> 16) * r * g0.w};
                orow[128 * j + 1] = (f32x4){bf2f(v.z & 0xffffu) * r * g1.x, bf2f(v.z >> 16) * r * g1.y, bf2f(v.w & 0xffffu) * r * g1.z, bf2f(v.w >> 16) * r * g1.w}; }
        }
    }

#undef IN
#undef SEAM
}

extern "C" void kernel_launch(void* const* d_in, const int* in_sizes, int n_in, void* d_out, int out_size, void* d_ws, size_t ws_size, hipStream_t stream) {
    static int grid = 0;
    if (grid == 0) {
        if (n_in != 8 || in_sizes[0] != NTOK * DM || out_size != NTOK * DM || ws_size < WS_END) {
            fprintf(stderr, "kernel_launch: shape mismatch n_in %d in0 %d out %d ws %zu (need %zu)\n", n_in, n_in > 0 ? in_sizes[0] : -1, out_size, ws_size, (size_t)WS_END); grid = -1; return; }
        int dev = 0, cus = 0;
        if (hipGetDevice(&dev) != hipSuccess || hipDeviceGetAttribute(&cus, hipDeviceAttributeMultiprocessorCount, dev) != hipSuccess) { grid = -1; return; }
        if (hipFuncSetAttribute((const void*)mega, hipFuncAttributeMaxDynamicSharedMemorySize, LDS_BYTES) != hipSuccess) { fprintf(stderr, "kernel_launch: hipFuncSetAttribute failed\n"); grid = -1; return; }
        int per_cu = 0;
        if (hipOccupancyMaxActiveBlocksPerMultiprocessor(&per_cu, (const void*)mega, NWAVES * 64, LDS_BYTES) != hipSuccess || per_cu < 1) { fprintf(stderr, "kernel_launch: occupancy query says %d blocks per CU\n", per_cu); grid = -1; return; }
        grid = cus;
    }
    if (grid < 0) return;
    const float* x = (const float*)d_in[0]; const float* sb_g = (const float*)d_in[4]; const float* dsa_g = (const float*)d_in[5]; const float* final_g = (const float*)d_in[7];
    unsigned char* ws = (unsigned char*)d_ws; float* out = (float*)d_out;
    bf16_t* MIXED = (bf16_t*)(ws + WS_MIXED); bf16_t* WT2 = (bf16_t*)(ws + WS_WT2);
    float* IW = (float*)(ws + WS_IW);
    unsigned long long* MASK = (unsigned long long*)(ws + WS_MASK); bf16_t* PROJ = (bf16_t*)(ws + WS_PROJ);
    Args a{};
    a.x = x; a.pos = (const int*)d_in[1]; a.norm_g = (const float*)d_in[2]; a.w_in = (const float*)d_in[3]; a.sb_g = sb_g; a.dsa_g = dsa_g; a.w_out = (const float*)d_in[6]; a.final_g = final_g;
    a.out = out; a.ws = ws;
    a.ph_lo = 0; a.ph_hi = 6;
    void* kargs[] = {(void*)&a};
    const hipError_t le = hipLaunchCooperativeKernel((const void*)mega, dim3(grid), dim3(NWAVES * 64), kargs, LDS_BYTES, stream);
    if (le != hipSuccess) fprintf(stderr, "kernel_launch: cooperative launch failed: %s (grid %d)\n", hipGetErrorString(le), grid);
}
```
